# Optimizing an MI355X kernel written in HIP

```python
import jax, jax.numpy as jnp
from jax import lax
import numpy as np

D_MODEL = 2048
BATCH = 1
SEQ = 8192
DEPTH = 1

BLK = 128
EPS = 1e-6
NEG = -1e30
TINY = 1e-30
FORCE = 1e4

A_DILATIONS = (1, 4, 16)
A_WINDOWS = (128, 512, 2048)
A_GROUPS = 3
A_HEADS = 4
A_HD = 128
B_HEADS = 16
B_KV = 2
B_REP = B_HEADS // B_KV
B_HD = 64
CMP_LEN = 32
CMP_STRIDE = 16
CMP_HIDDEN = 128
SLC_LEN = 64
N_SEL = 16
WIN = 512
N_BRANCH = 2
X_HEADS = 4
X_HD = 128
N_MEM = 256
PEER_HEADS = 8
PEER_DK = 256
N_KEYS = 128
N_EXPERTS = N_KEYS * N_KEYS
PEER_TOPK = 16
PEER_V_SCALE = 0.25

A_QKV_COLS = 3 * A_GROUPS * A_HEADS * A_HD
B_Q_COLS = B_HEADS * B_HD
B_KV_COLS = 3 * 2 * B_KV * B_HD
B_GATE_COLS = B_HEADS * 3
MERGE_COLS = N_BRANCH * D_MODEL
IN_COLS = A_QKV_COLS + B_Q_COLS + B_KV_COLS + B_GATE_COLS + MERGE_COLS
SPLITS = [A_QKV_COLS, A_QKV_COLS + B_Q_COLS, A_QKV_COLS + B_Q_COLS + B_KV_COLS, A_QKV_COLS + B_Q_COLS + B_KV_COLS + B_GATE_COLS]

kernel_name = 'hybrid_dilated_nsa_peer_block'


def rmsnorm(x, g):
    xf = x.astype(jnp.float32)
    y = xf * lax.rsqrt(jnp.mean(xf * xf, axis=-1, keepdims=True) + EPS)
    return (y * g.astype(jnp.float32)).astype(x.dtype)


def alibi_slopes(n):
    return jnp.power(2.0, -8.0 * (jnp.arange(n, dtype=jnp.float32) + 1.0) / n)


def masked_probs(s, ok):
    s = jnp.where(ok, s, NEG)
    m = jnp.max(s, axis=-1, keepdims=True)
    p = jnp.where(ok, jnp.exp(s - m), 0.0)
    return p / jnp.maximum(jnp.sum(p, axis=-1, keepdims=True), TINY)


def dilated_window_attn(q, k, v, slopes, dil, steps):
    B, T, H, hd = q.shape
    L = T // dil
    Lp = -(-L // BLK) * BLK
    nb = Lp // BLK
    N = B * dil

    def strided(a):
        a = a.reshape(B, L, dil, H, hd).transpose(0, 2, 3, 1, 4).reshape(N, H, L, hd)
        return jnp.pad(a, ((0, 0), (0, 0), (0, Lp - L), (0, 0))).reshape(N, H, nb, BLK, hd)

    qb, kb, vb = strided(q), strided(k), strided(v)

    def with_prev(a):
        prev = jnp.concatenate([jnp.zeros_like(a[:, :, :1]), a[:, :, :-1]], axis=2)
        return jnp.concatenate([prev, a], axis=3)

    k2, v2 = with_prev(kb), with_prev(vb)
    s = jnp.einsum('nhbqd,nhbkd->nhbqk', qb, k2).astype(jnp.float32) * (hd ** -0.5)
    rel = jnp.arange(BLK)[:, None] + BLK - jnp.arange(2 * BLK)[None, :]
    ok = (rel >= 0) & (rel <= steps)
    ok = ok[None] & ((jnp.arange(nb)[:, None, None] > 0) | (jnp.arange(2 * BLK)[None, None, :] >= BLK))
    s = s - slopes.astype(jnp.float32)[:, None, None, None] * (rel * dil).astype(jnp.float32)
    s = jnp.where(ok, s, NEG)
    m = jnp.max(s, axis=-1, keepdims=True)
    p = jnp.exp(s - m)
    den = jnp.sum(p, axis=-1, keepdims=True)
    o = jnp.einsum('nhbqk,nhbkd->nhbqd', p, v2) / den
    lse = (m + jnp.log(den))[..., 0]
    o = o.reshape(N, H, Lp, hd)[:, :, :L].reshape(B, dil, H, L, hd).transpose(0, 3, 1, 2, 4).reshape(B, T, H, hd)
    lse = lse.reshape(N, H, Lp)[:, :, :L].reshape(B, dil, H, L).transpose(0, 3, 1, 2).reshape(B, T, H)
    return o, lse


def dilated_attention(qkv):
    B, T = qkv.shape[:2]
    slopes = alibi_slopes(A_GROUPS * A_HEADS).reshape(A_GROUPS, A_HEADS)
    outs, lses = [], []
    for g in range(A_GROUPS):
        o, l = dilated_window_attn(qkv[:, :, 0, g], qkv[:, :, 1, g], qkv[:, :, 2, g], slopes[g],
                                   A_DILATIONS[g], A_WINDOWS[g] // A_DILATIONS[g])
        outs.append(o)
        lses.append(l)
    w = jax.nn.softmax(jnp.stack(lses), axis=0)
    o = jnp.einsum('gbth,gbthd->bthd', w, jnp.stack(outs))
    return o.reshape(B, T, A_HEADS * A_HD)


def nsa_attention(q, kv, gates, w_ck1, w_ck2, pe_k, w_cv1, w_cv2, pe_v):
    B, T = q.shape[:2]
    scale = B_HD ** -0.5
    slopes = alibi_slopes(B_HEADS).reshape(B_KV, B_REP)[:, :, None, None]
    qg = q.reshape(B, T, B_KV, B_REP, B_HD).transpose(0, 2, 3, 1, 4)
    gg = gates.reshape(B, T, B_KV, B_REP, 3).transpose(0, 2, 3, 1, 4)
    kvg = kv.transpose(2, 3, 0, 4, 1, 5)
    k_c, v_c, k_s, v_s, k_w, v_w = kvg[0, 0], kvg[0, 1], kvg[1, 0], kvg[1, 1], kvg[2, 0], kvg[2, 1]

    n_cmp = (T - CMP_LEN) // CMP_STRIDE + 1
    c_idx = jnp.arange(n_cmp)[:, None] * CMP_STRIDE + jnp.arange(CMP_LEN)[None, :]

    def compress(a, pe, w1, w2):
        blocks = (a[:, :, c_idx] + pe).reshape(B, B_KV, n_cmp, CMP_LEN * B_HD)
        return jax.nn.gelu(blocks @ w1) @ w2

    kc = compress(k_c, pe_k, w_ck1, w_ck2)
    vc = compress(v_c, pe_v, w_cv1, w_cv2)
    c_end = c_idx[:, -1]
    n_slc = T // SLC_LEN
    c_start = jnp.arange(n_cmp)[:, None] * CMP_STRIDE
    s_start = jnp.arange(n_slc)[None, :] * SLC_LEN
    overlap = jnp.clip(jnp.minimum(c_start + CMP_LEN, s_start + SLC_LEN) - jnp.maximum(c_start, s_start),
                       0, None).astype(jnp.float32) / CMP_LEN
    ks_blk = k_s.reshape(B, B_KV, n_slc, SLC_LEN, B_HD)
    vs_blk = v_s.reshape(B, B_KV, n_slc, SLC_LEN, B_HD)
    nsel = min(N_SEL, n_slc)
    bi = jnp.arange(B)[:, None, None, None]
    gi = jnp.arange(B_KV)[None, :, None, None]
    kw_pad = jnp.pad(k_w, ((0, 0), (0, 0), (WIN, 0), (0, 0)))
    vw_pad = jnp.pad(v_w, ((0, 0), (0, 0), (WIN, 0), (0, 0)))
    j_slc = jnp.arange(n_slc)
    w_off = jnp.arange(BLK + WIN) - WIN

    def block(b):
        t0 = b * BLK
        t = t0 + jnp.arange(BLK)
        qb = lax.dynamic_slice_in_dim(qg, t0, BLK, axis=3)
        gb = lax.dynamic_slice_in_dim(gg, t0, BLK, axis=3)
        dist = t[:, None] - c_end[None, :]
        s = jnp.einsum('bgrqd,bgcd->bgrqc', qb, kc).astype(jnp.float32) * scale - slopes * dist.astype(jnp.float32)
        p_c = masked_probs(s, dist >= 0)
        o_c = jnp.einsum('bgrqc,bgcd->bgrqd', p_c, vc)
        imp = jnp.einsum('bgrqc,cj->bgqj', p_c, overlap)
        cur = (t // SLC_LEN)[:, None]
        forced = (j_slc == 0) | (j_slc == cur) | (j_slc == cur - 1)
        score = jnp.where(forced, FORCE, jnp.where(j_slc <= cur, imp, NEG))
        top_s, top_i = lax.top_k(score, nsel)
        ks = ks_blk[bi, gi, top_i].reshape(B, B_KV, BLK, nsel * SLC_LEN, B_HD)
        vs = vs_blk[bi, gi, top_i].reshape(B, B_KV, BLK, nsel * SLC_LEN, B_HD)
        pos = (top_i[..., None] * SLC_LEN + jnp.arange(SLC_LEN)).reshape(B, B_KV, BLK, nsel * SLC_LEN)
        d_s = t[:, None] - pos
        ok_s = (d_s >= 0) & jnp.repeat(top_s > NEG / 2, SLC_LEN, axis=-1)
        s = jnp.einsum('bgrqd,bgqkd->bgrqk', qb, ks).astype(jnp.float32) * scale - slopes * d_s[:, :, None].astype(jnp.float32)
        p_s = masked_probs(s, ok_s[:, :, None])
        o_s = jnp.einsum('bgrqk,bgqkd->bgrqd', p_s, vs)
        kw = lax.dynamic_slice_in_dim(kw_pad, t0, BLK + WIN, axis=2)
        vw = lax.dynamic_slice_in_dim(vw_pad, t0, BLK + WIN, axis=2)
        pos_w = t0 + w_off
        d_w = t[:, None] - pos_w[None, :]
        ok_w = (d_w >= 0) & (d_w < WIN) & (pos_w >= 0)[None, :]
        s = jnp.einsum('bgrqd,bgkd->bgrqk', qb, kw).astype(jnp.float32) * scale - slopes * d_w.astype(jnp.float32)
        p_w = masked_probs(s, ok_w)
        o_w = jnp.einsum('bgrqk,bgkd->bgrqd', p_w, vw)
        return gb[..., 0:1] * o_c + gb[..., 1:2] * o_s + gb[..., 2:3] * o_w

    out = lax.map(block, jnp.arange(T // BLK))
    return out.transpose(1, 0, 4, 2, 3, 5).reshape(B, T, B_HEADS * B_HD)


def memory_cross_attention(hn, mn, w_q, w_kv, w_o):
    B, T, _ = hn.shape
    q = (hn @ w_q).reshape(B, T, X_HEADS, X_HD)
    kv = (mn @ w_kv).reshape(B, mn.shape[1], 2, X_HEADS, X_HD)
    s = jnp.einsum('bthd,bmhd->bhtm', q, kv[:, :, 0]).astype(jnp.float32) * (X_HD ** -0.5)
    p = jax.nn.softmax(s, axis=-1)
    o = jnp.einsum('bhtm,bmhd->bthd', p, kv[:, :, 1]).reshape(B, T, X_HEADS * X_HD)
    return o @ w_o


def peer(xn, w_pq, sub_k1, sub_k2, u_tab, v_tab):
    B, T, D = xn.shape
    half = PEER_DK // 2
    q = (xn @ w_pq).reshape(B, T, PEER_HEADS, PEER_DK)
    s1 = jnp.einsum('bthd,kd->bthk', q[..., :half], sub_k1).astype(jnp.float32)
    s2 = jnp.einsum('bthd,kd->bthk', q[..., half:], sub_k2).astype(jnp.float32)
    v1, i1 = lax.top_k(s1, PEER_TOPK)
    v2, i2 = lax.top_k(s2, PEER_TOPK)
    cand = (v1[..., :, None] + v2[..., None, :]).reshape(B, T, PEER_HEADS, PEER_TOPK * PEER_TOPK)
    vs, ci = lax.top_k(cand, PEER_TOPK)
    e1 = jnp.take_along_axis(i1, ci // PEER_TOPK, axis=-1)
    e2 = jnp.take_along_axis(i2, ci % PEER_TOPK, axis=-1)
    eid = e1 * N_KEYS + e2
    g = jax.nn.softmax(vs, axis=-1)
    n_chunks = (B * T) // BLK
    xf = xn.reshape(n_chunks, BLK, D)
    ef = eid.reshape(n_chunks, BLK, PEER_HEADS * PEER_TOPK)
    gf = g.reshape(n_chunks, BLK, PEER_HEADS * PEER_TOPK)

    def chunk(args):
        xb, eb, gb = args
        a = jax.nn.gelu(jnp.einsum('nd,ned->ne', xb, u_tab[eb]))
        return jnp.einsum('ne,ned->nd', a * gb, v_tab[eb])

    return lax.map(chunk, (xf, ef, gf)).reshape(B, T, D)


def setup_inputs(seed: int = 0) -> dict:
    key = jax.random.key(seed)
    ks = jax.random.split(key, 25)
    L, D = DEPTH, D_MODEL

    def nrm(k, shape, scale):
        return jax.random.normal(k, shape, jnp.float32) * scale

    def gain(k, shape):
        return 1.0 + 0.01 * jax.random.normal(k, shape, jnp.float32)

    return {
        'x': nrm(ks[0], (BATCH, SEQ, D), 1.0),
        'mem': nrm(ks[1], (BATCH, N_MEM, D), 1.0),
        'norm_mix': gain(ks[2], (L, D)),
        'w_in': nrm(ks[3], (L, D, IN_COLS), D ** -0.5),
        'w_cmp_k1': nrm(ks[4], (L, CMP_LEN * B_HD, CMP_HIDDEN), (CMP_LEN * B_HD) ** -0.5),
        'w_cmp_k2': nrm(ks[5], (L, CMP_HIDDEN, B_HD), CMP_HIDDEN ** -0.5),
        'pe_cmp_k': nrm(ks[6], (L, CMP_LEN, B_HD), 0.1),
        'w_cmp_v1': nrm(ks[7], (L, CMP_LEN * B_HD, CMP_HIDDEN), (CMP_LEN * B_HD) ** -0.5),
        'w_cmp_v2': nrm(ks[8], (L, CMP_HIDDEN, B_HD), CMP_HIDDEN ** -0.5),
        'pe_cmp_v': nrm(ks[9], (L, CMP_LEN, B_HD), 0.1),
        'w_up_a': nrm(ks[10], (L, A_HEADS * A_HD, D), (A_HEADS * A_HD) ** -0.5),
        'w_up_b': nrm(ks[11], (L, B_HEADS * B_HD, D), (B_HEADS * B_HD) ** -0.5),
        'w_out': nrm(ks[12], (L, D, D), D ** -0.5),
        'norm_x': gain(ks[13], (L, D)),
        'norm_mem': gain(ks[14], (L, D)),
        'w_xq': nrm(ks[15], (L, D, X_HEADS * X_HD), D ** -0.5),
        'w_xkv': nrm(ks[16], (L, D, 2 * X_HEADS * X_HD), D ** -0.5),
        'w_xo': nrm(ks[17], (L, X_HEADS * X_HD, D), (X_HEADS * X_HD) ** -0.5),
        'norm_ffn': gain(ks[18], (L, D)),
        'w_pq': nrm(ks[19], (L, D, PEER_HEADS * PEER_DK), D ** -0.5),
        'sub_keys1': nrm(ks[20], (L, N_KEYS, PEER_DK // 2), (PEER_DK // 2) ** -0.5),
        'sub_keys2': nrm(ks[21], (L, N_KEYS, PEER_DK // 2), (PEER_DK // 2) ** -0.5),
        'expert_u': nrm(ks[22], (L, N_EXPERTS, D), D ** -0.5),
        'expert_v': nrm(ks[23], (L, N_EXPERTS, D), PEER_V_SCALE),
        'norm_final': gain(ks[24], (D,)),
    }


def reference(x, mem, norm_mix, w_in, w_cmp_k1, w_cmp_k2, pe_cmp_k, w_cmp_v1, w_cmp_v2, pe_cmp_v,
              w_up_a, w_up_b, w_out, norm_x, norm_mem, w_xq, w_xkv, w_xo, norm_ffn, w_pq,
              sub_keys1, sub_keys2, expert_u, expert_v, norm_final):
    B, T, D = x.shape
    h = x
    for l in range(DEPTH):
        n = rmsnorm(h, norm_mix[l])
        proj = n @ w_in[l]
        a_qkv, b_q, b_kv, b_gate, m_gate = jnp.split(proj, SPLITS, axis=-1)
        y_a = dilated_attention(a_qkv.reshape(B, T, 3, A_GROUPS, A_HEADS, A_HD))
        y_b = nsa_attention(b_q.reshape(B, T, B_HEADS, B_HD),
                            b_kv.reshape(B, T, 3, 2, B_KV, B_HD),
                            jax.nn.sigmoid(b_gate.reshape(B, T, B_HEADS, 3)),
                            w_cmp_k1[l], w_cmp_k2[l], pe_cmp_k[l], w_cmp_v1[l], w_cmp_v2[l], pe_cmp_v[l])
        gates = jax.nn.sigmoid(m_gate.reshape(B, T, N_BRANCH, D))
        mix = gates[:, :, 0] * (y_a @ w_up_a[l]) + gates[:, :, 1] * (y_b @ w_up_b[l])
        h = h + mix @ w_out[l]
        h = h + memory_cross_attention(rmsnorm(h, norm_x[l]), rmsnorm(mem, norm_mem[l]), w_xq[l], w_xkv[l], w_xo[l])
        h = h + peer(rmsnorm(h, norm_ffn[l]), w_pq[l], sub_keys1[l], sub_keys2[l], expert_u[l], expert_v[l])
    return rmsnorm(h, norm_final).astype(x.dtype)
```

```cpp
#include <hip/hip_runtime.h>
#include <hip/hip_cooperative_groups.h>
#include <cstdio>
#include <cstdint>
namespace cg = cooperative_groups;

#ifndef ONE_LAUNCH
#define ONE_LAUNCH 1
#endif

namespace pg8 {
#define PG8_LAS __attribute__((address_space(3)))
typedef unsigned short bf16_t;
typedef short bf16x8 __attribute__((ext_vector_type(8)));
typedef float f32x4 __attribute__((ext_vector_type(4)));
typedef unsigned u32x4 __attribute__((ext_vector_type(4)));
constexpr int BM = 256, BK = 64, HALF = 128, HTB = HALF * BK * 2  , STAGE_BYTES = 8 * HTB, NXCD = 8, WGM = 8;

__host__ __device__ __forceinline__ int lds_byte(int r, int c) { const int st = (r >> 4) * 2 + (c >> 5), rr = r & 15, cc = c & 31, ob = rr * 64 + cc * 2; return st * 1024 + (ob ^ (((ob >> 9) & 1) << 5)); }
__host__ __device__ __forceinline__ void stage_rc(int b, int& R, int& C) { const int st = b / 1024, sb = b % 1024, swz = sb ^ (((sb >> 9) & 1) << 5); R = (st >> 1) * 16 + swz / 64; C = (st & 1) * 32 + (swz % 64) / 2; }
__host__ __device__ __forceinline__ int perm32(int rho) { const int n = rho >> 4, i = rho & 15; return 8 * (i >> 2) + 4 * n + (i & 3); }

struct Unit { int pm, pn; };
struct Gemm { const bf16_t* A; const bf16_t* Bt; int M, N, K; };

struct StaticOrder {
    int nM, nN, nwg, G, c;
    __host__ __device__ void init(int M, int N, int G_, int c_) { nM = M / BM; nN = N / BM; nwg = nM * nN; G = G_; c = c_; }
    __host__ __device__ bool next(int i, Unit& u) const {
        const long L = (long)i * G + c; if (L >= nwg) return false;
        int wgid = (int)L; { const int q = nwg / NXCD, r = nwg % NXCD, xcd = wgid % NXCD, off = wgid / NXCD; wgid = (xcd < r ? xcd * (q + 1) : r * (q + 1) + (xcd - r) * q) + off; }
        const int nig = WGM * nN, gid = wgid / nig, fm = gid * WGM, gsz = (nM - fm) < WGM ? (nM - fm) : WGM;
        u.pm = fm + ((wgid % nig) % gsz); u.pn = (wgid % nig) / gsz; return true;
    }
    __device__ __forceinline__ void a_ready(const Unit&) const {}
    __device__ __forceinline__ void done(const Unit&) const {}
};

__device__ __forceinline__ unsigned cvt_pk_bf16(float lo, float hi) { typedef float f2_t __attribute__((ext_vector_type(2))); typedef __bf16 b2_t __attribute__((ext_vector_type(2)));
    f2_t v = {lo, hi}; b2_t b = __builtin_convertvector(v, b2_t); return __builtin_bit_cast(unsigned, b); }
template <class Epi, class Sched, bool ALIGN_EPI = false, bool SP2 = false>
__device__ __forceinline__ void gemm_phase(PG8_LAS unsigned char* lds, const Gemm g, const Sched& S, const Epi& E) {
    const int tid = threadIdx.x, wid = __builtin_amdgcn_readfirstlane(tid >> 6), lane = tid & 63, wr = wid >> 2, wc = wid & 3, fr = lane & 15, fq = lane >> 4;
    const int K = g.K, nt = K / BK;
    unsigned voffA[2], voffB[2];
#pragma unroll
    for (int i = 0; i < 2; ++i) { int R, C; stage_rc(tid * 16 + i * 8192, R, C); const int Rb = Epi::PERM ? ((R & ~31) + perm32(R & 31)) : R;
        voffA[i] = (unsigned)(R * K + C) * 2u; voffB[i] = (unsigned)(Rb * K + C) * 2u; }
    const size_t kstep = (size_t)(BK * 2);
    const size_t hstep = (size_t)HALF * K * 2;
    const size_t tstep = 2 * hstep;
    const unsigned ldsw = (unsigned)wid * 1024u;
    const int aoff = lds_byte(wr * 64 + fr, fq * 8), boff = lds_byte(wc * 32 + fr, fq * 8);
#define PG8_SA(b, h) (((b) * 2 + (h)) * HTB)
#define PG8_SB(b, h) ((4 + (b) * 2 + (h)) * HTB)
#define PG8_STAGE(bufoff, gbase, voff) do { _Pragma("unroll") for (int _i = 0; _i < 2; ++_i) \
        __builtin_amdgcn_global_load_lds((const unsigned*)((const char*)(gbase) + (voff)[_i]), (PG8_LAS unsigned*)(lds + (bufoff) + ldsw + _i * 8192), 16, 0, 0); } while (0)
#define PG8_LDA(dst, b, h) do { _Pragma("unroll") for (int m = 0; m < 4; ++m) _Pragma("unroll") for (int k = 0; k < 2; ++k) dst[m][k] = *(const PG8_LAS bf16x8*)(lds + PG8_SA(b, h) + aoff + m * 2048 + k * 1024); } while (0)
#define PG8_LDB(dst, b, h) do { _Pragma("unroll") for (int n = 0; n < 2; ++n) _Pragma("unroll") for (int k = 0; k < 2; ++k) dst[n][k] = *(const PG8_LAS bf16x8*)(lds + PG8_SB(b, h) + boff + n * 2048 + k * 1024); } while (0)
#define PG8_MMA(ai, bj, At, Bt) do { __builtin_amdgcn_s_setprio(1); _Pragma("unroll") for (int m = 0; m < 4; ++m) _Pragma("unroll") for (int n = 0; n < 2; ++n) _Pragma("unroll") for (int k = 0; k < 2; ++k) \
        acc[ai][bj][m][n] = __builtin_amdgcn_mfma_f32_16x16x32_bf16(Bt[n][k], At[m][k], acc[ai][bj][m][n], 0, 0, 0); __builtin_amdgcn_s_setprio(0); } while (0)
#define PG8_WAIT_V(n) asm volatile("s_waitcnt vmcnt(" #n ")" ::: "memory")
#define PG8_WAIT_L(n) asm volatile("s_waitcnt lgkmcnt(" #n ")" ::: "memory")
#define PG8_BAR __builtin_amdgcn_s_barrier()
#define PG8_SCHED __builtin_amdgcn_sched_barrier(0)
    Unit cur, nxt; int ui = 0;
    if (!S.next(0, cur)) return;
    f32x4 acc[2][2][4][2];
#pragma unroll
    for (int a = 0; a < 2; ++a)
#pragma unroll
        for (int b = 0; b < 2; ++b)
#pragma unroll
            for (int m = 0; m < 4; ++m)
#pragma unroll
                for (int n = 0; n < 2; ++n) acc[a][b][m][n] = (f32x4){0.f, 0.f, 0.f, 0.f};
    bf16x8 At[4][2], B0[2][2], B1[2][2];
    const char* cA = (const char*)g.A + (size_t)cur.pm * tstep; const char* cB = (const char*)g.Bt + (size_t)cur.pn * tstep;
    S.a_ready(cur);
    if constexpr (SP2) {
        PG8_STAGE(PG8_SB(0, 0), cB, voffB); PG8_STAGE(PG8_SB(0, 1), cB + hstep, voffB); PG8_STAGE(PG8_SA(0, 0), cA, voffA); PG8_STAGE(PG8_SA(0, 1), cA + hstep, voffA);
        if (wr == 1) PG8_BAR;
        PG8_WAIT_V(2); PG8_BAR;
        PG8_STAGE(PG8_SB(1, 0), cB + kstep, voffB); PG8_STAGE(PG8_SA(1, 0), cA + kstep, voffA); PG8_STAGE(PG8_SB(1, 1), cB + hstep + kstep, voffB);
        PG8_WAIT_V(6); PG8_BAR;
    } else {
        PG8_STAGE(PG8_SB(0, 0), cB, voffB); PG8_STAGE(PG8_SA(0, 0), cA, voffA); PG8_STAGE(PG8_SB(0, 1), cB + hstep, voffB); PG8_STAGE(PG8_SA(0, 1), cA + hstep, voffA);
        if (wr == 1) PG8_BAR;
        PG8_WAIT_V(4); PG8_BAR;
        PG8_STAGE(PG8_SB(1, 0), cB + kstep, voffB); PG8_STAGE(PG8_SA(1, 0), cA + kstep, voffA); PG8_STAGE(PG8_SB(1, 1), cB + hstep + kstep, voffB);
        PG8_WAIT_V(6); PG8_BAR;
    }
    for (;;) {
        const bool has_next = S.next(ui + 1, nxt);
        const char* nA = has_next ? (const char*)g.A + (size_t)nxt.pm * tstep : cA; const char* nB = has_next ? (const char*)g.Bt + (size_t)nxt.pn * tstep : cB;
        for (int t = 0; t < nt; t += 2) {
            const bool last = (t == nt - 2);
            const char* a1 = cA + (size_t)(t + 1) * kstep;
            const char* a2 = last ? nA : cA + (size_t)(t + 2) * kstep; const char* b2 = last ? nB : cB + (size_t)(t + 2) * kstep;
            const char* a3 = a2 + kstep; const char* b3 = b2 + kstep;
            if (last && has_next) S.a_ready(nxt);
            if constexpr (SP2) {
            PG8_LDB(B0, 0, 0); PG8_LDB(B1, 0, 1); PG8_SCHED; PG8_LDA(At, 0, 0); PG8_STAGE(PG8_SA(1, 1), a1 + hstep, voffA);
            PG8_WAIT_V(8); PG8_WAIT_L(0); PG8_BAR; PG8_MMA(0, 0, At, B0); PG8_MMA(0, 1, At, B1); PG8_BAR; PG8_SCHED;
            PG8_LDA(At, 0, 1); PG8_STAGE(PG8_SB(0, 0), b2, voffB); PG8_STAGE(PG8_SB(0, 1), b2 + hstep, voffB); PG8_STAGE(PG8_SA(0, 0), a2, voffA);
            PG8_WAIT_V(8); PG8_WAIT_L(0); PG8_BAR; PG8_MMA(1, 0, At, B0); PG8_MMA(1, 1, At, B1); PG8_BAR; PG8_SCHED;
            PG8_LDB(B0, 1, 0); PG8_LDB(B1, 1, 1); PG8_SCHED; PG8_LDA(At, 1, 0); PG8_STAGE(PG8_SA(0, 1), a2 + hstep, voffA);
            PG8_WAIT_V(8); PG8_WAIT_L(0); PG8_BAR; PG8_MMA(0, 0, At, B0); PG8_MMA(0, 1, At, B1); PG8_BAR; PG8_SCHED;
            PG8_LDA(At, 1, 1); PG8_STAGE(PG8_SB(1, 0), b3, voffB); PG8_STAGE(PG8_SB(1, 1), b3 + hstep, voffB); PG8_STAGE(PG8_SA(1, 0), a3, voffA);
            PG8_WAIT_V(8); PG8_WAIT_L(0); PG8_BAR; PG8_MMA(1, 0, At, B0); PG8_MMA(1, 1, At, B1); PG8_BAR; PG8_SCHED;
            } else {
            PG8_LDB(B0, 0, 0); PG8_SCHED; PG8_LDA(At, 0, 0); PG8_STAGE(PG8_SA(1, 1), a1 + hstep, voffA);
            PG8_WAIT_L(8); PG8_BAR; PG8_WAIT_L(0); PG8_MMA(0, 0, At, B0); PG8_BAR; PG8_SCHED;
            PG8_LDB(B1, 0, 1); PG8_STAGE(PG8_SB(0, 0), b2, voffB);
            PG8_BAR; PG8_WAIT_L(0); PG8_MMA(0, 1, At, B1); PG8_BAR;
            PG8_LDA(At, 0, 1); PG8_STAGE(PG8_SA(0, 0), a2, voffA);
            PG8_BAR; PG8_WAIT_L(0); PG8_MMA(1, 0, At, B0); PG8_BAR; PG8_SCHED;
            PG8_STAGE(PG8_SB(0, 1), b2 + hstep, voffB);
            PG8_WAIT_V(6); PG8_BAR; PG8_MMA(1, 1, At, B1); PG8_BAR;
            PG8_LDB(B0, 1, 0); PG8_SCHED; PG8_LDA(At, 1, 0); PG8_STAGE(PG8_SA(0, 1), a2 + hstep, voffA);
            PG8_WAIT_L(8); PG8_BAR; PG8_WAIT_L(0); PG8_MMA(0, 0, At, B0); PG8_BAR; PG8_SCHED;
            PG8_LDB(B1, 1, 1); PG8_STAGE(PG8_SB(1, 0), b3, voffB);
            PG8_BAR; PG8_WAIT_L(0); PG8_MMA(0, 1, At, B1); PG8_BAR;
            PG8_LDA(At, 1, 1); PG8_STAGE(PG8_SA(1, 0), a3, voffA);
            PG8_BAR; PG8_WAIT_L(0); PG8_MMA(1, 0, At, B0); PG8_BAR; PG8_SCHED;
            PG8_STAGE(PG8_SB(1, 1), b3 + hstep, voffB);
            PG8_WAIT_V(6); PG8_BAR; PG8_MMA(1, 1, At, B1); PG8_BAR;
            }
        }
        if constexpr (ALIGN_EPI) { if (wr == 0) PG8_BAR; }
        if constexpr (!Epi::AFTER_DRAIN) { E(acc, cur, wr, wc, fr, fq); S.done(cur); }
        if (!has_next) break;
#pragma unroll
        for (int a = 0; a < 2; ++a)
#pragma unroll
            for (int b = 0; b < 2; ++b)
#pragma unroll
                for (int m = 0; m < 4; ++m)
#pragma unroll
                    for (int n = 0; n < 2; ++n) acc[a][b][m][n] = (f32x4){0.f, 0.f, 0.f, 0.f};
        cur = nxt; cA = nA; cB = nB; ++ui;
        if constexpr (ALIGN_EPI) { if (wr == 1) PG8_BAR; }
    }
    PG8_WAIT_V(0);
    if constexpr (!ALIGN_EPI) { if (wr == 0) PG8_BAR; }
    PG8_BAR;
    if constexpr (Epi::AFTER_DRAIN) { E.fused(acc, cur, wr, wc, fr, fq, lds, wid, lane); S.done(cur); }
#undef PG8_SA
#undef PG8_SB
#undef PG8_STAGE
#undef PG8_LDA
#undef PG8_LDB
#undef PG8_MMA
#undef PG8_WAIT_V
#undef PG8_WAIT_L
#undef PG8_BAR
#undef PG8_SCHED
}
}
#define LAS __attribute__((address_space(3)))
#define DI __device__ __forceinline__
typedef unsigned short bf16;
typedef short bf16x8 __attribute__((ext_vector_type(8)));
typedef short s16x4 __attribute__((ext_vector_type(4)));
typedef float f32x4 __attribute__((ext_vector_type(4)));
typedef float f32x16 __attribute__((ext_vector_type(16)));
typedef unsigned u32x2 __attribute__((ext_vector_type(2)));
typedef unsigned u32x4 __attribute__((ext_vector_type(4)));
using pg8::cvt_pk_bf16;
#define MFMA32(a, b, c) __builtin_amdgcn_mfma_f32_32x32x16_bf16((a), (b), (c), 0, 0, 0)

constexpr int T = 8192, DM = 2048, NWAVES = 8;
constexpr int NIN = 10544, NINP = 10752;
constexpr float LOG2E = 1.4426950408889634f, LN2 = 0.6931471805599453f, NEGBIG = -1e30f, EPS = 1e-6f;

constexpr size_t MiB = 1u << 20;
constexpr size_t WS_SUMSQ1 = 0, WS_SUMSQ2 = 32768, CTL_ZERO_BYTES = 65536;
constexpr size_t WS_WCK1T = 1 * MiB, WS_WCV1T = 1 * MiB + 512 * 1024, WS_WCK2T = 2 * MiB, WS_WCV2T = 2 * MiB + 16384, WS_SK1 = 2 * MiB + 32768, WS_SK2 = 2 * MiB + 65536,
                 WS_PEBK = 2 * MiB + 98304, WS_PEBV = 2 * MiB + 98304 + 512, WS_KX = 3 * MiB, WS_VXT = 3 * MiB + 262144, WS_KC = 3 * MiB + 524288, WS_VCT = 3 * MiB + 524288 + 131072,
                 WS_LSE = 4 * MiB, WS_GINV = 5 * MiB, WS_MN = 6 * MiB;
constexpr size_t WS_WIN = 8 * MiB, WS_WUPA = 50 * MiB, WS_WUPB = 52 * MiB, WS_WOUT = 56 * MiB, WS_WXQ = 64 * MiB, WS_WXKV = 66 * MiB, WS_WXO = 70 * MiB, WS_WPQ = 72 * MiB;
constexpr size_t WS_EU = 80 * MiB, WS_EV = 144 * MiB;
constexpr size_t WS_N = 208 * MiB, WS_MIXTMP = 208 * MiB, WS_AQ = 240 * MiB, WS_AK = 264 * MiB, WS_AVT = 288 * MiB, WS_BQ = 312 * MiB;
constexpr size_t WS_KCS = 328 * MiB, WS_VCS = 330 * MiB, WS_KS = 332 * MiB, WS_VST = 334 * MiB, WS_KW = 336 * MiB, WS_VWT = 338 * MiB, WS_BG = 340 * MiB, WS_MG = 342 * MiB;
constexpr size_t WS_OA = 406 * MiB, WS_YA = 431 * MiB, WS_YB = 439 * MiB, WS_MIX = 455 * MiB, WS_END = 487 * MiB;
constexpr size_t WS_H1G = 240 * MiB, WS_QX = 272 * MiB, WS_OX = 280 * MiB, WS_H2G = 288 * MiB, WS_PQ = 320 * MiB, WS_EID = 352 * MiB, WS_GW = 356 * MiB;
constexpr int LDS_BYTES = 147456;

struct Args { const float* in[25]; float* out; unsigned char* ws; int ph_lo, ph_hi; };

DI float bflo(unsigned w) { return __uint_as_float(w << 16); }
DI float bfhi(unsigned w) { return __uint_as_float(w & 0xffff0000u); }
DI float bf2f(bf16 b) { return __uint_as_float(((unsigned)b) << 16); }
DI bf16 f2bf(float f) { return (bf16)(cvt_pk_bf16(f, 0.f) & 0xffffu); }
DI float fexp2(float x) { return __builtin_amdgcn_exp2f(x); }
DI float sigm(float x) { return 1.f / (1.f + __expf(-x)); }
DI float gelu_tanh(float x) { const float u = 0.7978845608028654f * (x + 0.044715f * x * x * x); return x / (1.f + __expf(-2.f * u)); }
DI int crow(int r, int h) { return (r & 3) + 8 * (r >> 2) + 4 * h; }
DI float wave_sum(float v) {
#pragma unroll
    for (int o = 1; o < 64; o <<= 1) v += __shfl_xor(v, o);
    return v;
}
DI u32x4 pack8(const f32x4& a, const f32x4& b) { u32x4 w; w.x = cvt_pk_bf16(a[0], a[1]); w.y = cvt_pk_bf16(a[2], a[3]); w.z = cvt_pk_bf16(b[0], b[1]); w.w = cvt_pk_bf16(b[2], b[3]); return w; }
DI bf16x8 pack8f(const float* p) { u32x4 w; w.x = cvt_pk_bf16(p[0], p[1]); w.y = cvt_pk_bf16(p[2], p[3]); w.z = cvt_pk_bf16(p[4], p[5]); w.w = cvt_pk_bf16(p[6], p[7]); return __builtin_bit_cast(bf16x8, w); }
DI bf16x8 cat4(s16x4 a, s16x4 b) { return (bf16x8){a[0], a[1], a[2], a[3], b[0], b[1], b[2], b[3]}; }

struct EpiProj {
    static constexpr bool PERM = true, AFTER_DRAIN = false;
    unsigned char* ws;
    DI void operator()(const f32x4 (&acc)[2][2][4][2], const pg8::Unit& u, int wr, int wc, int fr, int fq) const {
#pragma unroll
        for (int bj = 0; bj < 2; ++bj) {
            const int c8 = u.pn * 256 + bj * 128 + wc * 32 + 8 * fq;
            if (c8 >= NIN) continue;
            const int r0 = u.pm * 256 + wr * 64 + fr;
            if (c8 < 4608) {
                const int qkv = c8 / 1536, rem = c8 % 1536, g = rem / 512, hh = (rem % 512) / 128, d = rem % 128, ld = 2 * g, dm1 = (1 << ld) - 1;
                if (qkv < 2) {
                    bf16* base = (bf16*)(ws + (qkv == 0 ? WS_AQ : WS_AK)) + (size_t)(g * 4 + hh) * T * 128 + d;
#pragma unroll
                    for (int ai = 0; ai < 2; ++ai)
#pragma unroll
                        for (int m = 0; m < 4; ++m) { const int t = r0 + ai * 128 + m * 16, tp = ((t & dm1) << (13 - ld)) + (t >> ld);
                            *(u32x4*)(base + (size_t)tp * 128) = pack8(acc[ai][bj][m][0], acc[ai][bj][m][1]); }
                } else {
                    bf16* base = (bf16*)(ws + WS_AVT) + (size_t)((g * 4 + hh) * 128 + d) * T;
#pragma unroll
                    for (int ai = 0; ai < 2; ++ai)
#pragma unroll
                        for (int m = 0; m < 4; ++m) { const int t = r0 + ai * 128 + m * 16, tp = ((t & dm1) << (13 - ld)) + (t >> ld);
#pragma unroll
                            for (int e = 0; e < 8; ++e) base[(size_t)e * T + tp] = f2bf(acc[ai][bj][m][e >> 2][e & 3]); }
                }
            } else if (c8 < 5632) {
                bf16* base = (bf16*)(ws + WS_BQ) + (c8 - 4608);
#pragma unroll
                for (int ai = 0; ai < 2; ++ai)
#pragma unroll
                    for (int m = 0; m < 4; ++m) { const int t = r0 + ai * 128 + m * 16; *(u32x4*)(base + (size_t)t * 1024) = pack8(acc[ai][bj][m][0], acc[ai][bj][m][1]); }
            } else if (c8 < 6400) {
                const int c = c8 - 5632, br = c / 256, kv = (c % 256) / 128, G = (c % 128) / 64, d = c % 64;
                if (kv == 0 || br == 0) {
                    const size_t off = kv == 0 ? (br == 0 ? WS_KCS : br == 1 ? WS_KS : WS_KW) : WS_VCS;
                    bf16* base = (bf16*)(ws + off) + (size_t)G * T * 64 + d;
#pragma unroll
                    for (int ai = 0; ai < 2; ++ai)
#pragma unroll
                        for (int m = 0; m < 4; ++m) { const int t = r0 + ai * 128 + m * 16; *(u32x4*)(base + (size_t)t * 64) = pack8(acc[ai][bj][m][0], acc[ai][bj][m][1]); }
                } else {
                    bf16* base = (bf16*)(ws + (br == 1 ? WS_VST : WS_VWT)) + (size_t)(G * 64 + d) * T;
#pragma unroll
                    for (int ai = 0; ai < 2; ++ai)
#pragma unroll
                        for (int m = 0; m < 4; ++m) { const int t = r0 + ai * 128 + m * 16;
#pragma unroll
                            for (int e = 0; e < 8; ++e) base[(size_t)e * T + t] = f2bf(acc[ai][bj][m][e >> 2][e & 3]); }
                }
            } else if (c8 < 10496) {
                bf16* base = (bf16*)(ws + WS_MG) + (c8 - 6400);
#pragma unroll
                for (int ai = 0; ai < 2; ++ai)
#pragma unroll
                    for (int m = 0; m < 4; ++m) { const int t = r0 + ai * 128 + m * 16; f32x4 a = acc[ai][bj][m][0], b = acc[ai][bj][m][1];
#pragma unroll
                        for (int e = 0; e < 4; ++e) { a[e] = sigm(a[e]); b[e] = sigm(b[e]); }
                        *(u32x4*)(base + (size_t)t * 4096) = pack8(a, b); }
            } else {
                float* base = (float*)(ws + WS_BG) + (c8 - 10496);
#pragma unroll
                for (int ai = 0; ai < 2; ++ai)
#pragma unroll
                    for (int m = 0; m < 4; ++m) { const int t = r0 + ai * 128 + m * 16; f32x4 a = acc[ai][bj][m][0], b = acc[ai][bj][m][1];
#pragma unroll
                        for (int e = 0; e < 4; ++e) { a[e] = sigm(a[e]); b[e] = sigm(b[e]); }
                        *(f32x4*)(base + (size_t)t * 48) = a; *(f32x4*)(base + (size_t)t * 48 + 4) = b; }
            }
        }
    }
};
struct EpiKvx {
    static constexpr bool PERM = true, AFTER_DRAIN = false;
    unsigned char* ws;
    DI void operator()(const f32x4 (&acc)[2][2][4][2], const pg8::Unit& u, int wr, int wc, int fr, int fq) const {
#pragma unroll
        for (int bj = 0; bj < 2; ++bj) {
            const int c8 = u.pn * 256 + bj * 128 + wc * 32 + 8 * fq, kvi = c8 / 512, hx = (c8 % 512) / 128, d = c8 % 128, r0 = wr * 64 + fr;
#pragma unroll
            for (int ai = 0; ai < 2; ++ai)
#pragma unroll
                for (int m = 0; m < 4; ++m) { const int row = r0 + ai * 128 + m * 16;
                    if (kvi == 0) *(u32x4*)((bf16*)(ws + WS_KX) + (size_t)(hx * 256 + row) * 128 + d) = pack8(acc[ai][bj][m][0], acc[ai][bj][m][1]);
                    else {
#pragma unroll
                        for (int e = 0; e < 8; ++e) ((bf16*)(ws + WS_VXT))[(size_t)(hx * 128 + d + e) * 256 + row] = f2bf(acc[ai][bj][m][e >> 2][e & 3]); } }
        }
    }
};
template <int SECOND> struct EpiMix {
    static constexpr bool PERM = true, AFTER_DRAIN = false;
    unsigned char* ws;
    DI void operator()(const f32x4 (&acc)[2][2][4][2], const pg8::Unit& u, int wr, int wc, int fr, int fq) const {
#pragma unroll
        for (int bj = 0; bj < 2; ++bj) {
            const int c8 = u.pn * 256 + bj * 128 + wc * 32 + 8 * fq, r0 = u.pm * 256 + wr * 64 + fr;
#pragma unroll
            for (int ai = 0; ai < 2; ++ai)
#pragma unroll
                for (int m = 0; m < 4; ++m) { const int t = r0 + ai * 128 + m * 16;
                    const u32x4 gt = *(const u32x4*)((const bf16*)(ws + WS_MG) + (size_t)t * 4096 + SECOND * 2048 + c8);
                    f32x4 a = acc[ai][bj][m][0], b = acc[ai][bj][m][1];
                    a[0] *= bflo(gt.x); a[1] *= bfhi(gt.x); a[2] *= bflo(gt.y); a[3] *= bfhi(gt.y); b[0] *= bflo(gt.z); b[1] *= bfhi(gt.z); b[2] *= bflo(gt.w); b[3] *= bfhi(gt.w);
                    if (SECOND) { const u32x4 p = *(const u32x4*)((const bf16*)(ws + WS_MIXTMP) + (size_t)t * 2048 + c8);
                        a[0] += bflo(p.x); a[1] += bfhi(p.x); a[2] += bflo(p.y); a[3] += bfhi(p.y); b[0] += bflo(p.z); b[1] += bfhi(p.z); b[2] += bflo(p.w); b[3] += bfhi(p.w); }
                    *(u32x4*)((bf16*)(ws + (SECOND ? WS_MIX : WS_MIXTMP)) + (size_t)t * 2048 + c8) = pack8(a, b); }
        }
    }
};
struct EpiRes {
    static constexpr bool PERM = false, AFTER_DRAIN = false;
    const float* base; float* out; bf16* hg; const float* gain; float* sumsq;
    DI void operator()(const f32x4 (&acc)[2][2][4][2], const pg8::Unit& u, int wr, int wc, int fr, int fq) const {
        const int r0 = u.pm * 256 + wr * 64 + fr, c0 = u.pn * 256 + wc * 32 + 4 * fq;
#pragma unroll
        for (int ai = 0; ai < 2; ++ai)
#pragma unroll
            for (int m = 0; m < 4; ++m) { const int t = r0 + ai * 128 + m * 16; float ss = 0.f;
#pragma unroll
                for (int bj = 0; bj < 2; ++bj)
#pragma unroll
                    for (int n = 0; n < 2; ++n) { const int c = c0 + bj * 128 + 16 * n; const size_t off = (size_t)t * DM + c;
                        const f32x4 h = *(const f32x4*)(base + off) + acc[ai][bj][m][n]; const f32x4 g = *(const f32x4*)(gain + c);
                        *(f32x4*)(out + off) = h; ss += (h[0] * h[0] + h[1] * h[1]) + (h[2] * h[2] + h[3] * h[3]);
                        u32x2 w; w.x = cvt_pk_bf16(h[0] * g[0], h[1] * g[1]); w.y = cvt_pk_bf16(h[2] * g[2], h[3] * g[3]); *(u32x2*)(hg + off) = w; }
                ss += __shfl_xor(ss, 16); ss += __shfl_xor(ss, 32);
                if (fq == 0) atomicAdd(sumsq + t, ss); }
    }
};
struct EpiScaleRow {
    static constexpr bool PERM = true, AFTER_DRAIN = false;
    bf16* O; int ldc; const float* sumsq;
    DI void operator()(const f32x4 (&acc)[2][2][4][2], const pg8::Unit& u, int wr, int wc, int fr, int fq) const {
        const int r0 = u.pm * 256 + wr * 64 + fr;
#pragma unroll
        for (int ai = 0; ai < 2; ++ai)
#pragma unroll
            for (int m = 0; m < 4; ++m) { const int t = r0 + ai * 128 + m * 16; const float rs = __builtin_amdgcn_rsqf(sumsq[t] * (1.f / DM) + EPS);
#pragma unroll
                for (int bj = 0; bj < 2; ++bj) { const int c8 = u.pn * 256 + bj * 128 + wc * 32 + 8 * fq;
                    *(u32x4*)(O + (size_t)t * ldc + c8) = pack8(acc[ai][bj][m][0] * rs, acc[ai][bj][m][1] * rs); } }
    }
};
template <class RowMap>
DI void transpose_item(const float* W, int K, int N, bf16* WT, LAS float* scr, int item, int lane, RowMap rowmap) {
    const int nblk = (N + 31) / 32, kb = item / nblk, nb = item % nblk, k0 = 64 * kb, n0 = 32 * nb;
    const int nn = n0 + (lane & 31);
#pragma unroll 8
    for (int i = 0; i < 32; ++i) { const int kk = 2 * i + (lane >> 5); scr[kk * 33 + (lane & 31)] = nn < N ? W[(size_t)(k0 + kk) * N + nn] : 0.f; }
    asm volatile("s_waitcnt lgkmcnt(0)" ::: "memory");
    const int c = lane & 7;
#pragma unroll
    for (int j = 0; j < 4; ++j) { const int nl = (lane >> 3) + 8 * j, n = n0 + nl; const LAS float* s = scr + (8 * c) * 33 + nl;
        u32x4 o; o.x = cvt_pk_bf16(s[0 * 33], s[1 * 33]); o.y = cvt_pk_bf16(s[2 * 33], s[3 * 33]); o.z = cvt_pk_bf16(s[4 * 33], s[5 * 33]); o.w = cvt_pk_bf16(s[6 * 33], s[7 * 33]);
        if (n < N) *(u32x4*)(WT + (size_t)rowmap(n) * K + k0 + 8 * c) = o; }
    asm volatile("s_waitcnt lgkmcnt(0)" ::: "memory");
}
struct RowId { DI int operator()(int n) const { return n; } };
struct RowWin { DI int operator()(int n) const { return n < 6400 ? n : (n < 6448 ? n + 4096 : n - 48); } };

DI void rms_row_to_bf16(const float* xrow, const float* gain, bf16* orow, int lane) {
    f32x4 v[8]; float s = 0.f;
#pragma unroll
    for (int j = 0; j < 8; ++j) { v[j] = *(const f32x4*)(xrow + j * 256 + lane * 4); s += (v[j][0] * v[j][0] + v[j][1] * v[j][1]) + (v[j][2] * v[j][2] + v[j][3] * v[j][3]); }
    const float rs = __builtin_amdgcn_rsqf(wave_sum(s) * (1.f / DM) + EPS);
#pragma unroll
    for (int j = 0; j < 8; ++j) { const f32x4 g = *(const f32x4*)(gain + j * 256 + lane * 4); u32x2 w; w.x = cvt_pk_bf16(v[j][0] * rs * g[0], v[j][1] * rs * g[1]); w.y = cvt_pk_bf16(v[j][2] * rs * g[2], v[j][3] * rs * g[3]);
        *(u32x2*)(orow + j * 256 + lane * 4) = w; }
}
DI void phase_prologue(const Args& a, LAS unsigned char* lds, int gw, int NGW, int wave, int lane) {
    unsigned char* ws = a.ws;
    LAS float* scr = (LAS float*)(lds + wave * 16384);
    constexpr int I_WIN = 32 * 330, I_UPA = 8 * 64, I_UPB = 16 * 64, I_OUT = 32 * 64, I_XQ = 32 * 16, I_XKV = 32 * 32, I_XO = 8 * 64, I_PQ = 32 * 64, I_C1 = 32 * 4, I_C2 = 2 * 2;
    constexpr int NITEMS = I_WIN + I_UPA + I_UPB + I_OUT + I_XQ + I_XKV + I_XO + I_PQ + 2 * I_C1 + 2 * I_C2;
    for (int it = gw; it < NITEMS; it += NGW) {
        int r = it;
        if (r < I_WIN) { transpose_item(a.in[3], 2048, NIN, (bf16*)(ws + WS_WIN), scr, r, lane, RowWin()); continue; } r -= I_WIN;
        if (r < I_UPA) { transpose_item(a.in[10], 512, 2048, (bf16*)(ws + WS_WUPA), scr, r, lane, RowId()); continue; } r -= I_UPA;
        if (r < I_UPB) { transpose_item(a.in[11], 1024, 2048, (bf16*)(ws + WS_WUPB), scr, r, lane, RowId()); continue; } r -= I_UPB;
        if (r < I_OUT) { transpose_item(a.in[12], 2048, 2048, (bf16*)(ws + WS_WOUT), scr, r, lane, RowId()); continue; } r -= I_OUT;
        if (r < I_XQ) { transpose_item(a.in[15], 2048, 512, (bf16*)(ws + WS_WXQ), scr, r, lane, RowId()); continue; } r -= I_XQ;
        if (r < I_XKV) { transpose_item(a.in[16], 2048, 1024, (bf16*)(ws + WS_WXKV), scr, r, lane, RowId()); continue; } r -= I_XKV;
        if (r < I_XO) { transpose_item(a.in[17], 512, 2048, (bf16*)(ws + WS_WXO), scr, r, lane, RowId()); continue; } r -= I_XO;
        if (r < I_PQ) { transpose_item(a.in[19], 2048, 2048, (bf16*)(ws + WS_WPQ), scr, r, lane, RowId()); continue; } r -= I_PQ;
        if (r < I_C1) { transpose_item(a.in[4], 2048, 128, (bf16*)(ws + WS_WCK1T), scr, r, lane, RowId()); continue; } r -= I_C1;
        if (r < I_C1) { transpose_item(a.in[7], 2048, 128, (bf16*)(ws + WS_WCV1T), scr, r, lane, RowId()); continue; } r -= I_C1;
        if (r < I_C2) { transpose_item(a.in[5], 128, 64, (bf16*)(ws + WS_WCK2T), scr, r, lane, RowId()); continue; } r -= I_C2;
        transpose_item(a.in[8], 128, 64, (bf16*)(ws + WS_WCV2T), scr, r, lane, RowId());
    }
    { u32x4* p = (u32x4*)((bf16*)(ws + WS_WIN) + (size_t)NIN * 2048); const int n16 = (NINP - NIN) * 2048 / 8;
      for (int i = gw * 64 + lane; i < n16; i += NGW * 64) p[i] = (u32x4){0u, 0u, 0u, 0u}; }
    for (int m = gw; m < T + 256; m += NGW) {
        if (m < T) rms_row_to_bf16(a.in[0] + (size_t)m * DM, a.in[2], (bf16*)(ws + WS_N) + (size_t)m * DM, lane);
        else rms_row_to_bf16(a.in[1] + (size_t)(m - T) * DM, a.in[14], (bf16*)(ws + WS_MN) + (size_t)(m - T) * DM, lane);
    }
    {   const size_t n8 = (size_t)16384 * 2048 / 8, tid = (size_t)gw * 64 + lane, nth = (size_t)NGW * 64;
        for (int tb = 0; tb < 2; ++tb) { const f32x4* src = (const f32x4*)a.in[22 + tb]; u32x4* dst = (u32x4*)(ws + (tb ? WS_EV : WS_EU));
            for (size_t i = tid; i < n8; i += nth) { const f32x4 x0 = __builtin_nontemporal_load(src + 2 * i), x1 = __builtin_nontemporal_load(src + 2 * i + 1); dst[i] = pack8(x0, x1); } }
        for (int tb = 0; tb < 2; ++tb) { const f32x4* src = (const f32x4*)a.in[20 + tb]; u32x4* dst = (u32x4*)(ws + (tb ? WS_SK2 : WS_SK1));
            for (size_t i = tid; i < 128 * 128 / 8; i += nth) dst[i] = pack8(src[2 * i], src[2 * i + 1]); }
    }
    for (int o = gw; o < 256; o += NGW) { const int kv = o >> 7, j = o & 127; const float* pe = a.in[kv ? 9 : 6]; const float* w1 = a.in[kv ? 7 : 4]; float s = 0.f;
        for (int i = lane; i < 2048; i += 64) s += pe[i] * w1[(size_t)i * 128 + j];
        s = wave_sum(s); if (lane == 0) ((float*)(ws + (kv ? WS_PEBV : WS_PEBK)))[j] = s; }
}
template <int HD, class SF>
DI void attn_tile(const bf16x8 (&q)[HD / 16], const bf16* kptr, const bf16* vptr, size_t vs32, float& m, float& l, f32x16 (&o)[HD / 32], SF sf) {
    f32x16 s;
#pragma unroll
    for (int r = 0; r < 16; ++r) s[r] = 0.f;
#pragma unroll
    for (int ks = 0; ks < HD / 16; ++ks) s = MFMA32(*(const bf16x8*)(kptr + 16 * ks), q[ks], s);
    float v[16]; float tmax = NEGBIG;
#pragma unroll
    for (int r = 0; r < 16; ++r) { v[r] = sf(r, s[r]); tmax = fmaxf(tmax, v[r]); }
    tmax = fmaxf(tmax, __shfl_xor(tmax, 32));
    const float mn = fmaxf(m, tmax), alpha = fexp2(m - mn);
    float p[16]; float ps = 0.f;
#pragma unroll
    for (int r = 0; r < 16; ++r) { p[r] = v[r] > -1e29f ? fexp2(v[r] - mn) : 0.f; ps += p[r]; }
    ps += __shfl_xor(ps, 32);
    l = l * alpha + ps; m = mn;
    const bf16x8 pf0 = pack8f(p), pf1 = pack8f(p + 8);
#pragma unroll
    for (int dt = 0; dt < HD / 32; ++dt) {
        const bf16* vp = vptr + dt * vs32;
        const s16x4 a0 = *(const s16x4*)(vp), a1 = *(const s16x4*)(vp + 8), b0 = *(const s16x4*)(vp + 16), b1 = *(const s16x4*)(vp + 24);
        o[dt] = o[dt] * alpha;
        o[dt] = MFMA32(cat4(a0, a1), pf0, o[dt]);
        o[dt] = MFMA32(cat4(b0, b1), pf1, o[dt]);
    }
}
template <int NT>
DI void store_ot(bf16* orow, const f32x16 (&o)[NT], float scale, int h) {
#pragma unroll
    for (int dt = 0; dt < NT; ++dt)
#pragma unroll
        for (int rg = 0; rg < 4; ++rg) { u32x2 w; w.x = cvt_pk_bf16(o[dt][4 * rg] * scale, o[dt][4 * rg + 1] * scale); w.y = cvt_pk_bf16(o[dt][4 * rg + 2] * scale, o[dt][4 * rg + 3] * scale);
            *(u32x2*)(orow + 32 * dt + 8 * rg + 4 * h) = w; }
}

DI void dilated_item(unsigned char* ws, int item, int w, int lane) {
    const int g = item >> 8, rem = item & 255, hh = rem >> 6, nb = rem & 63, ld = 2 * g, dil = 1 << ld, nbk = 64 >> ld, n = nb / nbk, b = nb % nbk, L = T >> ld;
    const int i32 = lane & 31, h = lane >> 5, iq = 32 * w + i32, rowbase = n * L + 128 * b, gh = g * 4 + hh;
    const bf16* Q = (const bf16*)(ws + WS_AQ) + ((size_t)gh * T + rowbase + iq) * 128 + 8 * h;
    const bf16* K = (const bf16*)(ws + WS_AK) + ((long)gh * T + rowbase - 128 + i32) * 128 + 8 * h;
    const bf16* V = (const bf16*)(ws + WS_AVT) + ((long)gh * 128 + i32) * T + (rowbase - 128) + 4 * h;
    bf16x8 q[8];
#pragma unroll
    for (int ks = 0; ks < 8; ++ks) q[ks] = *(const bf16x8*)(Q + 16 * ks);
    const float slope = exp2f(-8.f * (float)(gh + 1) / 12.f), sl2 = slope * (float)dil * LOG2E, sc2 = 0.08838834764831845f * LOG2E;
    f32x16 o[4];
#pragma unroll
    for (int dt = 0; dt < 4; ++dt)
#pragma unroll
        for (int r = 0; r < 16; ++r) o[dt][r] = 0.f;
    float m = NEGBIG, l = 0.f;
#pragma unroll 1
    for (int tt = 0; tt < 5; ++tt) {
        const int j0 = 32 * w + 32 * tt;
        if (b == 0 && j0 < 128) continue;
        attn_tile<128>(q, K + (size_t)j0 * 128, V + j0, (size_t)32 * T, m, l, o, [&](int r, float raw) {
            const int rel = iq + 128 - (j0 + crow(r, h)); return (rel >= 0 && rel <= 128) ? raw * sc2 - sl2 * (float)rel : NEGBIG; });
    }
    const int t = (128 * b + iq) * dil + n;
    store_ot<4>((bf16*)(ws + WS_OA) + ((size_t)g * T + t) * 512 + hh * 128, o, 1.f / l, h);
    if (h == 0) ((float*)(ws + WS_LSE))[((size_t)g * T + t) * 4 + hh] = (m + __log2f(l)) * LN2;
}
DI void compress_item(unsigned char* ws, int item, int lane) {
    const int kv = item >> 5, G = (item >> 4) & 1, rt = item & 15, i32 = lane & 31, h = lane >> 5;
    const int c = rt * 32 + i32, cc = c < 511 ? c : 510;
    const bf16* A = (const bf16*)(ws + (kv ? WS_VCS : WS_KCS)) + (size_t)G * T * 64 + (size_t)cc * 1024 + 8 * h;
    const bf16* W1 = (const bf16*)(ws + (kv ? WS_WCV1T : WS_WCK1T)) + (size_t)i32 * 2048 + 8 * h;
    f32x16 hid[4];
#pragma unroll
    for (int jt = 0; jt < 4; ++jt)
#pragma unroll
        for (int r = 0; r < 16; ++r) hid[jt][r] = 0.f;
#pragma unroll 1
    for (int ks = 0; ks < 128; ++ks) {
        const bf16x8 af = *(const bf16x8*)(A + 16 * ks);
#pragma unroll
        for (int jt = 0; jt < 4; ++jt) hid[jt] = MFMA32(*(const bf16x8*)(W1 + (size_t)jt * 32 * 2048 + 16 * ks), af, hid[jt]);
    }
    const float* peb = (const float*)(ws + (kv ? WS_PEBV : WS_PEBK));
    bf16x8 pf[4][2];
#pragma unroll
    for (int jt = 0; jt < 4; ++jt) { float gl[16];
#pragma unroll
        for (int r = 0; r < 16; ++r) gl[r] = gelu_tanh(hid[jt][r] + peb[jt * 32 + crow(r, h)]);
        pf[jt][0] = pack8f(gl); pf[jt][1] = pack8f(gl + 8); }
    const bf16* W2 = (const bf16*)(ws + (kv ? WS_WCV2T : WS_WCK2T)) + (size_t)i32 * 128 + 4 * h;
    f32x16 o[2];
#pragma unroll
    for (int dt = 0; dt < 2; ++dt) {
#pragma unroll
        for (int r = 0; r < 16; ++r) o[dt][r] = 0.f;
#pragma unroll
        for (int jt = 0; jt < 4; ++jt) { const bf16* wp = W2 + (size_t)dt * 32 * 128 + jt * 32;
            o[dt] = MFMA32(cat4(*(const s16x4*)(wp), *(const s16x4*)(wp + 8)), pf[jt][0], o[dt]);
            o[dt] = MFMA32(cat4(*(const s16x4*)(wp + 16), *(const s16x4*)(wp + 24)), pf[jt][1], o[dt]); }
    }
    const float keep = c < 511 ? 1.f : 0.f;
    if (kv == 0) store_ot<2>((bf16*)(ws + WS_KC) + ((size_t)G * 512 + c) * 64, o, keep, h);
    else {
        bf16* vt = (bf16*)(ws + WS_VCT) + (size_t)G * 64 * 512 + c;
#pragma unroll
        for (int dt = 0; dt < 2; ++dt)
#pragma unroll
            for (int r = 0; r < 16; ++r) vt[(size_t)(32 * dt + crow(r, h)) * 512] = f2bf(o[dt][r] * keep);
    }
}
DI void nsa_item(unsigned char* ws, int G, int chunk, LAS float* pc  , int lane) {
    const int i32 = lane & 31, h = lane >> 5, tok = i32 >> 3, hh = G * 8 + (i32 & 7), t0 = chunk * 4, t = t0 + tok;
    const float slope = exp2f(-0.5f * (float)(hh + 1)), sl2 = slope * LOG2E, sc2 = 0.125f * LOG2E;
    bf16x8 q[4];
    { const bf16* Q = (const bf16*)(ws + WS_BQ) + (size_t)t * 1024 + hh * 64 + 8 * h;
#pragma unroll
      for (int ks = 0; ks < 4; ++ks) q[ks] = *(const bf16x8*)(Q + 16 * ks); }
    const float* gate = (const float*)(ws + WS_BG) + (size_t)t * 48 + hh * 3;
    const float g_c = gate[0], g_s = gate[1], g_w = gate[2];
    f32x16 y[2], o[2];
#pragma unroll
    for (int dt = 0; dt < 2; ++dt)
#pragma unroll
        for (int r = 0; r < 16; ++r) { y[dt][r] = 0.f; o[dt][r] = 0.f; }
    const int cv = t >= 31 ? ((t - 31) >> 4) : -1;
    const int cmaxw = t0 + 3 >= 31 ? ((t0 + 3 - 31) >> 4) : -1;
    const int nct = cmaxw >= 0 ? (cmaxw >> 5) + 1 : 0;
    const bf16* KC = (const bf16*)(ws + WS_KC) + ((size_t)G * 512 + i32) * 64 + 8 * h;
    const bf16* VC = (const bf16*)(ws + WS_VCT) + ((size_t)G * 64 + i32) * 512 + 4 * h;
    float m = NEGBIG, l = 0.f;
    for (int ct = 0; ct < nct; ++ct) {
        f32x16 s;
#pragma unroll
        for (int r = 0; r < 16; ++r) s[r] = 0.f;
#pragma unroll
        for (int ks = 0; ks < 4; ++ks) s = MFMA32(*(const bf16x8*)(KC + (size_t)ct * 32 * 64 + 16 * ks), q[ks], s);
        float v[16]; float tmax = NEGBIG;
#pragma unroll
        for (int r = 0; r < 16; ++r) { const int c = ct * 32 + crow(r, h); v[r] = c <= cv ? s[r] * sc2 - sl2 * (float)(t - 16 * c - 31) : NEGBIG; tmax = fmaxf(tmax, v[r]); }
        tmax = fmaxf(tmax, __shfl_xor(tmax, 32));
        const float mn = fmaxf(m, tmax); float ps = 0.f;
#pragma unroll
        for (int r = 0; r < 16; ++r) ps += v[r] > -1e29f ? fexp2(v[r] - mn) : 0.f;
        ps += __shfl_xor(ps, 32);
        l = l * fexp2(m - mn) + ps; m = mn;
    }
    const float inv_c = l > 0.f ? 1.f / l : 0.f;
    for (int ct = 0; ct < nct; ++ct) {
        f32x16 s;
#pragma unroll
        for (int r = 0; r < 16; ++r) s[r] = 0.f;
#pragma unroll
        for (int ks = 0; ks < 4; ++ks) s = MFMA32(*(const bf16x8*)(KC + (size_t)ct * 32 * 64 + 16 * ks), q[ks], s);
        float p[16];
#pragma unroll
        for (int r = 0; r < 16; ++r) { const int c = ct * 32 + crow(r, h); p[r] = c <= cv ? fexp2(s[r] * sc2 - sl2 * (float)(t - 16 * c - 31) - m) * inv_c : 0.f; }
        const bf16x8 pf0 = pack8f(p), pf1 = pack8f(p + 8);
#pragma unroll
        for (int dt = 0; dt < 2; ++dt) { const bf16* vp = VC + (size_t)dt * 32 * 512 + ct * 32;
            o[dt] = MFMA32(cat4(*(const s16x4*)(vp), *(const s16x4*)(vp + 8)), pf0, o[dt]);
            o[dt] = MFMA32(cat4(*(const s16x4*)(vp + 16), *(const s16x4*)(vp + 24)), pf1, o[dt]); }
#pragma unroll
        for (int r = 0; r < 16; ++r) { float x = p[r]; x += __shfl_xor(x, 1); x += __shfl_xor(x, 2); x += __shfl_xor(x, 4);
            if ((i32 & 7) == 0) pc[tok * 512 + ct * 32 + crow(r, h)] = x; }
    }
#pragma unroll
    for (int dt = 0; dt < 2; ++dt)
#pragma unroll
        for (int r = 0; r < 16; ++r) { y[dt][r] = g_c * o[dt][r]; o[dt][r] = 0.f; }
    asm volatile("s_waitcnt lgkmcnt(0)" ::: "memory");
    unsigned msk[4] = {0u, 0u, 0u, 0u};
    {   const int ts = lane >> 4, l16 = lane & 15, tsel = t0 + ts, cur = tsel >> 6;
        float cand[8];
#pragma unroll
        for (int e = 0; e < 8; ++e) { const int j = l16 * 8 + e; const bool valid = j >= 1 && j <= cur - 2; const LAS float* pp = pc + ts * 512 + 4 * j;
            const int jm = valid ? -1 : 0;
            cand[e] = valid ? (pp[0] + pp[1]) + pp[2] + 0.5f * (pp[3] + pp[jm]) : -1.f; }
        msk[0] |= 1u;
#pragma unroll
        for (int w = 0; w < 4; ++w) { if ((cur >> 5) == w) msk[w] |= 1u << (cur & 31); if (cur >= 1 && ((cur - 1) >> 5) == w) msk[w] |= 1u << ((cur - 1) & 31); }
        for (int round = 0; round < 13; ++round) {
            float bv = -3.f; int bi = 1 << 20;
#pragma unroll
            for (int e = 0; e < 8; ++e) if (cand[e] > bv) { bv = cand[e]; bi = l16 * 8 + e; }
#pragma unroll
            for (int off = 1; off < 16; off <<= 1) { const float ov = __shfl_xor(bv, off); const int oi = __shfl_xor(bi, off); if (ov > bv || (ov == bv && oi < bi)) { bv = ov; bi = oi; } }
            if (bv >= 0.f) {
#pragma unroll
                for (int w = 0; w < 4; ++w) if ((bi >> 5) == w) msk[w] |= 1u << (bi & 31);
#pragma unroll
                for (int e = 0; e < 8; ++e) if (l16 * 8 + e == bi) cand[e] = -2.f;
            }
        }
    }
    unsigned mk[4], U[4];
#pragma unroll
    for (int w = 0; w < 4; ++w) { mk[w] = __shfl(msk[w], tok * 16);
        U[w] = __builtin_amdgcn_readlane(msk[w], 0) | __builtin_amdgcn_readlane(msk[w], 16) | __builtin_amdgcn_readlane(msk[w], 32) | __builtin_amdgcn_readlane(msk[w], 48); }
    const bf16* KS = (const bf16*)(ws + WS_KS) + ((size_t)G * T + i32) * 64 + 8 * h;
    const bf16* VS = (const bf16*)(ws + WS_VST) + ((size_t)G * 64 + i32) * T + 4 * h;
    m = NEGBIG; l = 0.f;
#pragma unroll
    for (int w = 0; w < 4; ++w) {
        unsigned bits = U[w];
        while (bits) {
            const int jb = __builtin_ctz(bits); bits &= bits - 1u;
            const bool mine = (mk[w] >> jb) & 1u;
            for (int half = 0; half < 2; ++half) {
                const int key0 = 64 * (w * 32 + jb) + 32 * half;
                if (key0 > t0 + 3) continue;
                attn_tile<64>(q, KS + (size_t)key0 * 64, VS + key0, (size_t)32 * T, m, l, o, [&](int r, float raw) {
                    const int pos = key0 + crow(r, h); return (mine && pos <= t) ? raw * sc2 - sl2 * (float)(t - pos) : NEGBIG; });
            }
        }
    }
    { const float sc = l > 0.f ? g_s / l : 0.f;
#pragma unroll
      for (int dt = 0; dt < 2; ++dt)
#pragma unroll
          for (int r = 0; r < 16; ++r) { y[dt][r] += sc * o[dt][r]; o[dt][r] = 0.f; } }
    const bf16* KW = (const bf16*)(ws + WS_KW) + ((size_t)G * T + i32) * 64 + 8 * h;
    const bf16* VW = (const bf16*)(ws + WS_VWT) + ((size_t)G * 64 + i32) * T + 4 * h;
    m = NEGBIG; l = 0.f;
    { const int lo = (t0 - 511 > 0 ? t0 - 511 : 0) & ~31;
      for (int key0 = lo; key0 <= t0 + 3; key0 += 32)
          attn_tile<64>(q, KW + (size_t)key0 * 64, VW + key0, (size_t)32 * T, m, l, o, [&](int r, float raw) {
              const int dd = t - (key0 + crow(r, h)); return (dd >= 0 && dd < 512) ? raw * sc2 - sl2 * (float)dd : NEGBIG; }); }
    { const float sc = l > 0.f ? g_w / l : 0.f;
#pragma unroll
      for (int dt = 0; dt < 2; ++dt)
#pragma unroll
          for (int r = 0; r < 16; ++r) y[dt][r] += sc * o[dt][r]; }
    store_ot<2>((bf16*)(ws + WS_YB) + (size_t)t * 1024 + hh * 64, y, 1.f, h);
}
DI void dilated_combine(unsigned char* ws, size_t tid, size_t nth) {
    const float* lse = (const float*)(ws + WS_LSE); const bf16* oa = (const bf16*)(ws + WS_OA); bf16* ya = (bf16*)(ws + WS_YA);
    for (size_t i = tid; i < (size_t)T * 64; i += nth) {
        const size_t t = i >> 6; const int c8 = (int)(i & 63) * 8, hh = c8 >> 7;
        const float l0 = lse[(0 * (size_t)T + t) * 4 + hh], l1 = lse[(1 * (size_t)T + t) * 4 + hh], l2 = lse[(2 * (size_t)T + t) * 4 + hh];
        const float mx = fmaxf(l0, fmaxf(l1, l2)), e0 = __expf(l0 - mx), e1 = __expf(l1 - mx), e2 = __expf(l2 - mx), inv = 1.f / (e0 + e1 + e2);
        const u32x4 a = *(const u32x4*)(oa + (0 * (size_t)T + t) * 512 + c8), b = *(const u32x4*)(oa + (1 * (size_t)T + t) * 512 + c8), c = *(const u32x4*)(oa + (2 * (size_t)T + t) * 512 + c8);
        const float w0 = e0 * inv, w1 = e1 * inv, w2 = e2 * inv; u32x4 r;
        r.x = cvt_pk_bf16(w0 * bflo(a.x) + w1 * bflo(b.x) + w2 * bflo(c.x), w0 * bfhi(a.x) + w1 * bfhi(b.x) + w2 * bfhi(c.x));
        r.y = cvt_pk_bf16(w0 * bflo(a.y) + w1 * bflo(b.y) + w2 * bflo(c.y), w0 * bfhi(a.y) + w1 * bfhi(b.y) + w2 * bfhi(c.y));
        r.z = cvt_pk_bf16(w0 * bflo(a.z) + w1 * bflo(b.z) + w2 * bflo(c.z), w0 * bfhi(a.z) + w1 * bfhi(b.z) + w2 * bfhi(c.z));
        r.w = cvt_pk_bf16(w0 * bflo(a.w) + w1 * bflo(b.w) + w2 * bflo(c.w), w0 * bfhi(a.w) + w1 * bfhi(b.w) + w2 * bfhi(c.w));
        *(u32x4*)(ya + t * 512 + c8) = r;
    }
}
DI void cross_item(unsigned char* ws, int item, int lane) {
    const int hx = item & 3, qt = item >> 2, i32 = lane & 31, h = lane >> 5, t = qt * 32 + i32;
    const bf16* Q = (const bf16*)(ws + WS_QX) + (size_t)t * 512 + hx * 128 + 8 * h;
    bf16x8 q[8];
#pragma unroll
    for (int ks = 0; ks < 8; ++ks) q[ks] = *(const bf16x8*)(Q + 16 * ks);
    const bf16* K = (const bf16*)(ws + WS_KX) + ((size_t)hx * 256 + i32) * 128 + 8 * h;
    const bf16* V = (const bf16*)(ws + WS_VXT) + ((size_t)hx * 128 + i32) * 256 + 4 * h;
    f32x16 o[4];
#pragma unroll
    for (int dt = 0; dt < 4; ++dt)
#pragma unroll
        for (int r = 0; r < 16; ++r) o[dt][r] = 0.f;
    float m = NEGBIG, l = 0.f; const float sc2 = 0.08838834764831845f * LOG2E;
    for (int kt = 0; kt < 8; ++kt)
        attn_tile<128>(q, K + (size_t)kt * 32 * 128, V + kt * 32, (size_t)32 * 256, m, l, o, [&](int r, float raw) { return raw * sc2; });
    store_ot<4>((bf16*)(ws + WS_OX) + (size_t)t * 512 + hx * 128, o, 1.f / l, h);
}
DI void peer_topk_item(unsigned char* ws, int item, LAS float* scr, int lane) {
    const int hp = item & 7, tt = item >> 3, i32 = lane & 31, h = lane >> 5, t = tt * 32 + i32;
    const bf16* Q = (const bf16*)(ws + WS_PQ) + (size_t)t * 2048 + hp * 256 + 8 * h;
    LAS float* my = scr + i32 * 64;
#pragma unroll 1
    for (int z = 0; z < 2; ++z) {
        bf16x8 q[8];
#pragma unroll
        for (int ks = 0; ks < 8; ++ks) q[ks] = *(const bf16x8*)(Q + z * 128 + 16 * ks);
        const bf16* SK = (const bf16*)(ws + (z ? WS_SK2 : WS_SK1)) + (size_t)i32 * 128 + 8 * h;
        f32x16 s[4];
#pragma unroll
        for (int kt = 0; kt < 4; ++kt) {
#pragma unroll
            for (int r = 0; r < 16; ++r) s[kt][r] = 0.f;
#pragma unroll
            for (int ks = 0; ks < 8; ++ks) s[kt] = MFMA32(*(const bf16x8*)(SK + (size_t)kt * 32 * 128 + 16 * ks), q[ks], s[kt]);
        }
#pragma unroll 1
        for (int round = 0; round < 16; ++round) {
            float bv = -3.0e38f; int bi = 1 << 20;
#pragma unroll
            for (int kt = 0; kt < 4; ++kt)
#pragma unroll
                for (int r = 0; r < 16; ++r) if (s[kt][r] > bv) { bv = s[kt][r]; bi = kt * 32 + crow(r, h); }
            { const float ov = __shfl_xor(bv, 32); const int oi = __shfl_xor(bi, 32); if (ov > bv || (ov == bv && oi < bi)) { bv = ov; bi = oi; } }
#pragma unroll
            for (int kt = 0; kt < 4; ++kt)
#pragma unroll
                for (int r = 0; r < 16; ++r) if (kt * 32 + crow(r, h) == bi) s[kt][r] = -3.0e38f;
            if (h == 0) { my[(z * 16 + round) * 2] = bv; my[(z * 16 + round) * 2 + 1] = __int_as_float(bi); }
        }
    }
    asm volatile("s_waitcnt lgkmcnt(0)" ::: "memory");
    float v1[16], v2[16];
#pragma unroll
    for (int k = 0; k < 16; ++k) { v1[k] = my[k * 2]; v2[k] = my[(16 + k) * 2]; }
    float cand[50]; int n = 0;
#pragma unroll
    for (int a = 0; a < 16; ++a)
#pragma unroll
        for (int b = 0; b < 16 / (a + 1); ++b) cand[n++] = v1[a] + v2[b];
    int* eid = (int*)(ws + WS_EID) + (size_t)t * 128 + hp * 16; float* gw = (float*)(ws + WS_GW) + (size_t)t * 128 + hp * 16;
    float vmax = 0.f, esum = 0.f;
#pragma unroll 1
    for (int round = 0; round < 16; ++round) {
        float bv = -3.0e38f; int bc = 0; n = 0;
#pragma unroll
        for (int a = 0; a < 16; ++a)
#pragma unroll
            for (int b = 0; b < 16 / (a + 1); ++b) { if (cand[n] > bv) { bv = cand[n]; bc = a * 16 + b; } ++n; }
        n = 0;
#pragma unroll
        for (int a = 0; a < 16; ++a)
#pragma unroll
            for (int b = 0; b < 16 / (a + 1); ++b) { if (a * 16 + b == bc) cand[n] = -3.0e38f; ++n; }
        if (round == 0) vmax = bv;
        const float e = __expf(bv - vmax); esum += e;
        const int e1 = __float_as_int(my[(bc >> 4) * 2 + 1]), e2 = __float_as_int(my[(16 + (bc & 15)) * 2 + 1]);
        if (h == 0) { eid[round] = e1 * 128 + e2; gw[round] = e; }
    }
    if (h == 0) ((float*)(ws + WS_GINV))[(size_t)t * 8 + hp] = 1.f / esum;
}
DI void peer_gather_token(const Args& a, int t, int lane) {
    unsigned char* ws = a.ws;
    const bf16* xg = (const bf16*)(ws + WS_H2G) + (size_t)t * DM + lane * 8;
    float xs[32];
#pragma unroll
    for (int c = 0; c < 4; ++c) { const u32x4 w = *(const u32x4*)(xg + c * 512);
        xs[c * 8 + 0] = bflo(w.x); xs[c * 8 + 1] = bfhi(w.x); xs[c * 8 + 2] = bflo(w.y); xs[c * 8 + 3] = bfhi(w.y); xs[c * 8 + 4] = bflo(w.z); xs[c * 8 + 5] = bfhi(w.z); xs[c * 8 + 6] = bflo(w.w); xs[c * 8 + 7] = bfhi(w.w); }
    const float rs2 = __builtin_amdgcn_rsqf(((const float*)(ws + WS_SUMSQ2))[t] * (1.f / DM) + EPS);
    const int* eidp = (const int*)(ws + WS_EID) + (size_t)t * 128; const float* gwp = (const float*)(ws + WS_GW) + (size_t)t * 128; const float* ginv = (const float*)(ws + WS_GINV) + (size_t)t * 8;
    const int eA = eidp[lane], eB = eidp[64 + lane];
    const float gA = gwp[lane] * ginv[lane >> 4], gB = gwp[64 + lane] * ginv[4 + (lane >> 4)];
    float y[32];
#pragma unroll
    for (int i = 0; i < 32; ++i) y[i] = 0.f;
    const bf16* EU = (const bf16*)(ws + WS_EU) + lane * 8; const bf16* EV = (const bf16*)(ws + WS_EV) + lane * 8;
#pragma unroll 2
    for (int p = 0; p < 128; ++p) {
        const int e = p < 64 ? __builtin_amdgcn_readlane(eA, p & 63) : __builtin_amdgcn_readlane(eB, p & 63);
        const int gbits = p < 64 ? __builtin_amdgcn_readlane(__float_as_int(gA), p & 63) : __builtin_amdgcn_readlane(__float_as_int(gB), p & 63);
        const bf16* up = EU + (size_t)e * DM; const bf16* vp = EV + (size_t)e * DM;
        u32x4 uw[4], vw[4];
#pragma unroll
        for (int c = 0; c < 4; ++c) { uw[c] = *(const u32x4*)(up + c * 512); vw[c] = *(const u32x4*)(vp + c * 512); }
        float d = 0.f;
#pragma unroll
        for (int c = 0; c < 4; ++c) { d += bflo(uw[c].x) * xs[c * 8 + 0] + bfhi(uw[c].x) * xs[c * 8 + 1] + bflo(uw[c].y) * xs[c * 8 + 2] + bfhi(uw[c].y) * xs[c * 8 + 3]
                                          + bflo(uw[c].z) * xs[c * 8 + 4] + bfhi(uw[c].z) * xs[c * 8 + 5] + bflo(uw[c].w) * xs[c * 8 + 6] + bfhi(uw[c].w) * xs[c * 8 + 7]; }
        d = wave_sum(d);
        const float coef = __int_as_float(gbits) * gelu_tanh(d * rs2);
#pragma unroll
        for (int c = 0; c < 4; ++c) { y[c * 8 + 0] += coef * bflo(vw[c].x); y[c * 8 + 1] += coef * bfhi(vw[c].x); y[c * 8 + 2] += coef * bflo(vw[c].y); y[c * 8 + 3] += coef * bfhi(vw[c].y);
                                      y[c * 8 + 4] += coef * bflo(vw[c].z); y[c * 8 + 5] += coef * bfhi(vw[c].z); y[c * 8 + 6] += coef * bflo(vw[c].w); y[c * 8 + 7] += coef * bfhi(vw[c].w); }
    }
    float* orow = a.out + (size_t)t * DM + lane * 8; const float* gf = a.in[24] + lane * 8; float ss = 0.f;
#pragma unroll
    for (int c = 0; c < 4; ++c) { const f32x4 h0 = *(const f32x4*)(orow + c * 512), h1 = *(const f32x4*)(orow + c * 512 + 4);
#pragma unroll
        for (int e = 0; e < 4; ++e) { y[c * 8 + e] += h0[e]; y[c * 8 + 4 + e] += h1[e]; ss += y[c * 8 + e] * y[c * 8 + e] + y[c * 8 + 4 + e] * y[c * 8 + 4 + e]; } }
    const float rs = __builtin_amdgcn_rsqf(wave_sum(ss) * (1.f / DM) + EPS);
#pragma unroll
    for (int c = 0; c < 4; ++c) { const f32x4 g0 = *(const f32x4*)(gf + c * 512), g1 = *(const f32x4*)(gf + c * 512 + 4); f32x4 o0, o1;
#pragma unroll
        for (int e = 0; e < 4; ++e) { o0[e] = y[c * 8 + e] * rs * g0[e]; o1[e] = y[c * 8 + 4 + e] * rs * g1[e]; }
        *(f32x4*)(orow + c * 512) = o0; *(f32x4*)(orow + c * 512 + 4) = o1; }
}
constexpr int NPHASES = 12;
__global__ void __launch_bounds__(NWAVES * 64, 2) fwd_kernel(Args a) {
    extern __shared__ __attribute__((aligned(16))) unsigned char lds_raw[];
    LAS unsigned char* lds = (LAS unsigned char*)lds_raw;
    const int tid = threadIdx.x, lane = tid & 63, wave = __builtin_amdgcn_readfirstlane(tid >> 6);
    const int G = gridDim.x, bx = blockIdx.x, gw = bx * NWAVES + wave, NGW = G * NWAVES;
    unsigned char* ws = a.ws;
    const int lo = a.ph_lo, hi = a.ph_hi;
#ifndef PHM
#define PHM 0xfff
#endif
#define IN(k) (((PHM >> (k)) & 1) && lo <= (k) && (k) < hi)
#define SEAM(k) do { if (IN(k) && IN((k) + 1)) cg::this_grid().sync(); } while (0)
#define GEMM_PHASE(EPI, gm, S, E) pg8::gemm_phase<EPI, pg8::StaticOrder, true, true>(lds, gm, S, E)

    if (IN(0)) phase_prologue(a, lds, gw, NGW, wave, lane);
    SEAM(0);
    if (IN(1)) {
        { pg8::Gemm gm{(const bf16*)(ws + WS_N), (const bf16*)(ws + WS_WIN), T, NINP, 2048}; pg8::StaticOrder S; S.init(T, NINP, G, bx); EpiProj E{ws}; GEMM_PHASE(EpiProj, gm, S, E); }
        { pg8::Gemm gm{(const bf16*)(ws + WS_MN), (const bf16*)(ws + WS_WXKV), 256, 1024, 2048}; pg8::StaticOrder S; S.init(256, 1024, G, G - 1 - bx); EpiKvx E{ws}; GEMM_PHASE(EpiKvx, gm, S, E); }
    }
    SEAM(1);
    if (IN(2)) {
        for (int wi = gw; wi < 3072; wi += NGW) dilated_item(ws, wi >> 2, wi & 3, lane);
        for (int wi = gw; wi < 3072 + 64; wi += NGW) if (wi >= 3072) compress_item(ws, wi - 3072, lane);
    }
    SEAM(2);
    if (IN(3)) {
        LAS float* pc = (LAS float*)(lds + wave * 8192);
        for (int it = gw; it < 4096; it += NGW) { const int Gk = it >> 11, idx = it & 2047; nsa_item(ws, Gk, Gk ? 2047 - idx : idx, pc, lane); }
        dilated_combine(ws, (size_t)gw * 64 + lane, (size_t)NGW * 64);
    }
    SEAM(3);
    if (IN(4)) {
        { pg8::Gemm gm{(const bf16*)(ws + WS_YA), (const bf16*)(ws + WS_WUPA), T, 2048, 512}; pg8::StaticOrder S; S.init(T, 2048, G, bx); EpiMix<0> E{ws}; GEMM_PHASE(EpiMix<0>, gm, S, E); }
        { pg8::Gemm gm{(const bf16*)(ws + WS_YB), (const bf16*)(ws + WS_WUPB), T, 2048, 1024}; pg8::StaticOrder S; S.init(T, 2048, G, bx); EpiMix<1> E{ws}; GEMM_PHASE(EpiMix<1>, gm, S, E); }
    }
    SEAM(4);
    if (IN(5)) {
        pg8::Gemm gm{(const bf16*)(ws + WS_MIX), (const bf16*)(ws + WS_WOUT), T, 2048, 2048}; pg8::StaticOrder S; S.init(T, 2048, G, bx);
        EpiRes E{a.in[0], a.out, (bf16*)(ws + WS_H1G), a.in[13], (float*)(ws + WS_SUMSQ1)}; GEMM_PHASE(EpiRes, gm, S, E);
    }
    SEAM(5);
    if (IN(6)) {
        pg8::Gemm gm{(const bf16*)(ws + WS_H1G), (const bf16*)(ws + WS_WXQ), T, 512, 2048}; pg8::StaticOrder S; S.init(T, 512, G, bx);
        EpiScaleRow E{(bf16*)(ws + WS_QX), 512, (const float*)(ws + WS_SUMSQ1)}; GEMM_PHASE(EpiScaleRow, gm, S, E);
    }
    SEAM(6);
    if (IN(7)) { for (int it = gw; it < 1024; it += NGW) cross_item(ws, it, lane); }
    SEAM(7);
    if (IN(8)) {
        pg8::Gemm gm{(const bf16*)(ws + WS_OX), (const bf16*)(ws + WS_WXO), T, 2048, 512}; pg8::StaticOrder S; S.init(T, 2048, G, bx);
        EpiRes E{a.out, a.out, (bf16*)(ws + WS_H2G), a.in[18], (float*)(ws + WS_SUMSQ2)}; GEMM_PHASE(EpiRes, gm, S, E);
    }
    SEAM(8);
    if (IN(9)) {
        pg8::Gemm gm{(const bf16*)(ws + WS_H2G), (const bf16*)(ws + WS_WPQ), T, 2048, 2048}; pg8::StaticOrder S; S.init(T, 2048, G, bx);
        EpiScaleRow E{(bf16*)(ws + WS_PQ), 2048, (const float*)(ws + WS_SUMSQ2)}; GEMM_PHASE(EpiScaleRow, gm, S, E);
    }
    SEAM(9);
    if (IN(10)) { LAS float* scr = (LAS float*)(lds + wave * 8192); for (int it = gw; it < 2048; it += NGW) peer_topk_item(ws, it, scr, lane); }
    SEAM(10);
    if (IN(11)) { for (int t = gw; t < T; t += NGW) peer_gather_token(a, t, lane); }
#undef IN
#undef SEAM
#undef GEMM_PHASE
}

extern "C" void kernel_launch(void* const* d_in, const int* in_sizes, int n_in, void* d_out, int out_size, void* d_ws, size_t ws_size, hipStream_t stream) {
    static int grid = 0;
    if (grid == 0) {
        if (n_in != 25 || out_size != T * DM || ws_size < WS_END) { fprintf(stderr, "kernel_launch: unexpected problem (n_in %d, out %d, ws %zu < %zu)\n", n_in, out_size, ws_size, (size_t)WS_END); grid = -1; return; }
        int dev = 0, cus = 0, per_cu = 0;
        if (hipGetDevice(&dev) != hipSuccess || hipDeviceGetAttribute(&cus, hipDeviceAttributeMultiprocessorCount, dev) != hipSuccess) { grid = -1; return; }
        if (hipFuncSetAttribute((const void*)fwd_kernel, hipFuncAttributeMaxDynamicSharedMemorySize, LDS_BYTES) != hipSuccess) { fprintf(stderr, "kernel_launch: hipFuncSetAttribute failed\n"); grid = -1; return; }
        if (hipOccupancyMaxActiveBlocksPerMultiprocessor(&per_cu, (const void*)fwd_kernel, NWAVES * 64, LDS_BYTES) != hipSuccess || per_cu < 1) { fprintf(stderr, "kernel_launch: occupancy query says %d\n", per_cu); per_cu = 1; }
        (void)hipGetLastError();
        grid = cus;
    }
    if (grid < 0) return;
    (void)hipMemsetAsync((char*)d_ws, 0, CTL_ZERO_BYTES, stream);
    Args a{};
    for (int i = 0; i < 25; ++i) a.in[i] = (const float*)d_in[i];
    a.out = (float*)d_out; a.ws = (unsigned char*)d_ws;
#if ONE_LAUNCH
    a.ph_lo = 0; a.ph_hi = NPHASES;
    void* kargs[] = {&a};
    hipError_t e = hipLaunchCooperativeKernel((const void*)fwd_kernel, dim3(grid), dim3(NWAVES * 64), kargs, LDS_BYTES, stream);
    if (e != hipSuccess) fprintf(stderr, "kernel_launch: cooperative launch failed: %s (grid %d)\n", hipGetErrorString(e), grid);
#else
    for (int ph = 0; ph < NPHASES; ++ph) { a.ph_lo = ph; a.ph_hi = ph + 1; hipLaunchKernelGGL(fwd_kernel, dim3(grid), dim3(NWAVES * 64), LDS_BYTES, stream, a); }
#endif
}
```

```cpp
#include <hip/hip_runtime.h>
#include <hip/hip_cooperative_groups.h>
#include <cstdio>
#include <cstdint>
namespace cg = cooperative_groups;

#ifndef ONE_LAUNCH
#define ONE_LAUNCH 1
#endif

namespace pg8 {
#define PG8_LAS __attribute__((address_space(3)))
typedef unsigned short bf16_t;
typedef short bf16x8 __attribute__((ext_vector_type(8)));
typedef float f32x4 __attribute__((ext_vector_type(4)));
typedef unsigned u32x4 __attribute__((ext_vector_type(4)));
constexpr int BM = 256, BK = 64, HALF = 128, HTB = HALF * BK * 2  , STAGE_BYTES = 8 * HTB, NXCD = 8, WGM = 8;

__host__ __device__ __forceinline__ int lds_byte(int r, int c) { const int st = (r >> 4) * 2 + (c >> 5), rr = r & 15, cc = c & 31, ob = rr * 64 + cc * 2; return st * 1024 + (ob ^ (((ob >> 9) & 1) << 5)); }
__host__ __device__ __forceinline__ void stage_rc(int b, int& R, int& C) { const int st = b / 1024, sb = b % 1024, swz = sb ^ (((sb >> 9) & 1) << 5); R = (st >> 1) * 16 + swz / 64; C = (st & 1) * 32 + (swz % 64) / 2; }
__host__ __device__ __forceinline__ int perm32(int rho) { const int n = rho >> 4, i = rho & 15; return 8 * (i >> 2) + 4 * n + (i & 3); }

struct Unit { int pm, pn; };
struct Gemm { const bf16_t* A; const bf16_t* Bt; int M, N, K; };

struct StaticOrder {
    int nM, nN, nwg, G, c;
    __host__ __device__ void init(int M, int N, int G_, int c_) { nM = M / BM; nN = N / BM; nwg = nM * nN; G = G_; c = c_; }
    __host__ __device__ bool next(int i, Unit& u) const {
        const long L = (long)i * G + c; if (L >= nwg) return false;
        int wgid = (int)L; { const int q = nwg / NXCD, r = nwg % NXCD, xcd = wgid % NXCD, off = wgid / NXCD; wgid = (xcd < r ? xcd * (q + 1) : r * (q + 1) + (xcd - r) * q) + off; }
        const int nig = WGM * nN, gid = wgid / nig, fm = gid * WGM, gsz = (nM - fm) < WGM ? (nM - fm) : WGM;
        u.pm = fm + ((wgid % nig) % gsz); u.pn = (wgid % nig) / gsz; return true;
    }
    __device__ __forceinline__ void a_ready(const Unit&) const {}
    __device__ __forceinline__ void done(const Unit&) const {}
};

__device__ __forceinline__ unsigned cvt_pk_bf16(float lo, float hi) { typedef float f2_t __attribute__((ext_vector_type(2))); typedef __bf16 b2_t __attribute__((ext_vector_type(2)));
    f2_t v = {lo, hi}; b2_t b = __builtin_convertvector(v, b2_t); return __builtin_bit_cast(unsigned, b); }
template <class Epi, class Sched, bool ALIGN_EPI = false, bool SP2 = false>
__device__ __forceinline__ void gemm_phase(PG8_LAS unsigned char* lds, const Gemm g, const Sched& S, const Epi& E) {
    const int tid = threadIdx.x, wid = __builtin_amdgcn_readfirstlane(tid >> 6), lane = tid & 63, wr = wid >> 2, wc = wid & 3, fr = lane & 15, fq = lane >> 4;
    const int K = g.K, nt = K / BK;
    unsigned voffA[2], voffB[2];
#pragma unroll
    for (int i = 0; i < 2; ++i) { int R, C; stage_rc(tid * 16 + i * 8192, R, C); const int Rb = Epi::PERM ? ((R & ~31) + perm32(R & 31)) : R;
        voffA[i] = (unsigned)(R * K + C) * 2u; voffB[i] = (unsigned)(Rb * K + C) * 2u; }
    const size_t kstep = (size_t)(BK * 2);
    const size_t hstep = (size_t)HALF * K * 2;
    const size_t tstep = 2 * hstep;
    const unsigned ldsw = (unsigned)wid * 1024u;
    const int aoff = lds_byte(wr * 64 + fr, fq * 8), boff = lds_byte(wc * 32 + fr, fq * 8);
#define PG8_SA(b, h) (((b) * 2 + (h)) * HTB)
#define PG8_SB(b, h) ((4 + (b) * 2 + (h)) * HTB)
#define PG8_STAGE(bufoff, gbase, voff) do { _Pragma("unroll") for (int _i = 0; _i < 2; ++_i) \
        __builtin_amdgcn_global_load_lds((const unsigned*)((const char*)(gbase) + (voff)[_i]), (PG8_LAS unsigned*)(lds + (bufoff) + ldsw + _i * 8192), 16, 0, 0); } while (0)
#define PG8_LDA(dst, b, h) do { _Pragma("unroll") for (int m = 0; m < 4; ++m) _Pragma("unroll") for (int k = 0; k < 2; ++k) dst[m][k] = *(const PG8_LAS bf16x8*)(lds + PG8_SA(b, h) + aoff + m * 2048 + k * 1024); } while (0)
#define PG8_LDB(dst, b, h) do { _Pragma("unroll") for (int n = 0; n < 2; ++n) _Pragma("unroll") for (int k = 0; k < 2; ++k) dst[n][k] = *(const PG8_LAS bf16x8*)(lds + PG8_SB(b, h) + boff + n * 2048 + k * 1024); } while (0)
#define PG8_MMA(ai, bj, At, Bt) do { __builtin_amdgcn_s_setprio(1); _Pragma("unroll") for (int m = 0; m < 4; ++m) _Pragma("unroll") for (int n = 0; n < 2; ++n) _Pragma("unroll") for (int k = 0; k < 2; ++k) \
        acc[ai][bj][m][n] = __builtin_amdgcn_mfma_f32_16x16x32_bf16(Bt[n][k], At[m][k], acc[ai][bj][m][n], 0, 0, 0); __builtin_amdgcn_s_setprio(0); } while (0)
#define PG8_WAIT_V(n) asm volatile("s_waitcnt vmcnt(" #n ")" ::: "memory")
#define PG8_WAIT_L(n) asm volatile("s_waitcnt lgkmcnt(" #n ")" ::: "memory")
#define PG8_BAR __builtin_amdgcn_s_barrier()
#define PG8_SCHED __builtin_amdgcn_sched_barrier(0)
    Unit cur, nxt; int ui = 0;
    if (!S.next(0, cur)) return;
    f32x4 acc[2][2][4][2];
#pragma unroll
    for (int a = 0; a < 2; ++a)
#pragma unroll
        for (int b = 0; b < 2; ++b)
#pragma unroll
            for (int m = 0; m < 4; ++m)
#pragma unroll
                for (int n = 0; n < 2; ++n) acc[a][b][m][n] = (f32x4){0.f, 0.f, 0.f, 0.f};
    bf16x8 At[4][2], B0[2][2], B1[2][2];
    const char* cA = (const char*)g.A + (size_t)cur.pm * tstep; const char* cB = (const char*)g.Bt + (size_t)cur.pn * tstep;
    S.a_ready(cur);
    if constexpr (SP2) {
        PG8_STAGE(PG8_SB(0, 0), cB, voffB); PG8_STAGE(PG8_SB(0, 1), cB + hstep, voffB); PG8_STAGE(PG8_SA(0, 0), cA, voffA); PG8_STAGE(PG8_SA(0, 1), cA + hstep, voffA);
        if (wr == 1) PG8_BAR;
        PG8_WAIT_V(2); PG8_BAR;
        PG8_STAGE(PG8_SB(1, 0), cB + kstep, voffB); PG8_STAGE(PG8_SA(1, 0), cA + kstep, voffA); PG8_STAGE(PG8_SB(1, 1), cB + hstep + kstep, voffB);
        PG8_WAIT_V(6); PG8_BAR;
    } else {
        PG8_STAGE(PG8_SB(0, 0), cB, voffB); PG8_STAGE(PG8_SA(0, 0), cA, voffA); PG8_STAGE(PG8_SB(0, 1), cB + hstep, voffB); PG8_STAGE(PG8_SA(0, 1), cA + hstep, voffA);
        if (wr == 1) PG8_BAR;
        PG8_WAIT_V(4); PG8_BAR;
        PG8_STAGE(PG8_SB(1, 0), cB + kstep, voffB); PG8_STAGE(PG8_SA(1, 0), cA + kstep, voffA); PG8_STAGE(PG8_SB(1, 1), cB + hstep + kstep, voffB);
        PG8_WAIT_V(6); PG8_BAR;
    }
    for (;;) {
        const bool has_next = S.next(ui + 1, nxt);
        const char* nA = has_next ? (const char*)g.A + (size_t)nxt.pm * tstep : cA; const char* nB = has_next ? (const char*)g.Bt + (size_t)nxt.pn * tstep : cB;
        for (int t = 0; t < nt; t += 2) {
            const bool last = (t == nt - 2);
            const char* a1 = cA + (size_t)(t + 1) * kstep;
            const char* a2 = last ? nA : cA + (size_t)(t + 2) * kstep; const char* b2 = last ? nB : cB + (size_t)(t + 2) * kstep;
            const char* a3 = a2 + kstep; const char* b3 = b2 + kstep;
            if (last && has_next) S.a_ready(nxt);
            if constexpr (SP2) {
            PG8_LDB(B0, 0, 0); PG8_LDB(B1, 0, 1); PG8_SCHED; PG8_LDA(At, 0, 0); PG8_STAGE(PG8_SA(1, 1), a1 + hstep, voffA);
            PG8_WAIT_V(8); PG8_WAIT_L(0); PG8_BAR; PG8_MMA(0, 0, At, B0); PG8_MMA(0, 1, At, B1); PG8_BAR; PG8_SCHED;
            PG8_LDA(At, 0, 1); PG8_STAGE(PG8_SB(0, 0), b2, voffB); PG8_STAGE(PG8_SB(0, 1), b2 + hstep, voffB); PG8_STAGE(PG8_SA(0, 0), a2, voffA);
            PG8_WAIT_V(8); PG8_WAIT_L(0); PG8_BAR; PG8_MMA(1, 0, At, B0); PG8_MMA(1, 1, At, B1); PG8_BAR; PG8_SCHED;
            PG8_LDB(B0, 1, 0); PG8_LDB(B1, 1, 1); PG8_SCHED; PG8_LDA(At, 1, 0); PG8_STAGE(PG8_SA(0, 1), a2 + hstep, voffA);
            PG8_WAIT_V(8); PG8_WAIT_L(0); PG8_BAR; PG8_MMA(0, 0, At, B0); PG8_MMA(0, 1, At, B1); PG8_BAR; PG8_SCHED;
            PG8_LDA(At, 1, 1); PG8_STAGE(PG8_SB(1, 0), b3, voffB); PG8_STAGE(PG8_SB(1, 1), b3 + hstep, voffB); PG8_STAGE(PG8_SA(1, 0), a3, voffA);
            PG8_WAIT_V(8); PG8_WAIT_L(0); PG8_BAR; PG8_MMA(1, 0, At, B0); PG8_MMA(1, 1, At, B1); PG8_BAR; PG8_SCHED;
            } else {
            PG8_LDB(B0, 0, 0); PG8_SCHED; PG8_LDA(At, 0, 0); PG8_STAGE(PG8_SA(1, 1), a1 + hstep, voffA);
            PG8_WAIT_L(8); PG8_BAR; PG8_WAIT_L(0); PG8_MMA(0, 0, At, B0); PG8_BAR; PG8_SCHED;
            PG8_LDB(B1, 0, 1); PG8_STAGE(PG8_SB(0, 0), b2, voffB);
            PG8_BAR; PG8_WAIT_L(0); PG8_MMA(0, 1, At, B1); PG8_BAR;
            PG8_LDA(At, 0, 1); PG8_STAGE(PG8_SA(0, 0), a2, voffA);
            PG8_BAR; PG8_WAIT_L(0); PG8_MMA(1, 0, At, B0); PG8_BAR; PG8_SCHED;
            PG8_STAGE(PG8_SB(0, 1), b2 + hstep, voffB);
            PG8_WAIT_V(6); PG8_BAR; PG8_MMA(1, 1, At, B1); PG8_BAR;
            PG8_LDB(B0, 1, 0); PG8_SCHED; PG8_LDA(At, 1, 0); PG8_STAGE(PG8_SA(0, 1), a2 + hstep, voffA);
            PG8_WAIT_L(8); PG8_BAR; PG8_WAIT_L(0); PG8_MMA(0, 0, At, B0); PG8_BAR; PG8_SCHED;
            PG8_LDB(B1, 1, 1); PG8_STAGE(PG8_SB(1, 0), b3, voffB);
            PG8_BAR; PG8_WAIT_L(0); PG8_MMA(0, 1, At, B1); PG8_BAR;
            PG8_LDA(At, 1, 1); PG8_STAGE(PG8_SA(1, 0), a3, voffA);
            PG8_BAR; PG8_WAIT_L(0); PG8_MMA(1, 0, At, B0); PG8_BAR; PG8_SCHED;
            PG8_STAGE(PG8_SB(1, 1), b3 + hstep, voffB);
            PG8_WAIT_V(6); PG8_BAR; PG8_MMA(1, 1, At, B1); PG8_BAR;
            }
        }
        if constexpr (ALIGN_EPI) { if (wr == 0) PG8_BAR; }
        if constexpr (!Epi::AFTER_DRAIN) { E(acc, cur, wr, wc, fr, fq); S.done(cur); }
        if (!has_next) break;
#pragma unroll
        for (int a = 0; a < 2; ++a)
#pragma unroll
            for (int b = 0; b < 2; ++b)
#pragma unroll
                for (int m = 0; m < 4; ++m)
#pragma unroll
                    for (int n = 0; n < 2; ++n) acc[a][b][m][n] = (f32x4){0.f, 0.f, 0.f, 0.f};
        cur = nxt; cA = nA; cB = nB; ++ui;
        if constexpr (ALIGN_EPI) { if (wr == 1) PG8_BAR; }
    }
    PG8_WAIT_V(0);
    if constexpr (!ALIGN_EPI) { if (wr == 0) PG8_BAR; }
    PG8_BAR;
    if constexpr (Epi::AFTER_DRAIN) { E.fused(acc, cur, wr, wc, fr, fq, lds, wid, lane); S.done(cur); }
#undef PG8_SA
#undef PG8_SB
#undef PG8_STAGE
#undef PG8_LDA
#undef PG8_LDB
#undef PG8_MMA
#undef PG8_WAIT_V
#undef PG8_WAIT_L
#undef PG8_BAR
#undef PG8_SCHED
}
}
#define LAS __attribute__((address_space(3)))
#define DI __device__ __forceinline__
typedef unsigned short bf16;
typedef short bf16x8 __attribute__((ext_vector_type(8)));
typedef short s16x4 __attribute__((ext_vector_type(4)));
typedef float f32x4 __attribute__((ext_vector_type(4)));
typedef float f32x16 __attribute__((ext_vector_type(16)));
typedef unsigned u32x2 __attribute__((ext_vector_type(2)));
typedef unsigned u32x4 __attribute__((ext_vector_type(4)));
using pg8::cvt_pk_bf16;
#define MFMA32(a, b, c) __builtin_amdgcn_mfma_f32_32x32x16_bf16((a), (b), (c), 0, 0, 0)

constexpr int T = 8192, DM = 2048, NWAVES = 8;
constexpr int NIN = 10544, NINP = 10752;
constexpr float LOG2E = 1.4426950408889634f, LN2 = 0.6931471805599453f, NEGBIG = -1e30f, EPS = 1e-6f;

constexpr size_t MiB = 1u << 20;
constexpr size_t WS_SUMSQ1 = 0, WS_SUMSQ2 = 32768, WS_BAR = 65536, CTL_ZERO_BYTES = 65536 + 16384;
constexpr size_t WS_WCK1T = 1 * MiB, WS_WCV1T = 1 * MiB + 512 * 1024, WS_WCK2T = 2 * MiB, WS_WCV2T = 2 * MiB + 16384, WS_SK1 = 2 * MiB + 32768, WS_SK2 = 2 * MiB + 65536,
                 WS_PEBK = 2 * MiB + 98304, WS_PEBV = 2 * MiB + 98304 + 512, WS_KX = 3 * MiB, WS_VXT = 3 * MiB + 262144, WS_KC = 3 * MiB + 524288, WS_VCT = 3 * MiB + 524288 + 131072,
                 WS_LSE = 4 * MiB, WS_GINV = 5 * MiB, WS_MN = 6 * MiB;
constexpr size_t WS_WIN = 8 * MiB, WS_WUPA = 50 * MiB, WS_WUPB = 52 * MiB, WS_WOUT = 56 * MiB, WS_WXQ = 64 * MiB, WS_WXKV = 66 * MiB, WS_WXO = 70 * MiB, WS_WPQ = 72 * MiB;
constexpr size_t WS_EU = 80 * MiB, WS_EV = 144 * MiB;
constexpr size_t WS_N = 208 * MiB, WS_MIXTMP = 208 * MiB, WS_AQ = 240 * MiB, WS_AK = 264 * MiB, WS_AVT = 288 * MiB, WS_BQ = 312 * MiB;
constexpr size_t WS_KCS = 328 * MiB, WS_VCS = 330 * MiB, WS_KS = 332 * MiB, WS_VST = 334 * MiB, WS_KW = 336 * MiB, WS_VWT = 338 * MiB, WS_BG = 340 * MiB, WS_MG = 342 * MiB;
constexpr size_t WS_OA = 406 * MiB, WS_YA = 431 * MiB, WS_YB = 439 * MiB, WS_MIX = 455 * MiB, WS_END = 487 * MiB;
constexpr size_t WS_H1G = 240 * MiB, WS_QX = 272 * MiB, WS_OX = 280 * MiB, WS_H2G = 288 * MiB, WS_PQ = 320 * MiB, WS_EID = 352 * MiB, WS_GW = 356 * MiB;
constexpr int LDSCTL_OFF = 131072;
constexpr int LDS_BYTES = 147456;

struct Args { const float* in[25]; float* out; unsigned char* ws; int ph_lo, ph_hi; };

DI float bflo(unsigned w) { return __uint_as_float(w << 16); }
DI float bfhi(unsigned w) { return __uint_as_float(w & 0xffff0000u); }
DI float bf2f(bf16 b) { return __uint_as_float(((unsigned)b) << 16); }
DI bf16 f2bf(float f) { return (bf16)(cvt_pk_bf16(f, 0.f) & 0xffffu); }
DI float fexp2(float x) { return __builtin_amdgcn_exp2f(x); }
DI float sigm(float x) { return 1.f / (1.f + __expf(-x)); }
DI float gelu_tanh(float x) { const float u = 0.7978845608028654f * (x + 0.044715f * x * x * x); return x / (1.f + __expf(-2.f * u)); }
DI int crow(int r, int h) { return (r & 3) + 8 * (r >> 2) + 4 * h; }
DI float wave_sum(float v) {
#pragma unroll
    for (int o = 1; o < 64; o <<= 1) v += __shfl_xor(v, o);
    return v;
}
DI u32x4 pack8(const f32x4& a, const f32x4& b) { u32x4 w; w.x = cvt_pk_bf16(a[0], a[1]); w.y = cvt_pk_bf16(a[2], a[3]); w.z = cvt_pk_bf16(b[0], b[1]); w.w = cvt_pk_bf16(b[2], b[3]); return w; }
DI bf16x8 pack8f(const float* p) { u32x4 w; w.x = cvt_pk_bf16(p[0], p[1]); w.y = cvt_pk_bf16(p[2], p[3]); w.z = cvt_pk_bf16(p[4], p[5]); w.w = cvt_pk_bf16(p[6], p[7]); return __builtin_bit_cast(bf16x8, w); }
DI bf16x8 cat4(s16x4 a, s16x4 b) { return (bf16x8){a[0], a[1], a[2], a[3], b[0], b[1], b[2], b[3]}; }

struct EpiProj {
    static constexpr bool PERM = true, AFTER_DRAIN = false;
    unsigned char* ws;
    DI void operator()(const f32x4 (&acc)[2][2][4][2], const pg8::Unit& u, int wr, int wc, int fr, int fq) const {
#pragma unroll
        for (int bj = 0; bj < 2; ++bj) {
            const int c8 = u.pn * 256 + bj * 128 + wc * 32 + 8 * fq;
            if (c8 >= NIN) continue;
            const int r0 = u.pm * 256 + wr * 64 + fr;
            if (c8 < 4608) {
                const int qkv = c8 / 1536, rem = c8 % 1536, g = rem / 512, hh = (rem % 512) / 128, d = rem % 128, ld = 2 * g, dm1 = (1 << ld) - 1;
                if (qkv < 2) {
                    bf16* base = (bf16*)(ws + (qkv == 0 ? WS_AQ : WS_AK)) + (size_t)(g * 4 + hh) * T * 128 + d;
#pragma unroll
                    for (int ai = 0; ai < 2; ++ai)
#pragma unroll
                        for (int m = 0; m < 4; ++m) { const int t = r0 + ai * 128 + m * 16, tp = ((t & dm1) << (13 - ld)) + (t >> ld);
                            *(u32x4*)(base + (size_t)tp * 128) = pack8(acc[ai][bj][m][0], acc[ai][bj][m][1]); }
                } else {
                    bf16* base = (bf16*)(ws + WS_AVT) + (size_t)((g * 4 + hh) * 128 + d) * T;
#pragma unroll
                    for (int ai = 0; ai < 2; ++ai)
#pragma unroll
                        for (int m = 0; m < 4; ++m) { const int t = r0 + ai * 128 + m * 16, tp = ((t & dm1) << (13 - ld)) + (t >> ld);
#pragma unroll
                            for (int e = 0; e < 8; ++e) base[(size_t)e * T + tp] = f2bf(acc[ai][bj][m][e >> 2][e & 3]); }
                }
            } else if (c8 < 5632) {
                bf16* base = (bf16*)(ws + WS_BQ) + (c8 - 4608);
#pragma unroll
                for (int ai = 0; ai < 2; ++ai)
#pragma unroll
                    for (int m = 0; m < 4; ++m) { const int t = r0 + ai * 128 + m * 16; *(u32x4*)(base + (size_t)t * 1024) = pack8(acc[ai][bj][m][0], acc[ai][bj][m][1]); }
            } else if (c8 < 6400) {
                const int c = c8 - 5632, br = c / 256, kv = (c % 256) / 128, G = (c % 128) / 64, d = c % 64;
                if (kv == 0 || br == 0) {
                    const size_t off = kv == 0 ? (br == 0 ? WS_KCS : br == 1 ? WS_KS : WS_KW) : WS_VCS;
                    bf16* base = (bf16*)(ws + off) + (size_t)G * T * 64 + d;
#pragma unroll
                    for (int ai = 0; ai < 2; ++ai)
#pragma unroll
                        for (int m = 0; m < 4; ++m) { const int t = r0 + ai * 128 + m * 16; *(u32x4*)(base + (size_t)t * 64) = pack8(acc[ai][bj][m][0], acc[ai][bj][m][1]); }
                } else {
                    bf16* base = (bf16*)(ws + (br == 1 ? WS_VST : WS_VWT)) + (size_t)(G * 64 + d) * T;
#pragma unroll
                    for (int ai = 0; ai < 2; ++ai)
#pragma unroll
                        for (int m = 0; m < 4; ++m) { const int t = r0 + ai * 128 + m * 16;
#pragma unroll
                            for (int e = 0; e < 8; ++e) base[(size_t)e * T + t] = f2bf(acc[ai][bj][m][e >> 2][e & 3]); }
                }
            } else if (c8 < 10496) {
                bf16* base = (bf16*)(ws + WS_MG) + (c8 - 6400);
#pragma unroll
                for (int ai = 0; ai < 2; ++ai)
#pragma unroll
                    for (int m = 0; m < 4; ++m) { const int t = r0 + ai * 128 + m * 16; f32x4 a = acc[ai][bj][m][0], b = acc[ai][bj][m][1];
#pragma unroll
                        for (int e = 0; e < 4; ++e) { a[e] = sigm(a[e]); b[e] = sigm(b[e]); }
                        *(u32x4*)(base + (size_t)t * 4096) = pack8(a, b); }
            } else {
                float* base = (float*)(ws + WS_BG) + (c8 - 10496);
#pragma unroll
                for (int ai = 0; ai < 2; ++ai)
#pragma unroll
                    for (int m = 0; m < 4; ++m) { const int t = r0 + ai * 128 + m * 16; f32x4 a = acc[ai][bj][m][0], b = acc[ai][bj][m][1];
#pragma unroll
                        for (int e = 0; e < 4; ++e) { a[e] = sigm(a[e]); b[e] = sigm(b[e]); }
                        *(f32x4*)(base + (size_t)t * 48) = a; *(f32x4*)(base + (size_t)t * 48 + 4) = b; }
            }
        }
    }
};
struct EpiKvx {
    static constexpr bool PERM = true, AFTER_DRAIN = false;
    unsigned char* ws;
    DI void operator()(const f32x4 (&acc)[2][2][4][2], const pg8::Unit& u, int wr, int wc, int fr, int fq) const {
#pragma unroll
        for (int bj = 0; bj < 2; ++bj) {
            const int c8 = u.pn * 256 + bj * 128 + wc * 32 + 8 * fq, kvi = c8 / 512, hx = (c8 % 512) / 128, d = c8 % 128, r0 = wr * 64 + fr;
#pragma unroll
            for (int ai = 0; ai < 2; ++ai)
#pragma unroll
                for (int m = 0; m < 4; ++m) { const int row = r0 + ai * 128 + m * 16;
                    if (kvi == 0) *(u32x4*)((bf16*)(ws + WS_KX) + (size_t)(hx * 256 + row) * 128 + d) = pack8(acc[ai][bj][m][0], acc[ai][bj][m][1]);
                    else {
#pragma unroll
                        for (int e = 0; e < 8; ++e) ((bf16*)(ws + WS_VXT))[(size_t)(hx * 128 + d + e) * 256 + row] = f2bf(acc[ai][bj][m][e >> 2][e & 3]); } }
        }
    }
};
template <int SECOND> struct EpiMix {
    static constexpr bool PERM = true, AFTER_DRAIN = false;
    unsigned char* ws;
    DI void operator()(const f32x4 (&acc)[2][2][4][2], const pg8::Unit& u, int wr, int wc, int fr, int fq) const {
#pragma unroll
        for (int bj = 0; bj < 2; ++bj) {
            const int c8 = u.pn * 256 + bj * 128 + wc * 32 + 8 * fq, r0 = u.pm * 256 + wr * 64 + fr;
#pragma unroll
            for (int ai = 0; ai < 2; ++ai)
#pragma unroll
                for (int m = 0; m < 4; ++m) { const int t = r0 + ai * 128 + m * 16;
                    const u32x4 gt = *(const u32x4*)((const bf16*)(ws + WS_MG) + (size_t)t * 4096 + SECOND * 2048 + c8);
                    f32x4 a = acc[ai][bj][m][0], b = acc[ai][bj][m][1];
                    a[0] *= bflo(gt.x); a[1] *= bfhi(gt.x); a[2] *= bflo(gt.y); a[3] *= bfhi(gt.y); b[0] *= bflo(gt.z); b[1] *= bfhi(gt.z); b[2] *= bflo(gt.w); b[3] *= bfhi(gt.w);
                    if (SECOND) { const u32x4 p = *(const u32x4*)((const bf16*)(ws + WS_MIXTMP) + (size_t)t * 2048 + c8);
                        a[0] += bflo(p.x); a[1] += bfhi(p.x); a[2] += bflo(p.y); a[3] += bfhi(p.y); b[0] += bflo(p.z); b[1] += bfhi(p.z); b[2] += bflo(p.w); b[3] += bfhi(p.w); }
                    *(u32x4*)((bf16*)(ws + (SECOND ? WS_MIX : WS_MIXTMP)) + (size_t)t * 2048 + c8) = pack8(a, b); }
        }
    }
};
struct EpiRes {
    static constexpr bool PERM = false, AFTER_DRAIN = false;
    const float* base; float* out; bf16* hg; const float* gain; float* sumsq;
    DI void operator()(const f32x4 (&acc)[2][2][4][2], const pg8::Unit& u, int wr, int wc, int fr, int fq) const {
        const int r0 = u.pm * 256 + wr * 64 + fr, c0 = u.pn * 256 + wc * 32 + 4 * fq;
#pragma unroll
        for (int ai = 0; ai < 2; ++ai)
#pragma unroll
            for (int m = 0; m < 4; ++m) { const int t = r0 + ai * 128 + m * 16; float ss = 0.f;
#pragma unroll
                for (int bj = 0; bj < 2; ++bj)
#pragma unroll
                    for (int n = 0; n < 2; ++n) { const int c = c0 + bj * 128 + 16 * n; const size_t off = (size_t)t * DM + c;
                        const f32x4 h = *(const f32x4*)(base + off) + acc[ai][bj][m][n]; const f32x4 g = *(const f32x4*)(gain + c);
                        *(f32x4*)(out + off) = h; ss += (h[0] * h[0] + h[1] * h[1]) + (h[2] * h[2] + h[3] * h[3]);
                        u32x2 w; w.x = cvt_pk_bf16(h[0] * g[0], h[1] * g[1]); w.y = cvt_pk_bf16(h[2] * g[2], h[3] * g[3]); *(u32x2*)(hg + off) = w; }
                ss += __shfl_xor(ss, 16); ss += __shfl_xor(ss, 32);
                if (fq == 0) atomicAdd(sumsq + t, ss); }
    }
};
struct EpiScaleRow {
    static constexpr bool PERM = true, AFTER_DRAIN = false;
    bf16* O; int ldc; const float* sumsq;
    DI void operator()(const f32x4 (&acc)[2][2][4][2], const pg8::Unit& u, int wr, int wc, int fr, int fq) const {
        const int r0 = u.pm * 256 + wr * 64 + fr;
#pragma unroll
        for (int ai = 0; ai < 2; ++ai)
#pragma unroll
            for (int m = 0; m < 4; ++m) { const int t = r0 + ai * 128 + m * 16; const float rs = __builtin_amdgcn_rsqf(sumsq[t] * (1.f / DM) + EPS);
#pragma unroll
                for (int bj = 0; bj < 2; ++bj) { const int c8 = u.pn * 256 + bj * 128 + wc * 32 + 8 * fq;
                    *(u32x4*)(O + (size_t)t * ldc + c8) = pack8(acc[ai][bj][m][0] * rs, acc[ai][bj][m][1] * rs); } }
    }
};
template <class RowMap>
DI void transpose_item(const float* W, int K, int N, bf16* WT, LAS float* scr, int item, int lane, RowMap rowmap) {
    const int nblk = (N + 31) / 32, kb = item / nblk, nb = item % nblk, k0 = 64 * kb, n0 = 32 * nb;
    const int nn = n0 + (lane & 31);
#pragma unroll 8
    for (int i = 0; i < 32; ++i) { const int kk = 2 * i + (lane >> 5); scr[kk * 33 + (lane & 31)] = nn < N ? W[(size_t)(k0 + kk) * N + nn] : 0.f; }
    asm volatile("s_waitcnt lgkmcnt(0)" ::: "memory");
    const int c = lane & 7;
#pragma unroll
    for (int j = 0; j < 4; ++j) { const int nl = (lane >> 3) + 8 * j, n = n0 + nl; const LAS float* s = scr + (8 * c) * 33 + nl;
        u32x4 o; o.x = cvt_pk_bf16(s[0 * 33], s[1 * 33]); o.y = cvt_pk_bf16(s[2 * 33], s[3 * 33]); o.z = cvt_pk_bf16(s[4 * 33], s[5 * 33]); o.w = cvt_pk_bf16(s[6 * 33], s[7 * 33]);
        if (n < N) *(u32x4*)(WT + (size_t)rowmap(n) * K + k0 + 8 * c) = o; }
    asm volatile("s_waitcnt lgkmcnt(0)" ::: "memory");
}
struct RowId { DI int operator()(int n) const { return n; } };
struct RowWin { DI int operator()(int n) const { return n < 6400 ? n : (n < 6448 ? n + 4096 : n - 48); } };

DI void rms_row_to_bf16(const float* xrow, const float* gain, bf16* orow, int lane) {
    f32x4 v[8]; float s = 0.f;
#pragma unroll
    for (int j = 0; j < 8; ++j) { v[j] = *(const f32x4*)(xrow + j * 256 + lane * 4); s += (v[j][0] * v[j][0] + v[j][1] * v[j][1]) + (v[j][2] * v[j][2] + v[j][3] * v[j][3]); }
    const float rs = __builtin_amdgcn_rsqf(wave_sum(s) * (1.f / DM) + EPS);
#pragma unroll
    for (int j = 0; j < 8; ++j) { const f32x4 g = *(const f32x4*)(gain + j * 256 + lane * 4); u32x2 w; w.x = cvt_pk_bf16(v[j][0] * rs * g[0], v[j][1] * rs * g[1]); w.y = cvt_pk_bf16(v[j][2] * rs * g[2], v[j][3] * rs * g[3]);
        *(u32x2*)(orow + j * 256 + lane * 4) = w; }
}
DI void phase_prologue(const Args& a, LAS unsigned char* lds, int gw, int NGW, int wave, int lane) {
    unsigned char* ws = a.ws;
    LAS float* scr = (LAS float*)(lds + wave * 16384);
    constexpr int I_WIN = 32 * 330, I_UPA = 8 * 64, I_UPB = 16 * 64, I_OUT = 32 * 64, I_XQ = 32 * 16, I_XKV = 32 * 32, I_XO = 8 * 64, I_PQ = 32 * 64, I_C1 = 32 * 4, I_C2 = 2 * 2;
    constexpr int NITEMS = I_WIN + I_UPA + I_UPB + I_OUT + I_XQ + I_XKV + I_XO + I_PQ + 2 * I_C1 + 2 * I_C2;
    for (int it = gw; it < NITEMS; it += NGW) {
        int r = it;
        if (r < I_WIN) { transpose_item(a.in[3], 2048, NIN, (bf16*)(ws + WS_WIN), scr, r, lane, RowWin()); continue; } r -= I_WIN;
        if (r < I_UPA) { transpose_item(a.in[10], 512, 2048, (bf16*)(ws + WS_WUPA), scr, r, lane, RowId()); continue; } r -= I_UPA;
        if (r < I_UPB) { transpose_item(a.in[11], 1024, 2048, (bf16*)(ws + WS_WUPB), scr, r, lane, RowId()); continue; } r -= I_UPB;
        if (r < I_OUT) { transpose_item(a.in[12], 2048, 2048, (bf16*)(ws + WS_WOUT), scr, r, lane, RowId()); continue; } r -= I_OUT;
        if (r < I_XQ) { transpose_item(a.in[15], 2048, 512, (bf16*)(ws + WS_WXQ), scr, r, lane, RowId()); continue; } r -= I_XQ;
        if (r < I_XKV) { transpose_item(a.in[16], 2048, 1024, (bf16*)(ws + WS_WXKV), scr, r, lane, RowId()); continue; } r -= I_XKV;
        if (r < I_XO) { transpose_item(a.in[17], 512, 2048, (bf16*)(ws + WS_WXO), scr, r, lane, RowId()); continue; } r -= I_XO;
        if (r < I_PQ) { transpose_item(a.in[19], 2048, 2048, (bf16*)(ws + WS_WPQ), scr, r, lane, RowId()); continue; } r -= I_PQ;
        if (r < I_C1) { transpose_item(a.in[4], 2048, 128, (bf16*)(ws + WS_WCK1T), scr, r, lane, RowId()); continue; } r -= I_C1;
        if (r < I_C1) { transpose_item(a.in[7], 2048, 128, (bf16*)(ws + WS_WCV1T), scr, r, lane, RowId()); continue; } r -= I_C1;
        if (r < I_C2) { transpose_item(a.in[5], 128, 64, (bf16*)(ws + WS_WCK2T), scr, r, lane, RowId()); continue; } r -= I_C2;
        transpose_item(a.in[8], 128, 64, (bf16*)(ws + WS_WCV2T), scr, r, lane, RowId());
    }
    { u32x4* p = (u32x4*)((bf16*)(ws + WS_WIN) + (size_t)NIN * 2048); const int n16 = (NINP - NIN) * 2048 / 8;
      for (int i = gw * 64 + lane; i < n16; i += NGW * 64) p[i] = (u32x4){0u, 0u, 0u, 0u}; }
    for (int m = gw; m < T + 256; m += NGW) {
        if (m < T) rms_row_to_bf16(a.in[0] + (size_t)m * DM, a.in[2], (bf16*)(ws + WS_N) + (size_t)m * DM, lane);
        else rms_row_to_bf16(a.in[1] + (size_t)(m - T) * DM, a.in[14], (bf16*)(ws + WS_MN) + (size_t)(m - T) * DM, lane);
    }
    {   const size_t n8 = (size_t)16384 * 2048 / 8, tid = (size_t)gw * 64 + lane, nth = (size_t)NGW * 64;
        for (int tb = 0; tb < 2; ++tb) { const f32x4* src = (const f32x4*)a.in[22 + tb]; u32x4* dst = (u32x4*)(ws + (tb ? WS_EV : WS_EU));
            for (size_t i = tid; i < n8; i += nth) { const f32x4 x0 = __builtin_nontemporal_load(src + 2 * i), x1 = __builtin_nontemporal_load(src + 2 * i + 1); dst[i] = pack8(x0, x1); } }
        for (int tb = 0; tb < 2; ++tb) { const f32x4* src = (const f32x4*)a.in[20 + tb]; u32x4* dst = (u32x4*)(ws + (tb ? WS_SK2 : WS_SK1));
            for (size_t i = tid; i < 128 * 128 / 8; i += nth) dst[i] = pack8(src[2 * i], src[2 * i + 1]); }
    }
    for (int o = gw; o < 256; o += NGW) { const int kv = o >> 7, j = o & 127; const float* pe = a.in[kv ? 9 : 6]; const float* w1 = a.in[kv ? 7 : 4]; float s = 0.f;
        for (int i = lane; i < 2048; i += 64) s += pe[i] * w1[(size_t)i * 128 + j];
        s = wave_sum(s); if (lane == 0) ((float*)(ws + (kv ? WS_PEBV : WS_PEBK)))[j] = s; }
}
template <int HD, class SF>
DI void attn_tile(const bf16x8 (&q)[HD / 16], const bf16* kptr, const bf16* vptr, size_t vs32, float& m, float& l, f32x16 (&o)[HD / 32], SF sf) {
    f32x16 s;
#pragma unroll
    for (int r = 0; r < 16; ++r) s[r] = 0.f;
#pragma unroll
    for (int ks = 0; ks < HD / 16; ++ks) s = MFMA32(*(const bf16x8*)(kptr + 16 * ks), q[ks], s);
    float v[16]; float tmax = NEGBIG;
#pragma unroll
    for (int r = 0; r < 16; ++r) { v[r] = sf(r, s[r]); tmax = fmaxf(tmax, v[r]); }
    tmax = fmaxf(tmax, __shfl_xor(tmax, 32));
    const float mn = fmaxf(m, tmax), alpha = fexp2(m - mn);
    float p[16]; float ps = 0.f;
#pragma unroll
    for (int r = 0; r < 16; ++r) { p[r] = v[r] > -1e29f ? fexp2(v[r] - mn) : 0.f; ps += p[r]; }
    ps += __shfl_xor(ps, 32);
    l = l * alpha + ps; m = mn;
    const bf16x8 pf0 = pack8f(p), pf1 = pack8f(p + 8);
#pragma unroll
    for (int dt = 0; dt < HD / 32; ++dt) {
        const bf16* vp = vptr + dt * vs32;
        const s16x4 a0 = *(const s16x4*)(vp), a1 = *(const s16x4*)(vp + 8), b0 = *(const s16x4*)(vp + 16), b1 = *(const s16x4*)(vp + 24);
        o[dt] = o[dt] * alpha;
        o[dt] = MFMA32(cat4(a0, a1), pf0, o[dt]);
        o[dt] = MFMA32(cat4(b0, b1), pf1, o[dt]);
    }
}
template <int NT>
DI void store_ot(bf16* orow, const f32x16 (&o)[NT], float scale, int h) {
#pragma unroll
    for (int dt = 0; dt < NT; ++dt)
#pragma unroll
        for (int rg = 0; rg < 4; ++rg) { u32x2 w; w.x = cvt_pk_bf16(o[dt][4 * rg] * scale, o[dt][4 * rg + 1] * scale); w.y = cvt_pk_bf16(o[dt][4 * rg + 2] * scale, o[dt][4 * rg + 3] * scale);
            *(u32x2*)(orow + 32 * dt + 8 * rg + 4 * h) = w; }
}

DI void dilated_item(unsigned char* ws, int item, int w, int lane) {
    const int g = item >> 8, rem = item & 255, hh = rem >> 6, nb = rem & 63, ld = 2 * g, dil = 1 << ld, nbk = 64 >> ld, n = nb / nbk, b = nb % nbk, L = T >> ld;
    const int i32 = lane & 31, h = lane >> 5, iq = 32 * w + i32, rowbase = n * L + 128 * b, gh = g * 4 + hh;
    const bf16* Q = (const bf16*)(ws + WS_AQ) + ((size_t)gh * T + rowbase + iq) * 128 + 8 * h;
    const bf16* K = (const bf16*)(ws + WS_AK) + ((long)gh * T + rowbase - 128 + i32) * 128 + 8 * h;
    const bf16* V = (const bf16*)(ws + WS_AVT) + ((long)gh * 128 + i32) * T + (rowbase - 128) + 4 * h;
    bf16x8 q[8];
#pragma unroll
    for (int ks = 0; ks < 8; ++ks) q[ks] = *(const bf16x8*)(Q + 16 * ks);
    const float slope = exp2f(-8.f * (float)(gh + 1) / 12.f), sl2 = slope * (float)dil * LOG2E, sc2 = 0.08838834764831845f * LOG2E;
    f32x16 o[4];
#pragma unroll
    for (int dt = 0; dt < 4; ++dt)
#pragma unroll
        for (int r = 0; r < 16; ++r) o[dt][r] = 0.f;
    float m = NEGBIG, l = 0.f;
#pragma unroll 1
    for (int tt = 0; tt < 5; ++tt) {
        const int j0 = 32 * w + 32 * tt;
        if (b == 0 && j0 < 128) continue;
        attn_tile<128>(q, K + (size_t)j0 * 128, V + j0, (size_t)32 * T, m, l, o, [&](int r, float raw) {
            const int rel = iq + 128 - (j0 + crow(r, h)); return (rel >= 0 && rel <= 128) ? raw * sc2 - sl2 * (float)rel : NEGBIG; });
    }
    const int t = (128 * b + iq) * dil + n;
    store_ot<4>((bf16*)(ws + WS_OA) + ((size_t)g * T + t) * 512 + hh * 128, o, 1.f / l, h);
    if (h == 0) ((float*)(ws + WS_LSE))[((size_t)g * T + t) * 4 + hh] = (m + __log2f(l)) * LN2;
}
DI void compress_item(unsigned char* ws, int item, int lane) {
    const int kv = item >> 5, G = (item >> 4) & 1, rt = item & 15, i32 = lane & 31, h = lane >> 5;
    const int c = rt * 32 + i32, cc = c < 511 ? c : 510;
    const bf16* A = (const bf16*)(ws + (kv ? WS_VCS : WS_KCS)) + (size_t)G * T * 64 + (size_t)cc * 1024 + 8 * h;
    const bf16* W1 = (const bf16*)(ws + (kv ? WS_WCV1T : WS_WCK1T)) + (size_t)i32 * 2048 + 8 * h;
    f32x16 hid[4];
#pragma unroll
    for (int jt = 0; jt < 4; ++jt)
#pragma unroll
        for (int r = 0; r < 16; ++r) hid[jt][r] = 0.f;
#pragma unroll 1
    for (int ks = 0; ks < 128; ++ks) {
        const bf16x8 af = *(const bf16x8*)(A + 16 * ks);
#pragma unroll
        for (int jt = 0; jt < 4; ++jt) hid[jt] = MFMA32(*(const bf16x8*)(W1 + (size_t)jt * 32 * 2048 + 16 * ks), af, hid[jt]);
    }
    const float* peb = (const float*)(ws + (kv ? WS_PEBV : WS_PEBK));
    bf16x8 pf[4][2];
#pragma unroll
    for (int jt = 0; jt < 4; ++jt) { float gl[16];
#pragma unroll
        for (int r = 0; r < 16; ++r) gl[r] = gelu_tanh(hid[jt][r] + peb[jt * 32 + crow(r, h)]);
        pf[jt][0] = pack8f(gl); pf[jt][1] = pack8f(gl + 8); }
    const bf16* W2 = (const bf16*)(ws + (kv ? WS_WCV2T : WS_WCK2T)) + (size_t)i32 * 128 + 4 * h;
    f32x16 o[2];
#pragma unroll
    for (int dt = 0; dt < 2; ++dt) {
#pragma unroll
        for (int r = 0; r < 16; ++r) o[dt][r] = 0.f;
#pragma unroll
        for (int jt = 0; jt < 4; ++jt) { const bf16* wp = W2 + (size_t)dt * 32 * 128 + jt * 32;
            o[dt] = MFMA32(cat4(*(const s16x4*)(wp), *(const s16x4*)(wp + 8)), pf[jt][0], o[dt]);
            o[dt] = MFMA32(cat4(*(const s16x4*)(wp + 16), *(const s16x4*)(wp + 24)), pf[jt][1], o[dt]); }
    }
    const float keep = c < 511 ? 1.f : 0.f;
    if (kv == 0) store_ot<2>((bf16*)(ws + WS_KC) + ((size_t)G * 512 + c) * 64, o, keep, h);
    else {
        bf16* vt = (bf16*)(ws + WS_VCT) + (size_t)G * 64 * 512 + c;
#pragma unroll
        for (int dt = 0; dt < 2; ++dt)
#pragma unroll
            for (int r = 0; r < 16; ++r) vt[(size_t)(32 * dt + crow(r, h)) * 512] = f2bf(o[dt][r] * keep);
    }
}
DI void nsa_item(unsigned char* ws, int G, int chunk, LAS float* pc  , int lane) {
    const int i32 = lane & 31, h = lane >> 5, tok = i32 >> 3, hh = G * 8 + (i32 & 7), t0 = chunk * 4, t = t0 + tok;
    const float slope = exp2f(-0.5f * (float)(hh + 1)), sl2 = slope * LOG2E, sc2 = 0.125f * LOG2E;
    bf16x8 q[4];
    { const bf16* Q = (const bf16*)(ws + WS_BQ) + (size_t)t * 1024 + hh * 64 + 8 * h;
#pragma unroll
      for (int ks = 0; ks < 4; ++ks) q[ks] = *(const bf16x8*)(Q + 16 * ks); }
    const float* gate = (const float*)(ws + WS_BG) + (size_t)t * 48 + hh * 3;
    const float g_c = gate[0], g_s = gate[1], g_w = gate[2];
    f32x16 y[2], o[2];
#pragma unroll
    for (int dt = 0; dt < 2; ++dt)
#pragma unroll
        for (int r = 0; r < 16; ++r) { y[dt][r] = 0.f; o[dt][r] = 0.f; }
    const int cv = t >= 31 ? ((t - 31) >> 4) : -1;
    const int cmaxw = t0 + 3 >= 31 ? ((t0 + 3 - 31) >> 4) : -1;
    const int nct = cmaxw >= 0 ? (cmaxw >> 5) + 1 : 0;
    const bf16* KC = (const bf16*)(ws + WS_KC) + ((size_t)G * 512 + i32) * 64 + 8 * h;
    const bf16* VC = (const bf16*)(ws + WS_VCT) + ((size_t)G * 64 + i32) * 512 + 4 * h;
    float m = NEGBIG, l = 0.f;
    for (int ct = 0; ct < nct; ++ct) {
        f32x16 s;
#pragma unroll
        for (int r = 0; r < 16; ++r) s[r] = 0.f;
#pragma unroll
        for (int ks = 0; ks < 4; ++ks) s = MFMA32(*(const bf16x8*)(KC + (size_t)ct * 32 * 64 + 16 * ks), q[ks], s);
        float v[16]; float tmax = NEGBIG;
#pragma unroll
        for (int r = 0; r < 16; ++r) { const int c = ct * 32 + crow(r, h); v[r] = c <= cv ? s[r] * sc2 - sl2 * (float)(t - 16 * c - 31) : NEGBIG; tmax = fmaxf(tmax, v[r]); }
        tmax = fmaxf(tmax, __shfl_xor(tmax, 32));
        const float mn = fmaxf(m, tmax); float ps = 0.f;
#pragma unroll
        for (int r = 0; r < 16; ++r) ps += v[r] > -1e29f ? fexp2(v[r] - mn) : 0.f;
        ps += __shfl_xor(ps, 32);
        l = l * fexp2(m - mn) + ps; m = mn;
    }
    const float inv_c = l > 0.f ? 1.f / l : 0.f;
    for (int ct = 0; ct < nct; ++ct) {
        f32x16 s;
#pragma unroll
        for (int r = 0; r < 16; ++r) s[r] = 0.f;
#pragma unroll
        for (int ks = 0; ks < 4; ++ks) s = MFMA32(*(const bf16x8*)(KC + (size_t)ct * 32 * 64 + 16 * ks), q[ks], s);
        float p[16];
#pragma unroll
        for (int r = 0; r < 16; ++r) { const int c = ct * 32 + crow(r, h); p[r] = c <= cv ? fexp2(s[r] * sc2 - sl2 * (float)(t - 16 * c - 31) - m) * inv_c : 0.f; }
        const bf16x8 pf0 = pack8f(p), pf1 = pack8f(p + 8);
#pragma unroll
        for (int dt = 0; dt < 2; ++dt) { const bf16* vp = VC + (size_t)dt * 32 * 512 + ct * 32;
            o[dt] = MFMA32(cat4(*(const s16x4*)(vp), *(const s16x4*)(vp + 8)), pf0, o[dt]);
            o[dt] = MFMA32(cat4(*(const s16x4*)(vp + 16), *(const s16x4*)(vp + 24)), pf1, o[dt]); }
#pragma unroll
        for (int r = 0; r < 16; ++r) { float x = p[r]; x += __shfl_xor(x, 1); x += __shfl_xor(x, 2); x += __shfl_xor(x, 4);
            if ((i32 & 7) == 0) pc[tok * 512 + ct * 32 + crow(r, h)] = x; }
    }
#pragma unroll
    for (int dt = 0; dt < 2; ++dt)
#pragma unroll
        for (int r = 0; r < 16; ++r) { y[dt][r] = g_c * o[dt][r]; o[dt][r] = 0.f; }
    asm volatile("s_waitcnt lgkmcnt(0)" ::: "memory");
    unsigned msk[4] = {0u, 0u, 0u, 0u};
    {   const int ts = lane >> 4, l16 = lane & 15, tsel = t0 + ts, cur = tsel >> 6;
        float cand[8];
#pragma unroll
        for (int e = 0; e < 8; ++e) { const int j = l16 * 8 + e; const bool valid = j >= 1 && j <= cur - 2; const LAS float* pp = pc + ts * 512 + 4 * j;
            const int jm = valid ? -1 : 0;
            cand[e] = valid ? (pp[0] + pp[1]) + pp[2] + 0.5f * (pp[3] + pp[jm]) : -1.f; }
        msk[0] |= 1u;
#pragma unroll
        for (int w = 0; w < 4; ++w) { if ((cur >> 5) == w) msk[w] |= 1u << (cur & 31); if (cur >= 1 && ((cur - 1) >> 5) == w) msk[w] |= 1u << ((cur - 1) & 31); }
        for (int round = 0; round < 13; ++round) {
            float bv = -3.f; int bi = 1 << 20;
#pragma unroll
            for (int e = 0; e < 8; ++e) if (cand[e] > bv) { bv = cand[e]; bi = l16 * 8 + e; }
#pragma unroll
            for (int off = 1; off < 16; off <<= 1) { const float ov = __shfl_xor(bv, off); const int oi = __shfl_xor(bi, off); if (ov > bv || (ov == bv && oi < bi)) { bv = ov; bi = oi; } }
            if (bv >= 0.f) {
#pragma unroll
                for (int w = 0; w < 4; ++w) if ((bi >> 5) == w) msk[w] |= 1u << (bi & 31);
#pragma unroll
                for (int e = 0; e < 8; ++e) if (l16 * 8 + e == bi) cand[e] = -2.f;
            }
        }
    }
    unsigned mk[4], U[4];
#pragma unroll
    for (int w = 0; w < 4; ++w) { mk[w] = __shfl(msk[w], tok * 16);
        U[w] = __builtin_amdgcn_readlane(msk[w], 0) | __builtin_amdgcn_readlane(msk[w], 16) | __builtin_amdgcn_readlane(msk[w], 32) | __builtin_amdgcn_readlane(msk[w], 48); }
    const bf16* KS = (const bf16*)(ws + WS_KS) + ((size_t)G * T + i32) * 64 + 8 * h;
    const bf16* VS = (const bf16*)(ws + WS_VST) + ((size_t)G * 64 + i32) * T + 4 * h;
    m = NEGBIG; l = 0.f;
#pragma unroll
    for (int w = 0; w < 4; ++w) {
        unsigned bits = U[w];
        while (bits) {
            const int jb = __builtin_ctz(bits); bits &= bits - 1u;
            const bool mine = (mk[w] >> jb) & 1u;
            for (int half = 0; half < 2; ++half) {
                const int key0 = 64 * (w * 32 + jb) + 32 * half;
                if (key0 > t0 + 3) continue;
                attn_tile<64>(q, KS + (size_t)key0 * 64, VS + key0, (size_t)32 * T, m, l, o, [&](int r, float raw) {
                    const int pos = key0 + crow(r, h); return (mine && pos <= t) ? raw * sc2 - sl2 * (float)(t - pos) : NEGBIG; });
            }
        }
    }
    { const float sc = l > 0.f ? g_s / l : 0.f;
#pragma unroll
      for (int dt = 0; dt < 2; ++dt)
#pragma unroll
          for (int r = 0; r < 16; ++r) { y[dt][r] += sc * o[dt][r]; o[dt][r] = 0.f; } }
    const bf16* KW = (const bf16*)(ws + WS_KW) + ((size_t)G * T + i32) * 64 + 8 * h;
    const bf16* VW = (const bf16*)(ws + WS_VWT) + ((size_t)G * 64 + i32) * T + 4 * h;
    m = NEGBIG; l = 0.f;
    { const int lo = (t0 - 511 > 0 ? t0 - 511 : 0) & ~31;
      for (int key0 = lo; key0 <= t0 + 3; key0 += 32)
          attn_tile<64>(q, KW + (size_t)key0 * 64, VW + key0, (size_t)32 * T, m, l, o, [&](int r, float raw) {
              const int dd = t - (key0 + crow(r, h)); return (dd >= 0 && dd < 512) ? raw * sc2 - sl2 * (float)dd : NEGBIG; }); }
    { const float sc = l > 0.f ? g_w / l : 0.f;
#pragma unroll
      for (int dt = 0; dt < 2; ++dt)
#pragma unroll
          for (int r = 0; r < 16; ++r) y[dt][r] += sc * o[dt][r]; }
    store_ot<2>((bf16*)(ws + WS_YB) + (size_t)t * 1024 + hh * 64, y, 1.f, h);
}
DI void dilated_combine(unsigned char* ws, size_t tid, size_t nth) {
    const float* lse = (const float*)(ws + WS_LSE); const bf16* oa = (const bf16*)(ws + WS_OA); bf16* ya = (bf16*)(ws + WS_YA);
    for (size_t i = tid; i < (size_t)T * 64; i += nth) {
        const size_t t = i >> 6; const int c8 = (int)(i & 63) * 8, hh = c8 >> 7;
        const float l0 = lse[(0 * (size_t)T + t) * 4 + hh], l1 = lse[(1 * (size_t)T + t) * 4 + hh], l2 = lse[(2 * (size_t)T + t) * 4 + hh];
        const float mx = fmaxf(l0, fmaxf(l1, l2)), e0 = __expf(l0 - mx), e1 = __expf(l1 - mx), e2 = __expf(l2 - mx), inv = 1.f / (e0 + e1 + e2);
        const u32x4 a = *(const u32x4*)(oa + (0 * (size_t)T + t) * 512 + c8), b = *(const u32x4*)(oa + (1 * (size_t)T + t) * 512 + c8), c = *(const u32x4*)(oa + (2 * (size_t)T + t) * 512 + c8);
        const float w0 = e0 * inv, w1 = e1 * inv, w2 = e2 * inv; u32x4 r;
        r.x = cvt_pk_bf16(w0 * bflo(a.x) + w1 * bflo(b.x) + w2 * bflo(c.x), w0 * bfhi(a.x) + w1 * bfhi(b.x) + w2 * bfhi(c.x));
        r.y = cvt_pk_bf16(w0 * bflo(a.y) + w1 * bflo(b.y) + w2 * bflo(c.y), w0 * bfhi(a.y) + w1 * bfhi(b.y) + w2 * bfhi(c.y));
        r.z = cvt_pk_bf16(w0 * bflo(a.z) + w1 * bflo(b.z) + w2 * bflo(c.z), w0 * bfhi(a.z) + w1 * bfhi(b.z) + w2 * bfhi(c.z));
        r.w = cvt_pk_bf16(w0 * bflo(a.w) + w1 * bflo(b.w) + w2 * bflo(c.w), w0 * bfhi(a.w) + w1 * bfhi(b.w) + w2 * bfhi(c.w));
        *(u32x4*)(ya + t * 512 + c8) = r;
    }
}
DI void cross_item(unsigned char* ws, int item, int lane) {
    const int hx = item & 3, qt = item >> 2, i32 = lane & 31, h = lane >> 5, t = qt * 32 + i32;
    const bf16* Q = (const bf16*)(ws + WS_QX) + (size_t)t * 512 + hx * 128 + 8 * h;
    bf16x8 q[8];
#pragma unroll
    for (int ks = 0; ks < 8; ++ks) q[ks] = *(const bf16x8*)(Q + 16 * ks);
    const bf16* K = (const bf16*)(ws + WS_KX) + ((size_t)hx * 256 + i32) * 128 + 8 * h;
    const bf16* V = (const bf16*)(ws + WS_VXT) + ((size_t)hx * 128 + i32) * 256 + 4 * h;
    f32x16 o[4];
#pragma unroll
    for (int dt = 0; dt < 4; ++dt)
#pragma unroll
        for (int r = 0; r < 16; ++r) o[dt][r] = 0.f;
    float m = NEGBIG, l = 0.f; const float sc2 = 0.08838834764831845f * LOG2E;
    for (int kt = 0; kt < 8; ++kt)
        attn_tile<128>(q, K + (size_t)kt * 32 * 128, V + kt * 32, (size_t)32 * 256, m, l, o, [&](int r, float raw) { return raw * sc2; });
    store_ot<4>((bf16*)(ws + WS_OX) + (size_t)t * 512 + hx * 128, o, 1.f / l, h);
}
DI void peer_topk_item(unsigned char* ws, int item, LAS float* scr, int lane) {
    const int hp = item & 7, tt = item >> 3, i32 = lane & 31, h = lane >> 5, t = tt * 32 + i32;
    const bf16* Q = (const bf16*)(ws + WS_PQ) + (size_t)t * 2048 + hp * 256 + 8 * h;
    LAS float* my = scr + i32 * 64;
#pragma unroll 1
    for (int z = 0; z < 2; ++z) {
        bf16x8 q[8];
#pragma unroll
        for (int ks = 0; ks < 8; ++ks) q[ks] = *(const bf16x8*)(Q + z * 128 + 16 * ks);
        const bf16* SK = (const bf16*)(ws + (z ? WS_SK2 : WS_SK1)) + (size_t)i32 * 128 + 8 * h;
        f32x16 s[4];
#pragma unroll
        for (int kt = 0; kt < 4; ++kt) {
#pragma unroll
            for (int r = 0; r < 16; ++r) s[kt][r] = 0.f;
#pragma unroll
            for (int ks = 0; ks < 8; ++ks) s[kt] = MFMA32(*(const bf16x8*)(SK + (size_t)kt * 32 * 128 + 16 * ks), q[ks], s[kt]);
        }
#pragma unroll 1
        for (int round = 0; round < 16; ++round) {
            float bv = -3.0e38f; int bi = 1 << 20;
#pragma unroll
            for (int kt = 0; kt < 4; ++kt)
#pragma unroll
                for (int r = 0; r < 16; ++r) if (s[kt][r] > bv) { bv = s[kt][r]; bi = kt * 32 + crow(r, h); }
            { const float ov = __shfl_xor(bv, 32); const int oi = __shfl_xor(bi, 32); if (ov > bv || (ov == bv && oi < bi)) { bv = ov; bi = oi; } }
#pragma unroll
            for (int kt = 0; kt < 4; ++kt)
#pragma unroll
                for (int r = 0; r < 16; ++r) if (kt * 32 + crow(r, h) == bi) s[kt][r] = -3.0e38f;
            if (h == 0) { my[(z * 16 + round) * 2] = bv; my[(z * 16 + round) * 2 + 1] = __int_as_float(bi); }
        }
    }
    asm volatile("s_waitcnt lgkmcnt(0)" ::: "memory");
    float v1[16], v2[16];
#pragma unroll
    for (int k = 0; k < 16; ++k) { v1[k] = my[k * 2]; v2[k] = my[(16 + k) * 2]; }
    float cand[50]; int n = 0;
#pragma unroll
    for (int a = 0; a < 16; ++a)
#pragma unroll
        for (int b = 0; b < 16 / (a + 1); ++b) cand[n++] = v1[a] + v2[b];
    int* eid = (int*)(ws + WS_EID) + (size_t)t * 128 + hp * 16; float* gw = (float*)(ws + WS_GW) + (size_t)t * 128 + hp * 16;
    float vmax = 0.f, esum = 0.f;
#pragma unroll 1
    for (int round = 0; round < 16; ++round) {
        float bv = -3.0e38f; int bc = 0; n = 0;
#pragma unroll
        for (int a = 0; a < 16; ++a)
#pragma unroll
            for (int b = 0; b < 16 / (a + 1); ++b) { if (cand[n] > bv) { bv = cand[n]; bc = a * 16 + b; } ++n; }
        n = 0;
#pragma unroll
        for (int a = 0; a < 16; ++a)
#pragma unroll
            for (int b = 0; b < 16 / (a + 1); ++b) { if (a * 16 + b == bc) cand[n] = -3.0e38f; ++n; }
        if (round == 0) vmax = bv;
        const float e = __expf(bv - vmax); esum += e;
        const int e1 = __float_as_int(my[(bc >> 4) * 2 + 1]), e2 = __float_as_int(my[(16 + (bc & 15)) * 2 + 1]);
        if (h == 0) { eid[round] = e1 * 128 + e2; gw[round] = e; }
    }
    if (h == 0) ((float*)(ws + WS_GINV))[(size_t)t * 8 + hp] = 1.f / esum;
}
DI void peer_gather_token(const Args& a, int t, int lane) {
    unsigned char* ws = a.ws;
    const bf16* xg = (const bf16*)(ws + WS_H2G) + (size_t)t * DM + lane * 8;
    float xs[32];
#pragma unroll
    for (int c = 0; c < 4; ++c) { const u32x4 w = *(const u32x4*)(xg + c * 512);
        xs[c * 8 + 0] = bflo(w.x); xs[c * 8 + 1] = bfhi(w.x); xs[c * 8 + 2] = bflo(w.y); xs[c * 8 + 3] = bfhi(w.y); xs[c * 8 + 4] = bflo(w.z); xs[c * 8 + 5] = bfhi(w.z); xs[c * 8 + 6] = bflo(w.w); xs[c * 8 + 7] = bfhi(w.w); }
    const float rs2 = __builtin_amdgcn_rsqf(((const float*)(ws + WS_SUMSQ2))[t] * (1.f / DM) + EPS);
    const int* eidp = (const int*)(ws + WS_EID) + (size_t)t * 128; const float* gwp = (const float*)(ws + WS_GW) + (size_t)t * 128; const float* ginv = (const float*)(ws + WS_GINV) + (size_t)t * 8;
    const int eA = eidp[lane], eB = eidp[64 + lane];
    const float gA = gwp[lane] * ginv[lane >> 4], gB = gwp[64 + lane] * ginv[4 + (lane >> 4)];
    float y[32];
#pragma unroll
    for (int i = 0; i < 32; ++i) y[i] = 0.f;
    const bf16* EU = (const bf16*)(ws + WS_EU) + lane * 8; const bf16* EV = (const bf16*)(ws + WS_EV) + lane * 8;
#pragma unroll 2
    for (int p = 0; p < 128; ++p) {
        const int e = p < 64 ? __builtin_amdgcn_readlane(eA, p & 63) : __builtin_amdgcn_readlane(eB, p & 63);
        const int gbits = p < 64 ? __builtin_amdgcn_readlane(__float_as_int(gA), p & 63) : __builtin_amdgcn_readlane(__float_as_int(gB), p & 63);
        const bf16* up = EU + (size_t)e * DM; const bf16* vp = EV + (size_t)e * DM;
        u32x4 uw[4], vw[4];
#pragma unroll
        for (int c = 0; c < 4; ++c) { uw[c] = *(const u32x4*)(up + c * 512); vw[c] = *(const u32x4*)(vp + c * 512); }
        float d = 0.f;
#pragma unroll
        for (int c = 0; c < 4; ++c) { d += bflo(uw[c].x) * xs[c * 8 + 0] + bfhi(uw[c].x) * xs[c * 8 + 1] + bflo(uw[c].y) * xs[c * 8 + 2] + bfhi(uw[c].y) * xs[c * 8 + 3]
                                          + bflo(uw[c].z) * xs[c * 8 + 4] + bfhi(uw[c].z) * xs[c * 8 + 5] + bflo(uw[c].w) * xs[c * 8 + 6] + bfhi(uw[c].w) * xs[c * 8 + 7]; }
        d = wave_sum(d);
        const float coef = __int_as_float(gbits) * gelu_tanh(d * rs2);
#pragma unroll
        for (int c = 0; c < 4; ++c) { y[c * 8 + 0] += coef * bflo(vw[c].x); y[c * 8 + 1] += coef * bfhi(vw[c].x); y[c * 8 + 2] += coef * bflo(vw[c].y); y[c * 8 + 3] += coef * bfhi(vw[c].y);
                                      y[c * 8 + 4] += coef * bflo(vw[c].z); y[c * 8 + 5] += coef * bfhi(vw[c].z); y[c * 8 + 6] += coef * bflo(vw[c].w); y[c * 8 + 7] += coef * bfhi(vw[c].w); }
    }
    float* orow = a.out + (size_t)t * DM + lane * 8; const float* gf = a.in[24] + lane * 8; float ss = 0.f;
#pragma unroll
    for (int c = 0; c < 4; ++c) { const f32x4 h0 = *(const f32x4*)(orow + c * 512), h1 = *(const f32x4*)(orow + c * 512 + 4);
#pragma unroll
        for (int e = 0; e < 4; ++e) { y[c * 8 + e] += h0[e]; y[c * 8 + 4 + e] += h1[e]; ss += y[c * 8 + e] * y[c * 8 + e] + y[c * 8 + 4 + e] * y[c * 8 + 4 + e]; } }
    const float rs = __builtin_amdgcn_rsqf(wave_sum(ss) * (1.f / DM) + EPS);
#pragma unroll
    for (int c = 0; c < 4; ++c) { const f32x4 g0 = *(const f32x4*)(gf + c * 512), g1 = *(const f32x4*)(gf + c * 512 + 4); f32x4 o0, o1;
#pragma unroll
        for (int e = 0; e < 4; ++e) { o0[e] = y[c * 8 + e] * rs * g0[e]; o1[e] = y[c * 8 + 4 + e] * rs * g1[e]; }
        *(f32x4*)(orow + c * 512) = o0; *(f32x4*)(orow + c * 512 + 4) = o1; }
}
#define XB_TMO      128
#define XB_XCNT(j)  (256  + 64 * (j))
#define XB_XSUB(j)  (1280 + 64 * (j))
#define XB_XGEN(j)  (2304 + 64 * (j))
#define XB_TOP      3328
#define XB_TOPGEN   3392
#define XCD_BAR_WORDS 3456
#define XB_SPIN_CAP (1u << 18)

__device__ __forceinline__ unsigned xb_ld(unsigned* p)              { return __hip_atomic_load(p, __ATOMIC_RELAXED, __HIP_MEMORY_SCOPE_AGENT); }
__device__ __forceinline__ unsigned xb_add(unsigned* p, unsigned v) { return __hip_atomic_fetch_add(p, v, __ATOMIC_RELAXED, __HIP_MEMORY_SCOPE_AGENT); }
__device__ __forceinline__ unsigned xb_xcc_id() { return (unsigned)__builtin_amdgcn_s_getreg((3 << 11) | 20) & 0xFu; }
#define XB_SPIN(cond, bar) do { unsigned _sp = 0; while (cond) { __builtin_amdgcn_s_sleep(1); \
    if ((++_sp & 255u) == 0u) { if (xb_ld(&(bar)[XB_TMO])) break; if (_sp > XB_SPIN_CAP) { atomicAdd(&(bar)[XB_TMO], 1u); break; } } } } while (0)

struct XcdBarrier {
    unsigned* bar; unsigned x;
    volatile LAS unsigned* st;
};

__device__ __forceinline__ XcdBarrier xcd_barrier_post(unsigned* bar, volatile LAS unsigned* st) {
    XcdBarrier b; b.bar = bar; b.x = xb_xcc_id(); b.st = st;
    if (threadIdx.x == 0) (void)xb_add(&bar[XB_XCNT(b.x)], 1u);
    return b;
}
__device__ __forceinline__ void xcd_barrier_complete(unsigned* bar, unsigned x, unsigned& nloc, unsigned& nx) {
    const unsigned G = gridDim.x * gridDim.y * gridDim.z;
    unsigned sum, cnt, mine, sp = 0u;
    for (;;) {
        sum = 0u; cnt = 0u; mine = 0u;
#pragma unroll
        for (unsigned j = 0; j < 16; ++j) { const unsigned c = xb_ld(&bar[XB_XCNT(j)]); sum += c; cnt += (c > 0u) ? 1u : 0u; mine = (j == x) ? c : mine; }
        if (sum == G) break;
        __builtin_amdgcn_s_sleep(1);
        if ((++sp & 255u) == 0u) { if (xb_ld(&bar[XB_TMO])) break; if (sp > XB_SPIN_CAP) { atomicAdd(&bar[XB_TMO], 1u); break; } }
    }
    nloc = mine > 0u ? mine : 1u; nx = cnt > 0u ? cnt : 1u;
}

__device__ __forceinline__ void xcd_barrier(const XcdBarrier& b) {
    asm volatile("s_waitcnt vmcnt(0)" ::: "memory");
    __syncthreads();
    if (threadIdx.x == 0) {
        unsigned* bar = b.bar;
        __builtin_amdgcn_s_waitcnt(0);
        unsigned nloc = b.st[0], nx = b.st[1];
        if (nloc == 0u) { xcd_barrier_complete(bar, b.x, nloc, nx); b.st[0] = nloc; b.st[1] = nx; }
        const unsigned old = xb_add(&bar[XB_XSUB(b.x)], 1u);
        const unsigned gen = old / nloc;
        if (old + 1u == (gen + 1u) * nloc) {
            __builtin_amdgcn_fence(__ATOMIC_RELEASE, "agent");
            asm volatile("s_waitcnt vmcnt(0)" ::: "memory");
            const unsigned og = xb_add(&bar[XB_TOP], 1u);
            const unsigned tg = og / nx;
            if (og + 1u == (tg + 1u) * nx) xb_add(&bar[XB_TOPGEN], 1u);
            else XB_SPIN(xb_ld(&bar[XB_TOPGEN]) == tg, bar);
            __builtin_amdgcn_fence(__ATOMIC_ACQUIRE, "agent");
            xb_add(&bar[XB_XGEN(b.x)], 1u);
            asm volatile("s_waitcnt vmcnt(0)" ::: "memory");
        } else {
            XB_SPIN(xb_ld(&bar[XB_XGEN(b.x)]) == gen, bar);
            __builtin_amdgcn_fence(__ATOMIC_ACQUIRE, "agent");
            asm volatile("s_waitcnt vmcnt(0)" ::: "memory");
        }
    }
    __syncthreads();
}

constexpr int NPHASES = 12;
__global__ void __launch_bounds__(NWAVES * 64, 2) fwd_kernel(Args a) {
    extern __shared__ __attribute__((aligned(16))) unsigned char lds_raw[];
    LAS unsigned char* lds = (LAS unsigned char*)lds_raw;
    const int tid = threadIdx.x, lane = tid & 63, wave = __builtin_amdgcn_readfirstlane(tid >> 6);
    const int G = gridDim.x, bx = blockIdx.x, gw = bx * NWAVES + wave, NGW = G * NWAVES;
    unsigned char* ws = a.ws;
    const int lo = a.ph_lo, hi = a.ph_hi;
    for (int u = tid; u < (LDS_BYTES - LDSCTL_OFF) / 4; u += NWAVES * 64) ((LAS unsigned*)(lds + LDSCTL_OFF))[u] = 0u;
    __syncthreads();
    XcdBarrier bar; bar.bar = (unsigned*)(ws + WS_BAR); bar.x = 0; bar.st = nullptr;
    if (hi - lo > 1) bar = xcd_barrier_post((unsigned*)(ws + WS_BAR), (volatile LAS unsigned*)(lds + LDSCTL_OFF + 64));
#ifndef PHM
#define PHM 0xfff
#endif
#define IN(k) (((PHM >> (k)) & 1) && lo <= (k) && (k) < hi)
#define SEAM(k) do { if (IN(k) && IN((k) + 1)) { if ((k) == 0) cg::this_grid().sync(); else xcd_barrier(bar); } } while (0)
#define GEMM_PHASE(EPI, gm, S, E) pg8::gemm_phase<EPI, pg8::StaticOrder, true, true>(lds, gm, S, E)

    if (IN(0)) phase_prologue(a, lds, gw, NGW, wave, lane);
    SEAM(0);
    if (IN(1)) {
        { pg8::Gemm gm{(const bf16*)(ws + WS_N), (const bf16*)(ws + WS_WIN), T, NINP, 2048}; pg8::StaticOrder S; S.init(T, NINP, G, bx); EpiProj E{ws}; GEMM_PHASE(EpiProj, gm, S, E); }
        { pg8::Gemm gm{(const bf16*)(ws + WS_MN), (const bf16*)(ws + WS_WXKV), 256, 1024, 2048}; pg8::StaticOrder S; S.init(256, 1024, G, G - 1 - bx); EpiKvx E{ws}; GEMM_PHASE(EpiKvx, gm, S, E); }
    }
    SEAM(1);
    if (IN(2)) {
        for (int wi = gw; wi < 3072; wi += NGW) dilated_item(ws, wi >> 2, wi & 3, lane);
        for (int wi = gw; wi < 3072 + 64; wi += NGW) if (wi >= 3072) compress_item(ws, wi - 3072, lane);
    }
    SEAM(2);
    if (IN(3)) {
        LAS float* pc = (LAS float*)(lds + wave * 8192);
        for (int it = gw; it < 4096; it += NGW) { const int Gk = it >> 11, idx = it & 2047; nsa_item(ws, Gk, Gk ? 2047 - idx : idx, pc, lane); }
        dilated_combine(ws, (size_t)gw * 64 + lane, (size_t)NGW * 64);
    }
    SEAM(3);
    if (IN(4)) {
        { pg8::Gemm gm{(const bf16*)(ws + WS_YA), (const bf16*)(ws + WS_WUPA), T, 2048, 512}; pg8::StaticOrder S; S.init(T, 2048, G, bx); EpiMix<0> E{ws}; GEMM_PHASE(EpiMix<0>, gm, S, E); }
        { pg8::Gemm gm{(const bf16*)(ws + WS_YB), (const bf16*)(ws + WS_WUPB), T, 2048, 1024}; pg8::StaticOrder S; S.init(T, 2048, G, bx); EpiMix<1> E{ws}; GEMM_PHASE(EpiMix<1>, gm, S, E); }
    }
    SEAM(4);
    if (IN(5)) {
        pg8::Gemm gm{(const bf16*)(ws + WS_MIX), (const bf16*)(ws + WS_WOUT), T, 2048, 2048}; pg8::StaticOrder S; S.init(T, 2048, G, bx);
        EpiRes E{a.in[0], a.out, (bf16*)(ws + WS_H1G), a.in[13], (float*)(ws + WS_SUMSQ1)}; GEMM_PHASE(EpiRes, gm, S, E);
    }
    SEAM(5);
    if (IN(6)) {
        pg8::Gemm gm{(const bf16*)(ws + WS_H1G), (const bf16*)(ws + WS_WXQ), T, 512, 2048}; pg8::StaticOrder S; S.init(T, 512, G, bx);
        EpiScaleRow E{(bf16*)(ws + WS_QX), 512, (const float*)(ws + WS_SUMSQ1)}; GEMM_PHASE(EpiScaleRow, gm, S, E);
    }
    SEAM(6);
    if (IN(7)) { for (int it = gw; it < 1024; it += NGW) cross_item(ws, it, lane); }
    SEAM(7);
    if (IN(8)) {
        pg8::Gemm gm{(const bf16*)(ws + WS_OX), (const bf16*)(ws + WS_WXO), T, 2048, 512}; pg8::StaticOrder S; S.init(T, 2048, G, bx);
        EpiRes E{a.out, a.out, (bf16*)(ws + WS_H2G), a.in[18], (float*)(ws + WS_SUMSQ2)}; GEMM_PHASE(EpiRes, gm, S, E);
    }
    SEAM(8);
    if (IN(9)) {
        pg8::Gemm gm{(const bf16*)(ws + WS_H2G), (const bf16*)(ws + WS_WPQ), T, 2048, 2048}; pg8::StaticOrder S; S.init(T, 2048, G, bx);
        EpiScaleRow E{(bf16*)(ws + WS_PQ), 2048, (const float*)(ws + WS_SUMSQ2)}; GEMM_PHASE(EpiScaleRow, gm, S, E);
    }
    SEAM(9);
    if (IN(10)) { LAS float* scr = (LAS float*)(lds + wave * 8192); for (int it = gw; it < 2048; it += NGW) peer_topk_item(ws, it, scr, lane); }
    SEAM(10);
    if (IN(11)) { for (int t = gw; t < T; t += NGW) peer_gather_token(a, t, lane); }
#undef IN
#undef SEAM
#undef GEMM_PHASE
}

extern "C" void kernel_launch(void* const* d_in, const int* in_sizes, int n_in, void* d_out, int out_size, void* d_ws, size_t ws_size, hipStream_t stream) {
    static int grid = 0;
    if (grid == 0) {
        if (n_in != 25 || out_size != T * DM || ws_size < WS_END) { fprintf(stderr, "kernel_launch: unexpected problem (n_in %d, out %d, ws %zu < %zu)\n", n_in, out_size, ws_size, (size_t)WS_END); grid = -1; return; }
        int dev = 0, cus = 0, per_cu = 0;
        if (hipGetDevice(&dev) != hipSuccess || hipDeviceGetAttribute(&cus, hipDeviceAttributeMultiprocessorCount, dev) != hipSuccess) { grid = -1; return; }
        if (hipFuncSetAttribute((const void*)fwd_kernel, hipFuncAttributeMaxDynamicSharedMemorySize, LDS_BYTES) != hipSuccess) { fprintf(stderr, "kernel_launch: hipFuncSetAttribute failed\n"); grid = -1; return; }
        if (hipOccupancyMaxActiveBlocksPerMultiprocessor(&per_cu, (const void*)fwd_kernel, NWAVES * 64, LDS_BYTES) != hipSuccess || per_cu < 1) { fprintf(stderr, "kernel_launch: occupancy query says %d\n", per_cu); per_cu = 1; }
        (void)hipGetLastError();
        grid = cus;
    }
    if (grid < 0) return;
    (void)hipMemsetAsync((char*)d_ws, 0, CTL_ZERO_BYTES, stream);
    Args a{};
    for (int i = 0; i < 25; ++i) a.in[i] = (const float*)d_in[i];
    a.out = (float*)d_out; a.ws = (unsigned char*)d_ws;
#if ONE_LAUNCH
    a.ph_lo = 0; a.ph_hi = NPHASES;
    void* kargs[] = {&a};
    hipError_t e = hipLaunchCooperativeKernel((const void*)fwd_kernel, dim3(grid), dim3(NWAVES * 64), kargs, LDS_BYTES, stream);
    if (e != hipSuccess) fprintf(stderr, "kernel_launch: cooperative launch failed: %s (grid %d)\n", hipGetErrorString(e), grid);
#else
    for (int ph = 0; ph < NPHASES; ++ph) { a.ph_lo = ph; a.ph_hi = ph + 1; hipLaunchKernelGGL(fwd_kernel, dim3(grid), dim3(NWAVES * 64), LDS_BYTES, stream, a); }
#endif
}
```

```cpp
#include <hip/hip_runtime.h>
#include <hip/hip_cooperative_groups.h>
#include <cstdio>
#include <cstdint>
namespace cg = cooperative_groups;

#ifndef ONE_LAUNCH
#define ONE_LAUNCH 1
#endif

namespace pg8 {
#define PG8_LAS __attribute__((address_space(3)))
typedef unsigned short bf16_t;
typedef short bf16x8 __attribute__((ext_vector_type(8)));
typedef float f32x4 __attribute__((ext_vector_type(4)));
typedef unsigned u32x4 __attribute__((ext_vector_type(4)));
constexpr int BM = 256, BK = 64, HALF = 128, HTB = HALF * BK * 2  , STAGE_BYTES = 8 * HTB, NXCD = 8, WGM = 8;

__host__ __device__ __forceinline__ int lds_byte(int r, int c) { const int st = (r >> 4) * 2 + (c >> 5), rr = r & 15, cc = c & 31, ob = rr * 64 + cc * 2; return st * 1024 + (ob ^ (((ob >> 9) & 1) << 5)); }
__host__ __device__ __forceinline__ void stage_rc(int b, int& R, int& C) { const int st = b / 1024, sb = b % 1024, swz = sb ^ (((sb >> 9) & 1) << 5); R = (st >> 1) * 16 + swz / 64; C = (st & 1) * 32 + (swz % 64) / 2; }
__host__ __device__ __forceinline__ int perm32(int rho) { const int n = rho >> 4, i = rho & 15; return 8 * (i >> 2) + 4 * n + (i & 3); }

struct Unit { int pm, pn; };
struct Gemm { const bf16_t* A; const bf16_t* Bt; int M, N, K; };

struct StaticOrder {
    int nM, nN, nwg, G, c;
    __host__ __device__ void init(int M, int N, int G_, int c_) { nM = M / BM; nN = N / BM; nwg = nM * nN; G = G_; c = c_; }
    __host__ __device__ bool next(int i, Unit& u) const {
        const long L = (long)i * G + c; if (L >= nwg) return false;
        int wgid = (int)L; { const int q = nwg / NXCD, r = nwg % NXCD, xcd = wgid % NXCD, off = wgid / NXCD; wgid = (xcd < r ? xcd * (q + 1) : r * (q + 1) + (xcd - r) * q) + off; }
        const int nig = WGM * nN, gid = wgid / nig, fm = gid * WGM, gsz = (nM - fm) < WGM ? (nM - fm) : WGM;
        u.pm = fm + ((wgid % nig) % gsz); u.pn = (wgid % nig) / gsz; return true;
    }
    __device__ __forceinline__ void a_ready(const Unit&) const {}
    __device__ __forceinline__ void done(const Unit&) const {}
};

__device__ __forceinline__ unsigned cvt_pk_bf16(float lo, float hi) { typedef float f2_t __attribute__((ext_vector_type(2))); typedef __bf16 b2_t __attribute__((ext_vector_type(2)));
    f2_t v = {lo, hi}; b2_t b = __builtin_convertvector(v, b2_t); return __builtin_bit_cast(unsigned, b); }
template <class Epi, class Sched, bool ALIGN_EPI = false, bool SP2 = false>
__device__ __forceinline__ void gemm_phase(PG8_LAS unsigned char* lds, const Gemm g, const Sched& S, const Epi& E) {
    const int tid = threadIdx.x, wid = __builtin_amdgcn_readfirstlane(tid >> 6), lane = tid & 63, wr = wid >> 2, wc = wid & 3, fr = lane & 15, fq = lane >> 4;
    const int K = g.K, nt = K / BK;
    unsigned voffA[2], voffB[2];
#pragma unroll
    for (int i = 0; i < 2; ++i) { int R, C; stage_rc(tid * 16 + i * 8192, R, C); const int Rb = Epi::PERM ? ((R & ~31) + perm32(R & 31)) : R;
        voffA[i] = (unsigned)(R * K + C) * 2u; voffB[i] = (unsigned)(Rb * K + C) * 2u; }
    const size_t kstep = (size_t)(BK * 2);
    const size_t hstep = (size_t)HALF * K * 2;
    const size_t tstep = 2 * hstep;
    const unsigned ldsw = (unsigned)wid * 1024u;
    const int aoff = lds_byte(wr * 64 + fr, fq * 8), boff = lds_byte(wc * 32 + fr, fq * 8);
#define PG8_SA(b, h) (((b) * 2 + (h)) * HTB)
#define PG8_SB(b, h) ((4 + (b) * 2 + (h)) * HTB)
#define PG8_STAGE(bufoff, gbase, voff) do { _Pragma("unroll") for (int _i = 0; _i < 2; ++_i) \
        __builtin_amdgcn_global_load_lds((const unsigned*)((const char*)(gbase) + (voff)[_i]), (PG8_LAS unsigned*)(lds + (bufoff) + ldsw + _i * 8192), 16, 0, 0); } while (0)
#define PG8_LDA(dst, b, h) do { _Pragma("unroll") for (int m = 0; m < 4; ++m) _Pragma("unroll") for (int k = 0; k < 2; ++k) dst[m][k] = *(const PG8_LAS bf16x8*)(lds + PG8_SA(b, h) + aoff + m * 2048 + k * 1024); } while (0)
#define PG8_LDB(dst, b, h) do { _Pragma("unroll") for (int n = 0; n < 2; ++n) _Pragma("unroll") for (int k = 0; k < 2; ++k) dst[n][k] = *(const PG8_LAS bf16x8*)(lds + PG8_SB(b, h) + boff + n * 2048 + k * 1024); } while (0)
#define PG8_MMA(ai, bj, At, Bt) do { __builtin_amdgcn_s_setprio(1); _Pragma("unroll") for (int m = 0; m < 4; ++m) _Pragma("unroll") for (int n = 0; n < 2; ++n) _Pragma("unroll") for (int k = 0; k < 2; ++k) \
        acc[ai][bj][m][n] = __builtin_amdgcn_mfma_f32_16x16x32_bf16(Bt[n][k], At[m][k], acc[ai][bj][m][n], 0, 0, 0); __builtin_amdgcn_s_setprio(0); } while (0)
#define PG8_WAIT_V(n) asm volatile("s_waitcnt vmcnt(" #n ")" ::: "memory")
#define PG8_WAIT_L(n) asm volatile("s_waitcnt lgkmcnt(" #n ")" ::: "memory")
#define PG8_BAR __builtin_amdgcn_s_barrier()
#define PG8_SCHED __builtin_amdgcn_sched_barrier(0)
    Unit cur, nxt; int ui = 0;
    if (!S.next(0, cur)) return;
    f32x4 acc[2][2][4][2];
#pragma unroll
    for (int a = 0; a < 2; ++a)
#pragma unroll
        for (int b = 0; b < 2; ++b)
#pragma unroll
            for (int m = 0; m < 4; ++m)
#pragma unroll
                for (int n = 0; n < 2; ++n) acc[a][b][m][n] = (f32x4){0.f, 0.f, 0.f, 0.f};
    bf16x8 At[4][2], B0[2][2], B1[2][2];
    const char* cA = (const char*)g.A + (size_t)cur.pm * tstep; const char* cB = (const char*)g.Bt + (size_t)cur.pn * tstep;
    S.a_ready(cur);
    if constexpr (SP2) {
        PG8_STAGE(PG8_SB(0, 0), cB, voffB); PG8_STAGE(PG8_SB(0, 1), cB + hstep, voffB); PG8_STAGE(PG8_SA(0, 0), cA, voffA); PG8_STAGE(PG8_SA(0, 1), cA + hstep, voffA);
        if (wr == 1) PG8_BAR;
        PG8_WAIT_V(2); PG8_BAR;
        PG8_STAGE(PG8_SB(1, 0), cB + kstep, voffB); PG8_STAGE(PG8_SA(1, 0), cA + kstep, voffA); PG8_STAGE(PG8_SB(1, 1), cB + hstep + kstep, voffB);
        PG8_WAIT_V(6); PG8_BAR;
    } else {
        PG8_STAGE(PG8_SB(0, 0), cB, voffB); PG8_STAGE(PG8_SA(0, 0), cA, voffA); PG8_STAGE(PG8_SB(0, 1), cB + hstep, voffB); PG8_STAGE(PG8_SA(0, 1), cA + hstep, voffA);
        if (wr == 1) PG8_BAR;
        PG8_WAIT_V(4); PG8_BAR;
        PG8_STAGE(PG8_SB(1, 0), cB + kstep, voffB); PG8_STAGE(PG8_SA(1, 0), cA + kstep, voffA); PG8_STAGE(PG8_SB(1, 1), cB + hstep + kstep, voffB);
        PG8_WAIT_V(6); PG8_BAR;
    }
    for (;;) {
        const bool has_next = S.next(ui + 1, nxt);
        const char* nA = has_next ? (const char*)g.A + (size_t)nxt.pm * tstep : cA; const char* nB = has_next ? (const char*)g.Bt + (size_t)nxt.pn * tstep : cB;
        for (int t = 0; t < nt; t += 2) {
            const bool last = (t == nt - 2);
            const char* a1 = cA + (size_t)(t + 1) * kstep;
            const char* a2 = last ? nA : cA + (size_t)(t + 2) * kstep; const char* b2 = last ? nB : cB + (size_t)(t + 2) * kstep;
            const char* a3 = a2 + kstep; const char* b3 = b2 + kstep;
            if (last && has_next) S.a_ready(nxt);
            if constexpr (SP2) {
            PG8_LDB(B0, 0, 0); PG8_LDB(B1, 0, 1); PG8_SCHED; PG8_LDA(At, 0, 0); PG8_STAGE(PG8_SA(1, 1), a1 + hstep, voffA);
            PG8_WAIT_V(8); PG8_WAIT_L(0); PG8_BAR; PG8_MMA(0, 0, At, B0); PG8_MMA(0, 1, At, B1); PG8_BAR; PG8_SCHED;
            PG8_LDA(At, 0, 1); PG8_STAGE(PG8_SB(0, 0), b2, voffB); PG8_STAGE(PG8_SB(0, 1), b2 + hstep, voffB); PG8_STAGE(PG8_SA(0, 0), a2, voffA);
            PG8_WAIT_V(8); PG8_WAIT_L(0); PG8_BAR; PG8_MMA(1, 0, At, B0); PG8_MMA(1, 1, At, B1); PG8_BAR; PG8_SCHED;
            PG8_LDB(B0, 1, 0); PG8_LDB(B1, 1, 1); PG8_SCHED; PG8_LDA(At, 1, 0); PG8_STAGE(PG8_SA(0, 1), a2 + hstep, voffA);
            PG8_WAIT_V(8); PG8_WAIT_L(0); PG8_BAR; PG8_MMA(0, 0, At, B0); PG8_MMA(0, 1, At, B1); PG8_BAR; PG8_SCHED;
            PG8_LDA(At, 1, 1); PG8_STAGE(PG8_SB(1, 0), b3, voffB); PG8_STAGE(PG8_SB(1, 1), b3 + hstep, voffB); PG8_STAGE(PG8_SA(1, 0), a3, voffA);
            PG8_WAIT_V(8); PG8_WAIT_L(0); PG8_BAR; PG8_MMA(1, 0, At, B0); PG8_MMA(1, 1, At, B1); PG8_BAR; PG8_SCHED;
            } else {
            PG8_LDB(B0, 0, 0); PG8_SCHED; PG8_LDA(At, 0, 0); PG8_STAGE(PG8_SA(1, 1), a1 + hstep, voffA);
            PG8_WAIT_L(8); PG8_BAR; PG8_WAIT_L(0); PG8_MMA(0, 0, At, B0); PG8_BAR; PG8_SCHED;
            PG8_LDB(B1, 0, 1); PG8_STAGE(PG8_SB(0, 0), b2, voffB);
            PG8_BAR; PG8_WAIT_L(0); PG8_MMA(0, 1, At, B1); PG8_BAR;
            PG8_LDA(At, 0, 1); PG8_STAGE(PG8_SA(0, 0), a2, voffA);
            PG8_BAR; PG8_WAIT_L(0); PG8_MMA(1, 0, At, B0); PG8_BAR; PG8_SCHED;
            PG8_STAGE(PG8_SB(0, 1), b2 + hstep, voffB);
            PG8_WAIT_V(6); PG8_BAR; PG8_MMA(1, 1, At, B1); PG8_BAR;
            PG8_LDB(B0, 1, 0); PG8_SCHED; PG8_LDA(At, 1, 0); PG8_STAGE(PG8_SA(0, 1), a2 + hstep, voffA);
            PG8_WAIT_L(8); PG8_BAR; PG8_WAIT_L(0); PG8_MMA(0, 0, At, B0); PG8_BAR; PG8_SCHED;
            PG8_LDB(B1, 1, 1); PG8_STAGE(PG8_SB(1, 0), b3, voffB);
            PG8_BAR; PG8_WAIT_L(0); PG8_MMA(0, 1, At, B1); PG8_BAR;
            PG8_LDA(At, 1, 1); PG8_STAGE(PG8_SA(1, 0), a3, voffA);
            PG8_BAR; PG8_WAIT_L(0); PG8_MMA(1, 0, At, B0); PG8_BAR; PG8_SCHED;
            PG8_STAGE(PG8_SB(1, 1), b3 + hstep, voffB);
            PG8_WAIT_V(6); PG8_BAR; PG8_MMA(1, 1, At, B1); PG8_BAR;
            }
        }
        if constexpr (ALIGN_EPI) { if (wr == 0) PG8_BAR; }
        if constexpr (!Epi::AFTER_DRAIN) { E(acc, cur, wr, wc, fr, fq); S.done(cur); }
        if (!has_next) break;
#pragma unroll
        for (int a = 0; a < 2; ++a)
#pragma unroll
            for (int b = 0; b < 2; ++b)
#pragma unroll
                for (int m = 0; m < 4; ++m)
#pragma unroll
                    for (int n = 0; n < 2; ++n) acc[a][b][m][n] = (f32x4){0.f, 0.f, 0.f, 0.f};
        cur = nxt; cA = nA; cB = nB; ++ui;
        if constexpr (ALIGN_EPI) { if (wr == 1) PG8_BAR; }
    }
    PG8_WAIT_V(0);
    if constexpr (!ALIGN_EPI) { if (wr == 0) PG8_BAR; }
    PG8_BAR;
    if constexpr (Epi::AFTER_DRAIN) { E.fused(acc, cur, wr, wc, fr, fq, lds, wid, lane); S.done(cur); }
#undef PG8_SA
#undef PG8_SB
#undef PG8_STAGE
#undef PG8_LDA
#undef PG8_LDB
#undef PG8_MMA
#undef PG8_WAIT_V
#undef PG8_WAIT_L
#undef PG8_BAR
#undef PG8_SCHED
}
}
#define LAS __attribute__((address_space(3)))
#define DI __device__ __forceinline__
typedef unsigned short bf16;
typedef short bf16x8 __attribute__((ext_vector_type(8)));
typedef short s16x4 __attribute__((ext_vector_type(4)));
typedef float f32x2 __attribute__((ext_vector_type(2)));
typedef float f32x4 __attribute__((ext_vector_type(4)));
typedef float f32x16 __attribute__((ext_vector_type(16)));
typedef unsigned u32x2 __attribute__((ext_vector_type(2)));
typedef unsigned u32x4 __attribute__((ext_vector_type(4)));
using pg8::cvt_pk_bf16;
#define MFMA32(a, b, c) __builtin_amdgcn_mfma_f32_32x32x16_bf16((a), (b), (c), 0, 0, 0)

constexpr int T = 8192, DM = 2048, NWAVES = 8;
constexpr int NIN = 10544, NINP = 10752;
constexpr float LOG2E = 1.4426950408889634f, LN2 = 0.6931471805599453f, NEGBIG = -1e30f, EPS = 1e-6f;

constexpr size_t MiB = 1u << 20;
constexpr size_t WS_SUMSQ1 = 0, WS_SUMSQ2 = 32768, WS_BAR = 65536, CTL_ZERO_BYTES = 65536 + 16384;
constexpr size_t WS_WCK1T = 1 * MiB, WS_WCV1T = 1 * MiB + 512 * 1024, WS_WCK2T = 2 * MiB, WS_WCV2T = 2 * MiB + 16384, WS_SK1 = 2 * MiB + 32768, WS_SK2 = 2 * MiB + 65536,
                 WS_PEBK = 2 * MiB + 98304, WS_PEBV = 2 * MiB + 98304 + 512, WS_KX = 3 * MiB, WS_VXT = 3 * MiB + 262144, WS_KC = 3 * MiB + 524288, WS_VCT = 3 * MiB + 524288 + 131072,
                 WS_LSE = 4 * MiB, WS_GINV = 5 * MiB, WS_MN = 6 * MiB;
constexpr size_t WS_WIN = 8 * MiB, WS_WUPA = 50 * MiB, WS_WUPB = 52 * MiB, WS_WOUT = 56 * MiB, WS_WXQ = 64 * MiB, WS_WXKV = 66 * MiB, WS_WXO = 70 * MiB, WS_WPQ = 72 * MiB;
constexpr size_t WS_EU = 80 * MiB, WS_EV = 112 * MiB;
constexpr size_t WS_N = 208 * MiB, WS_MIXTMP = 208 * MiB, WS_AQ = 240 * MiB, WS_AK = 264 * MiB, WS_AVT = 288 * MiB, WS_BQ = 312 * MiB;
constexpr size_t WS_KCS = 328 * MiB, WS_VCS = 330 * MiB, WS_KS = 332 * MiB, WS_VST = 334 * MiB, WS_KW = 336 * MiB, WS_VWT = 338 * MiB, WS_BG = 340 * MiB, WS_MG = 342 * MiB;
constexpr size_t WS_OA = 406 * MiB, WS_YA = 431 * MiB, WS_YB = 439 * MiB, WS_MIX = 455 * MiB, WS_END = 487 * MiB;
constexpr size_t WS_H1G = 240 * MiB, WS_QX = 272 * MiB, WS_OX = 280 * MiB, WS_H2G = 288 * MiB, WS_PQ = 320 * MiB, WS_EID = 352 * MiB, WS_GW = 356 * MiB;
constexpr int LDSCTL_OFF = 131072;
constexpr int LDS_BYTES = 147456;

struct Args { const float* in[25]; float* out; unsigned char* ws; int ph_lo, ph_hi; };

DI float bflo(unsigned w) { return __uint_as_float(w << 16); }
DI float bfhi(unsigned w) { return __uint_as_float(w & 0xffff0000u); }
DI float bf2f(bf16 b) { return __uint_as_float(((unsigned)b) << 16); }
DI bf16 f2bf(float f) { return (bf16)(cvt_pk_bf16(f, 0.f) & 0xffffu); }
DI float fexp2(float x) { return __builtin_amdgcn_exp2f(x); }
DI float sigm(float x) { return 1.f / (1.f + __expf(-x)); }
DI float gelu_tanh(float x) { const float u = 0.7978845608028654f * (x + 0.044715f * x * x * x); return x / (1.f + __expf(-2.f * u)); }
DI int crow(int r, int h) { return (r & 3) + 8 * (r >> 2) + 4 * h; }
DI float wave_sum(float v) {
#pragma unroll
    for (int o = 1; o < 64; o <<= 1) v += __shfl_xor(v, o);
    return v;
}
DI u32x4 pack8(const f32x4& a, const f32x4& b) { u32x4 w; w.x = cvt_pk_bf16(a[0], a[1]); w.y = cvt_pk_bf16(a[2], a[3]); w.z = cvt_pk_bf16(b[0], b[1]); w.w = cvt_pk_bf16(b[2], b[3]); return w; }
DI bf16x8 pack8f(const float* p) { u32x4 w; w.x = cvt_pk_bf16(p[0], p[1]); w.y = cvt_pk_bf16(p[2], p[3]); w.z = cvt_pk_bf16(p[4], p[5]); w.w = cvt_pk_bf16(p[6], p[7]); return __builtin_bit_cast(bf16x8, w); }
DI bf16x8 cat4(s16x4 a, s16x4 b) { return (bf16x8){a[0], a[1], a[2], a[3], b[0], b[1], b[2], b[3]}; }

struct EpiProj {
    static constexpr bool PERM = true, AFTER_DRAIN = false;
    unsigned char* ws;
    DI void operator()(const f32x4 (&acc)[2][2][4][2], const pg8::Unit& u, int wr, int wc, int fr, int fq) const {
#pragma unroll
        for (int bj = 0; bj < 2; ++bj) {
            const int c8 = u.pn * 256 + bj * 128 + wc * 32 + 8 * fq;
            if (c8 >= NIN) continue;
            const int r0 = u.pm * 256 + wr * 64 + fr;
            if (c8 < 4608) {
                const int qkv = c8 / 1536, rem = c8 % 1536, g = rem / 512, hh = (rem % 512) / 128, d = rem % 128, ld = 2 * g, dm1 = (1 << ld) - 1;
                if (qkv < 2) {
                    bf16* base = (bf16*)(ws + (qkv == 0 ? WS_AQ : WS_AK)) + (size_t)(g * 4 + hh) * T * 128 + d;
#pragma unroll
                    for (int ai = 0; ai < 2; ++ai)
#pragma unroll
                        for (int m = 0; m < 4; ++m) { const int t = r0 + ai * 128 + m * 16, tp = ((t & dm1) << (13 - ld)) + (t >> ld);
                            *(u32x4*)(base + (size_t)tp * 128) = pack8(acc[ai][bj][m][0], acc[ai][bj][m][1]); }
                } else {
                    bf16* base = (bf16*)(ws + WS_AVT) + (size_t)((g * 4 + hh) * 128 + d) * T;
#pragma unroll
                    for (int ai = 0; ai < 2; ++ai)
#pragma unroll
                        for (int m = 0; m < 4; ++m) { const int t = r0 + ai * 128 + m * 16, tp = ((t & dm1) << (13 - ld)) + (t >> ld);
#pragma unroll
                            for (int e = 0; e < 8; ++e) base[(size_t)e * T + tp] = f2bf(acc[ai][bj][m][e >> 2][e & 3]); }
                }
            } else if (c8 < 5632) {
                bf16* base = (bf16*)(ws + WS_BQ) + (c8 - 4608);
#pragma unroll
                for (int ai = 0; ai < 2; ++ai)
#pragma unroll
                    for (int m = 0; m < 4; ++m) { const int t = r0 + ai * 128 + m * 16; *(u32x4*)(base + (size_t)t * 1024) = pack8(acc[ai][bj][m][0], acc[ai][bj][m][1]); }
            } else if (c8 < 6400) {
                const int c = c8 - 5632, br = c / 256, kv = (c % 256) / 128, G = (c % 128) / 64, d = c % 64;
                if (kv == 0 || br == 0) {
                    const size_t off = kv == 0 ? (br == 0 ? WS_KCS : br == 1 ? WS_KS : WS_KW) : WS_VCS;
                    bf16* base = (bf16*)(ws + off) + (size_t)G * T * 64 + d;
#pragma unroll
                    for (int ai = 0; ai < 2; ++ai)
#pragma unroll
                        for (int m = 0; m < 4; ++m) { const int t = r0 + ai * 128 + m * 16; *(u32x4*)(base + (size_t)t * 64) = pack8(acc[ai][bj][m][0], acc[ai][bj][m][1]); }
                } else {
                    bf16* base = (bf16*)(ws + (br == 1 ? WS_VST : WS_VWT)) + (size_t)(G * 64 + d) * T;
#pragma unroll
                    for (int ai = 0; ai < 2; ++ai)
#pragma unroll
                        for (int m = 0; m < 4; ++m) { const int t = r0 + ai * 128 + m * 16;
#pragma unroll
                            for (int e = 0; e < 8; ++e) base[(size_t)e * T + t] = f2bf(acc[ai][bj][m][e >> 2][e & 3]); }
                }
            } else if (c8 < 10496) {
                bf16* base = (bf16*)(ws + WS_MG) + (c8 - 6400);
#pragma unroll
                for (int ai = 0; ai < 2; ++ai)
#pragma unroll
                    for (int m = 0; m < 4; ++m) { const int t = r0 + ai * 128 + m * 16; f32x4 a = acc[ai][bj][m][0], b = acc[ai][bj][m][1];
#pragma unroll
                        for (int e = 0; e < 4; ++e) { a[e] = sigm(a[e]); b[e] = sigm(b[e]); }
                        *(u32x4*)(base + (size_t)t * 4096) = pack8(a, b); }
            } else {
                float* base = (float*)(ws + WS_BG) + (c8 - 10496);
#pragma unroll
                for (int ai = 0; ai < 2; ++ai)
#pragma unroll
                    for (int m = 0; m < 4; ++m) { const int t = r0 + ai * 128 + m * 16; f32x4 a = acc[ai][bj][m][0], b = acc[ai][bj][m][1];
#pragma unroll
                        for (int e = 0; e < 4; ++e) { a[e] = sigm(a[e]); b[e] = sigm(b[e]); }
                        *(f32x4*)(base + (size_t)t * 48) = a; *(f32x4*)(base + (size_t)t * 48 + 4) = b; }
            }
        }
    }
};
struct EpiKvx {
    static constexpr bool PERM = true, AFTER_DRAIN = false;
    unsigned char* ws;
    DI void operator()(const f32x4 (&acc)[2][2][4][2], const pg8::Unit& u, int wr, int wc, int fr, int fq) const {
#pragma unroll
        for (int bj = 0; bj < 2; ++bj) {
            const int c8 = u.pn * 256 + bj * 128 + wc * 32 + 8 * fq, kvi = c8 / 512, hx = (c8 % 512) / 128, d = c8 % 128, r0 = wr * 64 + fr;
#pragma unroll
            for (int ai = 0; ai < 2; ++ai)
#pragma unroll
                for (int m = 0; m < 4; ++m) { const int row = r0 + ai * 128 + m * 16;
                    if (kvi == 0) *(u32x4*)((bf16*)(ws + WS_KX) + (size_t)(hx * 256 + row) * 128 + d) = pack8(acc[ai][bj][m][0], acc[ai][bj][m][1]);
                    else {
#pragma unroll
                        for (int e = 0; e < 8; ++e) ((bf16*)(ws + WS_VXT))[(size_t)(hx * 128 + d + e) * 256 + row] = f2bf(acc[ai][bj][m][e >> 2][e & 3]); } }
        }
    }
};
template <int SECOND> struct EpiMix {
    static constexpr bool PERM = true, AFTER_DRAIN = false;
    unsigned char* ws;
    DI void operator()(const f32x4 (&acc)[2][2][4][2], const pg8::Unit& u, int wr, int wc, int fr, int fq) const {
#pragma unroll
        for (int bj = 0; bj < 2; ++bj) {
            const int c8 = u.pn * 256 + bj * 128 + wc * 32 + 8 * fq, r0 = u.pm * 256 + wr * 64 + fr;
#pragma unroll
            for (int ai = 0; ai < 2; ++ai)
#pragma unroll
                for (int m = 0; m < 4; ++m) { const int t = r0 + ai * 128 + m * 16;
                    const u32x4 gt = *(const u32x4*)((const bf16*)(ws + WS_MG) + (size_t)t * 4096 + SECOND * 2048 + c8);
                    f32x4 a = acc[ai][bj][m][0], b = acc[ai][bj][m][1];
                    a[0] *= bflo(gt.x); a[1] *= bfhi(gt.x); a[2] *= bflo(gt.y); a[3] *= bfhi(gt.y); b[0] *= bflo(gt.z); b[1] *= bfhi(gt.z); b[2] *= bflo(gt.w); b[3] *= bfhi(gt.w);
                    if (SECOND) { const u32x4 p = *(const u32x4*)((const bf16*)(ws + WS_MIXTMP) + (size_t)t * 2048 + c8);
                        a[0] += bflo(p.x); a[1] += bfhi(p.x); a[2] += bflo(p.y); a[3] += bfhi(p.y); b[0] += bflo(p.z); b[1] += bfhi(p.z); b[2] += bflo(p.w); b[3] += bfhi(p.w); }
                    *(u32x4*)((bf16*)(ws + (SECOND ? WS_MIX : WS_MIXTMP)) + (size_t)t * 2048 + c8) = pack8(a, b); }
        }
    }
};
struct EpiRes {
    static constexpr bool PERM = false, AFTER_DRAIN = false;
    const float* base; float* out; bf16* hg; const float* gain; float* sumsq;
    DI void operator()(const f32x4 (&acc)[2][2][4][2], const pg8::Unit& u, int wr, int wc, int fr, int fq) const {
        const int r0 = u.pm * 256 + wr * 64 + fr, c0 = u.pn * 256 + wc * 32 + 4 * fq;
#pragma unroll
        for (int ai = 0; ai < 2; ++ai)
#pragma unroll
            for (int m = 0; m < 4; ++m) { const int t = r0 + ai * 128 + m * 16; float ss = 0.f;
#pragma unroll
                for (int bj = 0; bj < 2; ++bj)
#pragma unroll
                    for (int n = 0; n < 2; ++n) { const int c = c0 + bj * 128 + 16 * n; const size_t off = (size_t)t * DM + c;
                        const f32x4 h = *(const f32x4*)(base + off) + acc[ai][bj][m][n]; const f32x4 g = *(const f32x4*)(gain + c);
                        *(f32x4*)(out + off) = h; ss += (h[0] * h[0] + h[1] * h[1]) + (h[2] * h[2] + h[3] * h[3]);
                        u32x2 w; w.x = cvt_pk_bf16(h[0] * g[0], h[1] * g[1]); w.y = cvt_pk_bf16(h[2] * g[2], h[3] * g[3]); *(u32x2*)(hg + off) = w; }
                ss += __shfl_xor(ss, 16); ss += __shfl_xor(ss, 32);
                if (fq == 0) atomicAdd(sumsq + t, ss); }
    }
};
struct EpiScaleRow {
    static constexpr bool PERM = true, AFTER_DRAIN = false;
    bf16* O; int ldc; const float* sumsq;
    DI void operator()(const f32x4 (&acc)[2][2][4][2], const pg8::Unit& u, int wr, int wc, int fr, int fq) const {
        const int r0 = u.pm * 256 + wr * 64 + fr;
#pragma unroll
        for (int ai = 0; ai < 2; ++ai)
#pragma unroll
            for (int m = 0; m < 4; ++m) { const int t = r0 + ai * 128 + m * 16; const float rs = __builtin_amdgcn_rsqf(sumsq[t] * (1.f / DM) + EPS);
#pragma unroll
                for (int bj = 0; bj < 2; ++bj) { const int c8 = u.pn * 256 + bj * 128 + wc * 32 + 8 * fq;
                    *(u32x4*)(O + (size_t)t * ldc + c8) = pack8(acc[ai][bj][m][0] * rs, acc[ai][bj][m][1] * rs); } }
    }
};
template <class RowMap>
DI void transpose_item(const float* W, int K, int N, bf16* WT, LAS float* scr, int item, int lane, RowMap rowmap) {
    const int nblk = (N + 31) / 32, kb = item / nblk, nb = item % nblk, k0 = 64 * kb, n0 = 32 * nb;
    const int nn = n0 + (lane & 31);
#pragma unroll 8
    for (int i = 0; i < 32; ++i) { const int kk = 2 * i + (lane >> 5); scr[kk * 33 + (lane & 31)] = nn < N ? W[(size_t)(k0 + kk) * N + nn] : 0.f; }
    asm volatile("s_waitcnt lgkmcnt(0)" ::: "memory");
    const int c = lane & 7;
#pragma unroll
    for (int j = 0; j < 4; ++j) { const int nl = (lane >> 3) + 8 * j, n = n0 + nl; const LAS float* s = scr + (8 * c) * 33 + nl;
        u32x4 o; o.x = cvt_pk_bf16(s[0 * 33], s[1 * 33]); o.y = cvt_pk_bf16(s[2 * 33], s[3 * 33]); o.z = cvt_pk_bf16(s[4 * 33], s[5 * 33]); o.w = cvt_pk_bf16(s[6 * 33], s[7 * 33]);
        if (n < N) *(u32x4*)(WT + (size_t)rowmap(n) * K + k0 + 8 * c) = o; }
    asm volatile("s_waitcnt lgkmcnt(0)" ::: "memory");
}
struct RowId { DI int operator()(int n) const { return n; } };
struct RowWin { DI int operator()(int n) const { return n < 6400 ? n : (n < 6448 ? n + 4096 : n - 48); } };

DI void rms_row_to_bf16(const float* xrow, const float* gain, bf16* orow, int lane) {
    f32x4 v[8]; float s = 0.f;
#pragma unroll
    for (int j = 0; j < 8; ++j) { v[j] = *(const f32x4*)(xrow + j * 256 + lane * 4); s += (v[j][0] * v[j][0] + v[j][1] * v[j][1]) + (v[j][2] * v[j][2] + v[j][3] * v[j][3]); }
    const float rs = __builtin_amdgcn_rsqf(wave_sum(s) * (1.f / DM) + EPS);
#pragma unroll
    for (int j = 0; j < 8; ++j) { const f32x4 g = *(const f32x4*)(gain + j * 256 + lane * 4); u32x2 w; w.x = cvt_pk_bf16(v[j][0] * rs * g[0], v[j][1] * rs * g[1]); w.y = cvt_pk_bf16(v[j][2] * rs * g[2], v[j][3] * rs * g[3]);
        *(u32x2*)(orow + j * 256 + lane * 4) = w; }
}
DI void phase_prologue(const Args& a, LAS unsigned char* lds, int gw, int NGW, int wave, int lane) {
    unsigned char* ws = a.ws;
    LAS float* scr = (LAS float*)(lds + wave * 16384);
    constexpr int I_WIN = 32 * 330, I_UPA = 8 * 64, I_UPB = 16 * 64, I_OUT = 32 * 64, I_XQ = 32 * 16, I_XKV = 32 * 32, I_XO = 8 * 64, I_PQ = 32 * 64, I_C1 = 32 * 4, I_C2 = 2 * 2;
    constexpr int NITEMS = I_WIN + I_UPA + I_UPB + I_OUT + I_XQ + I_XKV + I_XO + I_PQ + 2 * I_C1 + 2 * I_C2;
    for (int it = gw; it < NITEMS; it += NGW) {
        int r = it;
        if (r < I_WIN) { transpose_item(a.in[3], 2048, NIN, (bf16*)(ws + WS_WIN), scr, r, lane, RowWin()); continue; } r -= I_WIN;
        if (r < I_UPA) { transpose_item(a.in[10], 512, 2048, (bf16*)(ws + WS_WUPA), scr, r, lane, RowId()); continue; } r -= I_UPA;
        if (r < I_UPB) { transpose_item(a.in[11], 1024, 2048, (bf16*)(ws + WS_WUPB), scr, r, lane, RowId()); continue; } r -= I_UPB;
        if (r < I_OUT) { transpose_item(a.in[12], 2048, 2048, (bf16*)(ws + WS_WOUT), scr, r, lane, RowId()); continue; } r -= I_OUT;
        if (r < I_XQ) { transpose_item(a.in[15], 2048, 512, (bf16*)(ws + WS_WXQ), scr, r, lane, RowId()); continue; } r -= I_XQ;
        if (r < I_XKV) { transpose_item(a.in[16], 2048, 1024, (bf16*)(ws + WS_WXKV), scr, r, lane, RowId()); continue; } r -= I_XKV;
        if (r < I_XO) { transpose_item(a.in[17], 512, 2048, (bf16*)(ws + WS_WXO), scr, r, lane, RowId()); continue; } r -= I_XO;
        if (r < I_PQ) { transpose_item(a.in[19], 2048, 2048, (bf16*)(ws + WS_WPQ), scr, r, lane, RowId()); continue; } r -= I_PQ;
        if (r < I_C1) { transpose_item(a.in[4], 2048, 128, (bf16*)(ws + WS_WCK1T), scr, r, lane, RowId()); continue; } r -= I_C1;
        if (r < I_C1) { transpose_item(a.in[7], 2048, 128, (bf16*)(ws + WS_WCV1T), scr, r, lane, RowId()); continue; } r -= I_C1;
        if (r < I_C2) { transpose_item(a.in[5], 128, 64, (bf16*)(ws + WS_WCK2T), scr, r, lane, RowId()); continue; } r -= I_C2;
        transpose_item(a.in[8], 128, 64, (bf16*)(ws + WS_WCV2T), scr, r, lane, RowId());
    }
    { u32x4* p = (u32x4*)((bf16*)(ws + WS_WIN) + (size_t)NIN * 2048); const int n16 = (NINP - NIN) * 2048 / 8;
      for (int i = gw * 64 + lane; i < n16; i += NGW * 64) p[i] = (u32x4){0u, 0u, 0u, 0u}; }
    for (int m = gw; m < T + 256; m += NGW) {
        if (m < T) rms_row_to_bf16(a.in[0] + (size_t)m * DM, a.in[2], (bf16*)(ws + WS_N) + (size_t)m * DM, lane);
        else rms_row_to_bf16(a.in[1] + (size_t)(m - T) * DM, a.in[14], (bf16*)(ws + WS_MN) + (size_t)(m - T) * DM, lane);
    }
    {   const size_t tid = (size_t)gw * 64 + lane, nth = (size_t)NGW * 64;
        for (int tb = 0; tb < 2; ++tb) { const f32x4* src = (const f32x4*)a.in[20 + tb]; u32x4* dst = (u32x4*)(ws + (tb ? WS_SK2 : WS_SK1));
            for (size_t i = tid; i < 128 * 128 / 8; i += nth) dst[i] = pack8(src[2 * i], src[2 * i + 1]); }
    }
    for (int o = gw; o < 256; o += NGW) { const int kv = o >> 7, j = o & 127; const float* pe = a.in[kv ? 9 : 6]; const float* w1 = a.in[kv ? 7 : 4]; float s = 0.f;
        for (int i = lane; i < 2048; i += 64) s += pe[i] * w1[(size_t)i * 128 + j];
        s = wave_sum(s); if (lane == 0) ((float*)(ws + (kv ? WS_PEBV : WS_PEBK)))[j] = s; }
}
constexpr float EU_SCALE = 64.f, EV_SCALE = 8.f;
DI unsigned pk4_fp8(const f32x4 v, float sc) {
    const float a = __builtin_amdgcn_fmed3f(v[0] * sc, -448.f, 448.f), b = __builtin_amdgcn_fmed3f(v[1] * sc, -448.f, 448.f), c = __builtin_amdgcn_fmed3f(v[2] * sc, -448.f, 448.f), d = __builtin_amdgcn_fmed3f(v[3] * sc, -448.f, 448.f);
    int w = __builtin_amdgcn_cvt_pk_fp8_f32(a, b, 0, false); w = __builtin_amdgcn_cvt_pk_fp8_f32(c, d, w, true); return (unsigned)w;
}
DI void convert_experts(const Args& a, size_t tid, size_t nth) {
    const size_t n16 = (size_t)16384 * 2048 / 16;
    for (int tb = 0; tb < 2; ++tb) { const f32x4* src = (const f32x4*)a.in[22 + tb]; u32x4* dst = (u32x4*)(a.ws + (tb ? WS_EV : WS_EU)); const float sc = tb ? EV_SCALE : EU_SCALE;
        for (size_t i = tid; i < n16; i += nth) { const f32x4 x0 = __builtin_nontemporal_load(src + 4 * i), x1 = __builtin_nontemporal_load(src + 4 * i + 1), x2 = __builtin_nontemporal_load(src + 4 * i + 2), x3 = __builtin_nontemporal_load(src + 4 * i + 3);
            u32x4 w; w.x = pk4_fp8(x0, sc); w.y = pk4_fp8(x1, sc); w.z = pk4_fp8(x2, sc); w.w = pk4_fp8(x3, sc); dst[i] = w; } }
}
template <int HD, class SF>
DI void attn_tile(const bf16x8 (&q)[HD / 16], const bf16* kptr, const bf16* vptr, size_t vs32, float& m, float& l, f32x16 (&o)[HD / 32], SF sf) {
    f32x16 s;
#pragma unroll
    for (int r = 0; r < 16; ++r) s[r] = 0.f;
#pragma unroll
    for (int ks = 0; ks < HD / 16; ++ks) s = MFMA32(*(const bf16x8*)(kptr + 16 * ks), q[ks], s);
    float v[16]; float tmax = NEGBIG;
#pragma unroll
    for (int r = 0; r < 16; ++r) { v[r] = sf(r, s[r]); tmax = fmaxf(tmax, v[r]); }
    tmax = fmaxf(tmax, __shfl_xor(tmax, 32));
    const float mn = fmaxf(m, tmax), alpha = fexp2(m - mn);
    float p[16]; float ps = 0.f;
#pragma unroll
    for (int r = 0; r < 16; ++r) { p[r] = v[r] > -1e29f ? fexp2(v[r] - mn) : 0.f; ps += p[r]; }
    ps += __shfl_xor(ps, 32);
    l = l * alpha + ps; m = mn;
    const bf16x8 pf0 = pack8f(p), pf1 = pack8f(p + 8);
#pragma unroll
    for (int dt = 0; dt < HD / 32; ++dt) {
        const bf16* vp = vptr + dt * vs32;
        const s16x4 a0 = *(const s16x4*)(vp), a1 = *(const s16x4*)(vp + 8), b0 = *(const s16x4*)(vp + 16), b1 = *(const s16x4*)(vp + 24);
        o[dt] = o[dt] * alpha;
        o[dt] = MFMA32(cat4(a0, a1), pf0, o[dt]);
        o[dt] = MFMA32(cat4(b0, b1), pf1, o[dt]);
    }
}
template <int NT>
DI void store_ot(bf16* orow, const f32x16 (&o)[NT], float scale, int h) {
#pragma unroll
    for (int dt = 0; dt < NT; ++dt)
#pragma unroll
        for (int rg = 0; rg < 4; ++rg) { u32x2 w; w.x = cvt_pk_bf16(o[dt][4 * rg] * scale, o[dt][4 * rg + 1] * scale); w.y = cvt_pk_bf16(o[dt][4 * rg + 2] * scale, o[dt][4 * rg + 3] * scale);
            *(u32x2*)(orow + 32 * dt + 8 * rg + 4 * h) = w; }
}

DI void dilated_item(unsigned char* ws, int item, int w, int lane) {
    const int g = item >> 8, rem = item & 255, hh = rem >> 6, nb = rem & 63, ld = 2 * g, dil = 1 << ld, nbk = 64 >> ld, n = nb / nbk, b = nb % nbk, L = T >> ld;
    const int i32 = lane & 31, h = lane >> 5, iq = 32 * w + i32, rowbase = n * L + 128 * b, gh = g * 4 + hh;
    const bf16* Q = (const bf16*)(ws + WS_AQ) + ((size_t)gh * T + rowbase + iq) * 128 + 8 * h;
    const bf16* K = (const bf16*)(ws + WS_AK) + ((long)gh * T + rowbase - 128 + i32) * 128 + 8 * h;
    const bf16* V = (const bf16*)(ws + WS_AVT) + ((long)gh * 128 + i32) * T + (rowbase - 128) + 4 * h;
    bf16x8 q[8];
#pragma unroll
    for (int ks = 0; ks < 8; ++ks) q[ks] = *(const bf16x8*)(Q + 16 * ks);
    const float slope = exp2f(-8.f * (float)(gh + 1) / 12.f), sl2 = slope * (float)dil * LOG2E, sc2 = 0.08838834764831845f * LOG2E;
    f32x16 o[4];
#pragma unroll
    for (int dt = 0; dt < 4; ++dt)
#pragma unroll
        for (int r = 0; r < 16; ++r) o[dt][r] = 0.f;
    float m = NEGBIG, l = 0.f;
#pragma unroll 1
    for (int tt = 0; tt < 5; ++tt) {
        const int j0 = 32 * w + 32 * tt;
        if (b == 0 && j0 < 128) continue;
        attn_tile<128>(q, K + (size_t)j0 * 128, V + j0, (size_t)32 * T, m, l, o, [&](int r, float raw) {
            const int rel = iq + 128 - (j0 + crow(r, h)); return (rel >= 0 && rel <= 128) ? raw * sc2 - sl2 * (float)rel : NEGBIG; });
    }
    const int t = (128 * b + iq) * dil + n;
    store_ot<4>((bf16*)(ws + WS_OA) + ((size_t)g * T + t) * 512 + hh * 128, o, 1.f / l, h);
    if (h == 0) ((float*)(ws + WS_LSE))[((size_t)g * T + t) * 4 + hh] = (m + __log2f(l)) * LN2;
}
DI void compress_item(unsigned char* ws, int item, int lane) {
    const int kv = item >> 5, G = (item >> 4) & 1, rt = item & 15, i32 = lane & 31, h = lane >> 5;
    const int c = rt * 32 + i32, cc = c < 511 ? c : 510;
    const bf16* A = (const bf16*)(ws + (kv ? WS_VCS : WS_KCS)) + (size_t)G * T * 64 + (size_t)cc * 1024 + 8 * h;
    const bf16* W1 = (const bf16*)(ws + (kv ? WS_WCV1T : WS_WCK1T)) + (size_t)i32 * 2048 + 8 * h;
    f32x16 hid[4];
#pragma unroll
    for (int jt = 0; jt < 4; ++jt)
#pragma unroll
        for (int r = 0; r < 16; ++r) hid[jt][r] = 0.f;
#pragma unroll 1
    for (int ks = 0; ks < 128; ++ks) {
        const bf16x8 af = *(const bf16x8*)(A + 16 * ks);
#pragma unroll
        for (int jt = 0; jt < 4; ++jt) hid[jt] = MFMA32(*(const bf16x8*)(W1 + (size_t)jt * 32 * 2048 + 16 * ks), af, hid[jt]);
    }
    const float* peb = (const float*)(ws + (kv ? WS_PEBV : WS_PEBK));
    bf16x8 pf[4][2];
#pragma unroll
    for (int jt = 0; jt < 4; ++jt) { float gl[16];
#pragma unroll
        for (int r = 0; r < 16; ++r) gl[r] = gelu_tanh(hid[jt][r] + peb[jt * 32 + crow(r, h)]);
        pf[jt][0] = pack8f(gl); pf[jt][1] = pack8f(gl + 8); }
    const bf16* W2 = (const bf16*)(ws + (kv ? WS_WCV2T : WS_WCK2T)) + (size_t)i32 * 128 + 4 * h;
    f32x16 o[2];
#pragma unroll
    for (int dt = 0; dt < 2; ++dt) {
#pragma unroll
        for (int r = 0; r < 16; ++r) o[dt][r] = 0.f;
#pragma unroll
        for (int jt = 0; jt < 4; ++jt) { const bf16* wp = W2 + (size_t)dt * 32 * 128 + jt * 32;
            o[dt] = MFMA32(cat4(*(const s16x4*)(wp), *(const s16x4*)(wp + 8)), pf[jt][0], o[dt]);
            o[dt] = MFMA32(cat4(*(const s16x4*)(wp + 16), *(const s16x4*)(wp + 24)), pf[jt][1], o[dt]); }
    }
    const float keep = c < 511 ? 1.f : 0.f;
    if (kv == 0) store_ot<2>((bf16*)(ws + WS_KC) + ((size_t)G * 512 + c) * 64, o, keep, h);
    else {
        bf16* vt = (bf16*)(ws + WS_VCT) + (size_t)G * 64 * 512 + c;
#pragma unroll
        for (int dt = 0; dt < 2; ++dt)
#pragma unroll
            for (int r = 0; r < 16; ++r) vt[(size_t)(32 * dt + crow(r, h)) * 512] = f2bf(o[dt][r] * keep);
    }
}
DI void nsa_item(unsigned char* ws, int G, int chunk, LAS float* pc  , int lane) {
    const int i32 = lane & 31, h = lane >> 5, tok = i32 >> 3, hh = G * 8 + (i32 & 7), t0 = chunk * 4, t = t0 + tok;
    const float slope = exp2f(-0.5f * (float)(hh + 1)), sl2 = slope * LOG2E, sc2 = 0.125f * LOG2E;
    bf16x8 q[4];
    { const bf16* Q = (const bf16*)(ws + WS_BQ) + (size_t)t * 1024 + hh * 64 + 8 * h;
#pragma unroll
      for (int ks = 0; ks < 4; ++ks) q[ks] = *(const bf16x8*)(Q + 16 * ks); }
    const float* gate = (const float*)(ws + WS_BG) + (size_t)t * 48 + hh * 3;
    const float g_c = gate[0], g_s = gate[1], g_w = gate[2];
    f32x16 y[2], o[2];
#pragma unroll
    for (int dt = 0; dt < 2; ++dt)
#pragma unroll
        for (int r = 0; r < 16; ++r) { y[dt][r] = 0.f; o[dt][r] = 0.f; }
    const int cv = t >= 31 ? ((t - 31) >> 4) : -1;
    const int cmaxw = t0 + 3 >= 31 ? ((t0 + 3 - 31) >> 4) : -1;
    const int nct = cmaxw >= 0 ? (cmaxw >> 5) + 1 : 0;
    const bf16* KC = (const bf16*)(ws + WS_KC) + ((size_t)G * 512 + i32) * 64 + 8 * h;
    const bf16* VC = (const bf16*)(ws + WS_VCT) + ((size_t)G * 64 + i32) * 512 + 4 * h;
    float m = NEGBIG, l = 0.f;
    for (int ct = 0; ct < nct; ++ct) {
        f32x16 s;
#pragma unroll
        for (int r = 0; r < 16; ++r) s[r] = 0.f;
#pragma unroll
        for (int ks = 0; ks < 4; ++ks) s = MFMA32(*(const bf16x8*)(KC + (size_t)ct * 32 * 64 + 16 * ks), q[ks], s);
        float v[16]; float tmax = NEGBIG;
#pragma unroll
        for (int r = 0; r < 16; ++r) { const int c = ct * 32 + crow(r, h); v[r] = c <= cv ? s[r] * sc2 - sl2 * (float)(t - 16 * c - 31) : NEGBIG; tmax = fmaxf(tmax, v[r]); }
        tmax = fmaxf(tmax, __shfl_xor(tmax, 32));
        const float mn = fmaxf(m, tmax); float ps = 0.f;
#pragma unroll
        for (int r = 0; r < 16; ++r) ps += v[r] > -1e29f ? fexp2(v[r] - mn) : 0.f;
        ps += __shfl_xor(ps, 32);
        l = l * fexp2(m - mn) + ps; m = mn;
    }
    const float inv_c = l > 0.f ? 1.f / l : 0.f;
    for (int ct = 0; ct < nct; ++ct) {
        f32x16 s;
#pragma unroll
        for (int r = 0; r < 16; ++r) s[r] = 0.f;
#pragma unroll
        for (int ks = 0; ks < 4; ++ks) s = MFMA32(*(const bf16x8*)(KC + (size_t)ct * 32 * 64 + 16 * ks), q[ks], s);
        float p[16];
#pragma unroll
        for (int r = 0; r < 16; ++r) { const int c = ct * 32 + crow(r, h); p[r] = c <= cv ? fexp2(s[r] * sc2 - sl2 * (float)(t - 16 * c - 31) - m) * inv_c : 0.f; }
        const bf16x8 pf0 = pack8f(p), pf1 = pack8f(p + 8);
#pragma unroll
        for (int dt = 0; dt < 2; ++dt) { const bf16* vp = VC + (size_t)dt * 32 * 512 + ct * 32;
            o[dt] = MFMA32(cat4(*(const s16x4*)(vp), *(const s16x4*)(vp + 8)), pf0, o[dt]);
            o[dt] = MFMA32(cat4(*(const s16x4*)(vp + 16), *(const s16x4*)(vp + 24)), pf1, o[dt]); }
#pragma unroll
        for (int r = 0; r < 16; ++r) { float x = p[r]; x += __shfl_xor(x, 1); x += __shfl_xor(x, 2); x += __shfl_xor(x, 4);
            if ((i32 & 7) == 0) pc[tok * 512 + ct * 32 + crow(r, h)] = x; }
    }
#pragma unroll
    for (int dt = 0; dt < 2; ++dt)
#pragma unroll
        for (int r = 0; r < 16; ++r) { y[dt][r] = g_c * o[dt][r]; o[dt][r] = 0.f; }
    asm volatile("s_waitcnt lgkmcnt(0)" ::: "memory");
    unsigned msk[4] = {0u, 0u, 0u, 0u};
    {   const int ts = lane >> 4, l16 = lane & 15, tsel = t0 + ts, cur = tsel >> 6;
        float cand[8];
#pragma unroll
        for (int e = 0; e < 8; ++e) { const int j = l16 * 8 + e; const bool valid = j >= 1 && j <= cur - 2; const LAS float* pp = pc + ts * 512 + 4 * j;
            const int jm = valid ? -1 : 0;
            cand[e] = valid ? (pp[0] + pp[1]) + pp[2] + 0.5f * (pp[3] + pp[jm]) : -1.f; }
        msk[0] |= 1u;
#pragma unroll
        for (int w = 0; w < 4; ++w) { if ((cur >> 5) == w) msk[w] |= 1u << (cur & 31); if (cur >= 1 && ((cur - 1) >> 5) == w) msk[w] |= 1u << ((cur - 1) & 31); }
        for (int round = 0; round < 13; ++round) {
            float bv = -3.f; int bi = 1 << 20;
#pragma unroll
            for (int e = 0; e < 8; ++e) if (cand[e] > bv) { bv = cand[e]; bi = l16 * 8 + e; }
#pragma unroll
            for (int off = 1; off < 16; off <<= 1) { const float ov = __shfl_xor(bv, off); const int oi = __shfl_xor(bi, off); if (ov > bv || (ov == bv && oi < bi)) { bv = ov; bi = oi; } }
            if (bv >= 0.f) {
#pragma unroll
                for (int w = 0; w < 4; ++w) if ((bi >> 5) == w) msk[w] |= 1u << (bi & 31);
#pragma unroll
                for (int e = 0; e < 8; ++e) if (l16 * 8 + e == bi) cand[e] = -2.f;
            }
        }
    }
    unsigned mk[4], U[4];
#pragma unroll
    for (int w = 0; w < 4; ++w) { mk[w] = __shfl(msk[w], tok * 16);
        U[w] = __builtin_amdgcn_readlane(msk[w], 0) | __builtin_amdgcn_readlane(msk[w], 16) | __builtin_amdgcn_readlane(msk[w], 32) | __builtin_amdgcn_readlane(msk[w], 48); }
    const bf16* KS = (const bf16*)(ws + WS_KS) + ((size_t)G * T + i32) * 64 + 8 * h;
    const bf16* VS = (const bf16*)(ws + WS_VST) + ((size_t)G * 64 + i32) * T + 4 * h;
    m = NEGBIG; l = 0.f;
#pragma unroll
    for (int w = 0; w < 4; ++w) {
        unsigned bits = U[w];
        while (bits) {
            const int jb = __builtin_ctz(bits); bits &= bits - 1u;
            const bool mine = (mk[w] >> jb) & 1u;
            for (int half = 0; half < 2; ++half) {
                const int key0 = 64 * (w * 32 + jb) + 32 * half;
                if (key0 > t0 + 3) continue;
                attn_tile<64>(q, KS + (size_t)key0 * 64, VS + key0, (size_t)32 * T, m, l, o, [&](int r, float raw) {
                    const int pos = key0 + crow(r, h); return (mine && pos <= t) ? raw * sc2 - sl2 * (float)(t - pos) : NEGBIG; });
            }
        }
    }
    { const float sc = l > 0.f ? g_s / l : 0.f;
#pragma unroll
      for (int dt = 0; dt < 2; ++dt)
#pragma unroll
          for (int r = 0; r < 16; ++r) { y[dt][r] += sc * o[dt][r]; o[dt][r] = 0.f; } }
    const bf16* KW = (const bf16*)(ws + WS_KW) + ((size_t)G * T + i32) * 64 + 8 * h;
    const bf16* VW = (const bf16*)(ws + WS_VWT) + ((size_t)G * 64 + i32) * T + 4 * h;
    m = NEGBIG; l = 0.f;
    { const int lo = (t0 - 511 > 0 ? t0 - 511 : 0) & ~31;
      for (int key0 = lo; key0 <= t0 + 3; key0 += 32)
          attn_tile<64>(q, KW + (size_t)key0 * 64, VW + key0, (size_t)32 * T, m, l, o, [&](int r, float raw) {
              const int dd = t - (key0 + crow(r, h)); return (dd >= 0 && dd < 512) ? raw * sc2 - sl2 * (float)dd : NEGBIG; }); }
    { const float sc = l > 0.f ? g_w / l : 0.f;
#pragma unroll
      for (int dt = 0; dt < 2; ++dt)
#pragma unroll
          for (int r = 0; r < 16; ++r) y[dt][r] += sc * o[dt][r]; }
    store_ot<2>((bf16*)(ws + WS_YB) + (size_t)t * 1024 + hh * 64, y, 1.f, h);
}
DI void dilated_combine(unsigned char* ws, size_t tid, size_t nth) {
    const float* lse = (const float*)(ws + WS_LSE); const bf16* oa = (const bf16*)(ws + WS_OA); bf16* ya = (bf16*)(ws + WS_YA);
    for (size_t i = tid; i < (size_t)T * 64; i += nth) {
        const size_t t = i >> 6; const int c8 = (int)(i & 63) * 8, hh = c8 >> 7;
        const float l0 = lse[(0 * (size_t)T + t) * 4 + hh], l1 = lse[(1 * (size_t)T + t) * 4 + hh], l2 = lse[(2 * (size_t)T + t) * 4 + hh];
        const float mx = fmaxf(l0, fmaxf(l1, l2)), e0 = __expf(l0 - mx), e1 = __expf(l1 - mx), e2 = __expf(l2 - mx), inv = 1.f / (e0 + e1 + e2);
        const u32x4 a = *(const u32x4*)(oa + (0 * (size_t)T + t) * 512 + c8), b = *(const u32x4*)(oa + (1 * (size_t)T + t) * 512 + c8), c = *(const u32x4*)(oa + (2 * (size_t)T + t) * 512 + c8);
        const float w0 = e0 * inv, w1 = e1 * inv, w2 = e2 * inv; u32x4 r;
        r.x = cvt_pk_bf16(w0 * bflo(a.x) + w1 * bflo(b.x) + w2 * bflo(c.x), w0 * bfhi(a.x) + w1 * bfhi(b.x) + w2 * bfhi(c.x));
        r.y = cvt_pk_bf16(w0 * bflo(a.y) + w1 * bflo(b.y) + w2 * bflo(c.y), w0 * bfhi(a.y) + w1 * bfhi(b.y) + w2 * bfhi(c.y));
        r.z = cvt_pk_bf16(w0 * bflo(a.z) + w1 * bflo(b.z) + w2 * bflo(c.z), w0 * bfhi(a.z) + w1 * bfhi(b.z) + w2 * bfhi(c.z));
        r.w = cvt_pk_bf16(w0 * bflo(a.w) + w1 * bflo(b.w) + w2 * bflo(c.w), w0 * bfhi(a.w) + w1 * bfhi(b.w) + w2 * bfhi(c.w));
        *(u32x4*)(ya + t * 512 + c8) = r;
    }
}
DI void cross_item(unsigned char* ws, int item, int lane) {
    const int hx = item & 3, qt = item >> 2, i32 = lane & 31, h = lane >> 5, t = qt * 32 + i32;
    const bf16* Q = (const bf16*)(ws + WS_QX) + (size_t)t * 512 + hx * 128 + 8 * h;
    bf16x8 q[8];
#pragma unroll
    for (int ks = 0; ks < 8; ++ks) q[ks] = *(const bf16x8*)(Q + 16 * ks);
    const bf16* K = (const bf16*)(ws + WS_KX) + ((size_t)hx * 256 + i32) * 128 + 8 * h;
    const bf16* V = (const bf16*)(ws + WS_VXT) + ((size_t)hx * 128 + i32) * 256 + 4 * h;
    f32x16 o[4];
#pragma unroll
    for (int dt = 0; dt < 4; ++dt)
#pragma unroll
        for (int r = 0; r < 16; ++r) o[dt][r] = 0.f;
    float m = NEGBIG, l = 0.f; const float sc2 = 0.08838834764831845f * LOG2E;
    for (int kt = 0; kt < 8; ++kt)
        attn_tile<128>(q, K + (size_t)kt * 32 * 128, V + kt * 32, (size_t)32 * 256, m, l, o, [&](int r, float raw) { return raw * sc2; });
    store_ot<4>((bf16*)(ws + WS_OX) + (size_t)t * 512 + hx * 128, o, 1.f / l, h);
}
DI void peer_topk_item(unsigned char* ws, int item, LAS float* scr, int lane) {
    const int hp = item & 7, tt = item >> 3, i32 = lane & 31, h = lane >> 5, t = tt * 32 + i32;
    const bf16* Q = (const bf16*)(ws + WS_PQ) + (size_t)t * 2048 + hp * 256 + 8 * h;
    LAS float* my = scr + i32 * 64;
#pragma unroll 1
    for (int z = 0; z < 2; ++z) {
        bf16x8 q[8];
#pragma unroll
        for (int ks = 0; ks < 8; ++ks) q[ks] = *(const bf16x8*)(Q + z * 128 + 16 * ks);
        const bf16* SK = (const bf16*)(ws + (z ? WS_SK2 : WS_SK1)) + (size_t)i32 * 128 + 8 * h;
        f32x16 s[4];
#pragma unroll
        for (int kt = 0; kt < 4; ++kt) {
#pragma unroll
            for (int r = 0; r < 16; ++r) s[kt][r] = 0.f;
#pragma unroll
            for (int ks = 0; ks < 8; ++ks) s[kt] = MFMA32(*(const bf16x8*)(SK + (size_t)kt * 32 * 128 + 16 * ks), q[ks], s[kt]);
        }
#pragma unroll 1
        for (int round = 0; round < 16; ++round) {
            float bv = -3.0e38f; int bi = 1 << 20;
#pragma unroll
            for (int kt = 0; kt < 4; ++kt)
#pragma unroll
                for (int r = 0; r < 16; ++r) if (s[kt][r] > bv) { bv = s[kt][r]; bi = kt * 32 + crow(r, h); }
            { const float ov = __shfl_xor(bv, 32); const int oi = __shfl_xor(bi, 32); if (ov > bv || (ov == bv && oi < bi)) { bv = ov; bi = oi; } }
#pragma unroll
            for (int kt = 0; kt < 4; ++kt)
#pragma unroll
                for (int r = 0; r < 16; ++r) if (kt * 32 + crow(r, h) == bi) s[kt][r] = -3.0e38f;
            if (h == 0) { my[(z * 16 + round) * 2] = bv; my[(z * 16 + round) * 2 + 1] = __int_as_float(bi); }
        }
    }
    asm volatile("s_waitcnt lgkmcnt(0)" ::: "memory");
    float v1[16], v2[16];
#pragma unroll
    for (int k = 0; k < 16; ++k) { v1[k] = my[k * 2]; v2[k] = my[(16 + k) * 2]; }
    float cand[50]; int n = 0;
#pragma unroll
    for (int a = 0; a < 16; ++a)
#pragma unroll
        for (int b = 0; b < 16 / (a + 1); ++b) cand[n++] = v1[a] + v2[b];
    int* eid = (int*)(ws + WS_EID) + (size_t)t * 128 + hp * 16; float* gw = (float*)(ws + WS_GW) + (size_t)t * 128 + hp * 16;
    float vmax = 0.f, esum = 0.f;
#pragma unroll 1
    for (int round = 0; round < 16; ++round) {
        float bv = -3.0e38f; int bc = 0; n = 0;
#pragma unroll
        for (int a = 0; a < 16; ++a)
#pragma unroll
            for (int b = 0; b < 16 / (a + 1); ++b) { if (cand[n] > bv) { bv = cand[n]; bc = a * 16 + b; } ++n; }
        n = 0;
#pragma unroll
        for (int a = 0; a < 16; ++a)
#pragma unroll
            for (int b = 0; b < 16 / (a + 1); ++b) { if (a * 16 + b == bc) cand[n] = -3.0e38f; ++n; }
        if (round == 0) vmax = bv;
        const float e = __expf(bv - vmax); esum += e;
        const int e1 = __float_as_int(my[(bc >> 4) * 2 + 1]), e2 = __float_as_int(my[(16 + (bc & 15)) * 2 + 1]);
        if (h == 0) { eid[round] = e1 * 128 + e2; gw[round] = e; }
    }
    if (h == 0) ((float*)(ws + WS_GINV))[(size_t)t * 8 + hp] = 1.f / esum;
}
DI void peer_load(u32x4 (&R)[4][2], const unsigned char* E, int eA, int eB, int b) {
#pragma unroll
    for (int k = 0; k < 4; ++k) { const int p = 4 * b + k; const int e = b < 16 ? __builtin_amdgcn_readlane(eA, p & 63) : __builtin_amdgcn_readlane(eB, p & 63);
        const unsigned char* rp = E + (size_t)e * DM; R[k][0] = *(const u32x4*)(rp); R[k][1] = *(const u32x4*)(rp + 1024); }
}
DI float peer_dots(const u32x4 (&U)[4][2], const f32x2 (&xs)[16], int lane) {
    float d[4];
#pragma unroll
    for (int k = 0; k < 4; ++k) { f32x2 acc = {0.f, 0.f};
#pragma unroll
        for (int c = 0; c < 2; ++c)
#pragma unroll
            for (int wd = 0; wd < 4; ++wd) { const int w = (int)U[k][c][wd];
                acc = __builtin_elementwise_fma(__builtin_amdgcn_cvt_pk_f32_fp8(w, false), xs[c * 8 + wd * 2], acc);
                acc = __builtin_elementwise_fma(__builtin_amdgcn_cvt_pk_f32_fp8(w, true), xs[c * 8 + wd * 2 + 1], acc); }
        d[k] = acc.x + acc.y; }
    const bool hi32 = lane & 32, hi16 = lane & 16;
    float k0 = hi32 ? d[2] : d[0], k1 = hi32 ? d[3] : d[1];
    k0 += __shfl_xor(hi32 ? d[0] : d[2], 32); k1 += __shfl_xor(hi32 ? d[1] : d[3], 32);
    float kk = hi16 ? k1 : k0; kk += __shfl_xor(hi16 ? k0 : k1, 16);
    kk += __shfl_xor(kk, 8); kk += __shfl_xor(kk, 4); kk += __shfl_xor(kk, 2); kk += __shfl_xor(kk, 1);
    return kk;
}
DI void peer_axpy(const u32x4 (&V)[4][2], float kk, f32x2 (&y)[16], int gA, int gB, int b, float arg_scale) {
#pragma unroll
    for (int k = 0; k < 4; ++k) { const int p = 4 * b + k;
        const float dot = __int_as_float(__builtin_amdgcn_readlane(__float_as_int(kk), 16 * k));
        const float g = __int_as_float(b < 16 ? __builtin_amdgcn_readlane(gA, p & 63) : __builtin_amdgcn_readlane(gB, p & 63));
        const float coef = g * gelu_tanh(dot * arg_scale); const f32x2 cf = {coef, coef};
#pragma unroll
        for (int c = 0; c < 2; ++c)
#pragma unroll
            for (int wd = 0; wd < 4; ++wd) { const int w = (int)V[k][c][wd];
                y[c * 8 + wd * 2] = __builtin_elementwise_fma(__builtin_amdgcn_cvt_pk_f32_fp8(w, false), cf, y[c * 8 + wd * 2]);
                y[c * 8 + wd * 2 + 1] = __builtin_elementwise_fma(__builtin_amdgcn_cvt_pk_f32_fp8(w, true), cf, y[c * 8 + wd * 2 + 1]); } }
}
DI void peer_gather_token(const Args& a, int t, int lane) {
    unsigned char* ws = a.ws;
    const bf16* xg = (const bf16*)(ws + WS_H2G) + (size_t)t * DM + lane * 16;
    f32x2 xs[16];
#pragma unroll
    for (int c = 0; c < 2; ++c)
#pragma unroll
        for (int q = 0; q < 2; ++q) { const u32x4 w = *(const u32x4*)(xg + c * 1024 + q * 8);
            xs[c * 8 + q * 4 + 0] = (f32x2){bflo(w.x), bfhi(w.x)}; xs[c * 8 + q * 4 + 1] = (f32x2){bflo(w.y), bfhi(w.y)}; xs[c * 8 + q * 4 + 2] = (f32x2){bflo(w.z), bfhi(w.z)}; xs[c * 8 + q * 4 + 3] = (f32x2){bflo(w.w), bfhi(w.w)}; }
    const float rs2 = __builtin_amdgcn_rsqf(((const float*)(ws + WS_SUMSQ2))[t] * (1.f / DM) + EPS);
    const int* eidp = (const int*)(ws + WS_EID) + (size_t)t * 128; const float* gwp = (const float*)(ws + WS_GW) + (size_t)t * 128; const float* ginv = (const float*)(ws + WS_GINV) + (size_t)t * 8;
    const int eA = eidp[lane], eB = eidp[64 + lane];
    const int gA = __float_as_int(gwp[lane] * ginv[lane >> 4] * (1.f / EV_SCALE)), gB = __float_as_int(gwp[64 + lane] * ginv[4 + (lane >> 4)] * (1.f / EV_SCALE));
    f32x2 y[16];
#pragma unroll
    for (int i = 0; i < 16; ++i) y[i] = (f32x2){0.f, 0.f};
    const unsigned char* EU = ws + WS_EU + lane * 16; const unsigned char* EV = ws + WS_EV + lane * 16;
    const float arg_scale = rs2 * (1.f / EU_SCALE);
    u32x4 U0[4][2], V0[4][2], U1[4][2], V1[4][2];
    peer_load(U0, EU, eA, eB, 0); peer_load(V0, EV, eA, eB, 0);
#pragma unroll 1
    for (int b = 0; b < 32; b += 2) {
        peer_load(U1, EU, eA, eB, b + 1);
        const float ka = peer_dots(U0, xs, lane);
        asm volatile("" ::: "memory");
        peer_load(V1, EV, eA, eB, b + 1);
        peer_axpy(V0, ka, y, gA, gB, b, arg_scale);
        asm volatile("" ::: "memory");
        if (b + 2 < 32) peer_load(U0, EU, eA, eB, b + 2);
        const float kb = peer_dots(U1, xs, lane);
        asm volatile("" ::: "memory");
        if (b + 2 < 32) peer_load(V0, EV, eA, eB, b + 2);
        peer_axpy(V1, kb, y, gA, gB, b + 1, arg_scale);
        asm volatile("" ::: "memory");
    }
    float* orow = a.out + (size_t)t * DM + lane * 16; const float* gf = a.in[24] + lane * 16; float ss = 0.f;
#pragma unroll
    for (int c = 0; c < 2; ++c)
#pragma unroll
        for (int q = 0; q < 4; ++q) { const f32x4 hv = *(const f32x4*)(orow + c * 1024 + q * 4);
            f32x2& y0 = y[c * 8 + q * 2]; f32x2& y1 = y[c * 8 + q * 2 + 1];
            y0.x += hv[0]; y0.y += hv[1]; y1.x += hv[2]; y1.y += hv[3]; ss += (y0.x * y0.x + y0.y * y0.y) + (y1.x * y1.x + y1.y * y1.y); }
    const float rs = __builtin_amdgcn_rsqf(wave_sum(ss) * (1.f / DM) + EPS);
#pragma unroll
    for (int c = 0; c < 2; ++c)
#pragma unroll
        for (int q = 0; q < 4; ++q) { const f32x4 gv = *(const f32x4*)(gf + c * 1024 + q * 4); const f32x2 y0 = y[c * 8 + q * 2], y1 = y[c * 8 + q * 2 + 1];
            *(f32x4*)(orow + c * 1024 + q * 4) = (f32x4){y0.x * rs * gv[0], y0.y * rs * gv[1], y1.x * rs * gv[2], y1.y * rs * gv[3]}; }
}
#define XB_TMO      128
#define XB_XCNT(j)  (256  + 64 * (j))
#define XB_XSUB(j)  (1280 + 64 * (j))
#define XB_XGEN(j)  (2304 + 64 * (j))
#define XB_TOP      3328
#define XB_TOPGEN   3392
#define XCD_BAR_WORDS 3456
#define XB_SPIN_CAP (1u << 18)

__device__ __forceinline__ unsigned xb_ld(unsigned* p)              { return __hip_atomic_load(p, __ATOMIC_RELAXED, __HIP_MEMORY_SCOPE_AGENT); }
__device__ __forceinline__ unsigned xb_add(unsigned* p, unsigned v) { return __hip_atomic_fetch_add(p, v, __ATOMIC_RELAXED, __HIP_MEMORY_SCOPE_AGENT); }
__device__ __forceinline__ unsigned xb_xcc_id() { return (unsigned)__builtin_amdgcn_s_getreg((3 << 11) | 20) & 0xFu; }
#define XB_SPIN(cond, bar) do { unsigned _sp = 0; while (cond) { __builtin_amdgcn_s_sleep(1); \
    if ((++_sp & 255u) == 0u) { if (xb_ld(&(bar)[XB_TMO])) break; if (_sp > XB_SPIN_CAP) { atomicAdd(&(bar)[XB_TMO], 1u); break; } } } } while (0)

struct XcdBarrier {
    unsigned* bar; unsigned x;
    volatile LAS unsigned* st;
};

__device__ __forceinline__ XcdBarrier xcd_barrier_post(unsigned* bar, volatile LAS unsigned* st) {
    XcdBarrier b; b.bar = bar; b.x = xb_xcc_id(); b.st = st;
    if (threadIdx.x == 0) (void)xb_add(&bar[XB_XCNT(b.x)], 1u);
    return b;
}
__device__ __forceinline__ void xcd_barrier_complete(unsigned* bar, unsigned x, unsigned& nloc, unsigned& nx) {
    const unsigned G = gridDim.x * gridDim.y * gridDim.z;
    unsigned sum, cnt, mine, sp = 0u;
    for (;;) {
        sum = 0u; cnt = 0u; mine = 0u;
#pragma unroll
        for (unsigned j = 0; j < 16; ++j) { const unsigned c = xb_ld(&bar[XB_XCNT(j)]); sum += c; cnt += (c > 0u) ? 1u : 0u; mine = (j == x) ? c : mine; }
        if (sum == G) break;
        __builtin_amdgcn_s_sleep(1);
        if ((++sp & 255u) == 0u) { if (xb_ld(&bar[XB_TMO])) break; if (sp > XB_SPIN_CAP) { atomicAdd(&bar[XB_TMO], 1u); break; } }
    }
    nloc = mine > 0u ? mine : 1u; nx = cnt > 0u ? cnt : 1u;
}

__device__ __forceinline__ void xcd_barrier(const XcdBarrier& b) {
    asm volatile("s_waitcnt vmcnt(0)" ::: "memory");
    __syncthreads();
    if (threadIdx.x == 0) {
        unsigned* bar = b.bar;
        __builtin_amdgcn_s_waitcnt(0);
        unsigned nloc = b.st[0], nx = b.st[1];
        if (nloc == 0u) { xcd_barrier_complete(bar, b.x, nloc, nx); b.st[0] = nloc; b.st[1] = nx; }
        const unsigned old = xb_add(&bar[XB_XSUB(b.x)], 1u);
        const unsigned gen = old / nloc;
        if (old + 1u == (gen + 1u) * nloc) {
            __builtin_amdgcn_fence(__ATOMIC_RELEASE, "agent");
            asm volatile("s_waitcnt vmcnt(0)" ::: "memory");
            const unsigned og = xb_add(&bar[XB_TOP], 1u);
            const unsigned tg = og / nx;
            if (og + 1u == (tg + 1u) * nx) xb_add(&bar[XB_TOPGEN], 1u);
            else XB_SPIN(xb_ld(&bar[XB_TOPGEN]) == tg, bar);
            __builtin_amdgcn_fence(__ATOMIC_ACQUIRE, "agent");
            xb_add(&bar[XB_XGEN(b.x)], 1u);
            asm volatile("s_waitcnt vmcnt(0)" ::: "memory");
        } else {
            XB_SPIN(xb_ld(&bar[XB_XGEN(b.x)]) == gen, bar);
            __builtin_amdgcn_fence(__ATOMIC_ACQUIRE, "agent");
            asm volatile("s_waitcnt vmcnt(0)" ::: "memory");
        }
    }
    __syncthreads();
}

constexpr int NPHASES = 12;
__global__ void __launch_bounds__(NWAVES * 64, 2) fwd_kernel(Args a) {
    extern __shared__ __attribute__((aligned(16))) unsigned char lds_raw[];
    LAS unsigned char* lds = (LAS unsigned char*)lds_raw;
    const int tid = threadIdx.x, lane = tid & 63, wave = __builtin_amdgcn_readfirstlane(tid >> 6);
    const int G = gridDim.x, bx = blockIdx.x, gw = bx * NWAVES + wave, NGW = G * NWAVES;
    unsigned char* ws = a.ws;
    const int lo = a.ph_lo, hi = a.ph_hi;
    for (int u = tid; u < (LDS_BYTES - LDSCTL_OFF) / 4; u += NWAVES * 64) ((LAS unsigned*)(lds + LDSCTL_OFF))[u] = 0u;
    __syncthreads();
    XcdBarrier bar; bar.bar = (unsigned*)(ws + WS_BAR); bar.x = 0; bar.st = nullptr;
    if (hi - lo > 1) bar = xcd_barrier_post((unsigned*)(ws + WS_BAR), (volatile LAS unsigned*)(lds + LDSCTL_OFF + 64));
#ifndef PHM
#define PHM 0xfff
#endif
#define IN(k) (((PHM >> (k)) & 1) && lo <= (k) && (k) < hi)
#define SEAM(k) do { if (IN(k) && IN((k) + 1)) { if ((k) == 0) cg::this_grid().sync(); else xcd_barrier(bar); } } while (0)
#define GEMM_PHASE(EPI, gm, S, E) pg8::gemm_phase<EPI, pg8::StaticOrder, true, true>(lds, gm, S, E)

    if (IN(0)) phase_prologue(a, lds, gw, NGW, wave, lane);
    SEAM(0);
    if (IN(1)) {
        { pg8::Gemm gm{(const bf16*)(ws + WS_N), (const bf16*)(ws + WS_WIN), T, NINP, 2048}; pg8::StaticOrder S; S.init(T, NINP, G, bx); EpiProj E{ws}; GEMM_PHASE(EpiProj, gm, S, E); }
        { pg8::Gemm gm{(const bf16*)(ws + WS_MN), (const bf16*)(ws + WS_WXKV), 256, 1024, 2048}; pg8::StaticOrder S; S.init(256, 1024, G, G - 1 - bx); EpiKvx E{ws}; GEMM_PHASE(EpiKvx, gm, S, E); }
    }
    SEAM(1);
    if (IN(2)) {
        for (int wi = gw; wi < 3072; wi += NGW) dilated_item(ws, wi >> 2, wi & 3, lane);
        for (int wi = gw; wi < 3072 + 64; wi += NGW) if (wi >= 3072) compress_item(ws, wi - 3072, lane);
    }
    SEAM(2);
    if (IN(3)) {
        LAS float* pc = (LAS float*)(lds + wave * 8192);
        for (int it = gw; it < 4096; it += NGW) { const int Gk = it >> 11, idx = it & 2047; nsa_item(ws, Gk, Gk ? 2047 - idx : idx, pc, lane); }
        dilated_combine(ws, (size_t)gw * 64 + lane, (size_t)NGW * 64);
    }
    SEAM(3);
    if (IN(4)) {
        { pg8::Gemm gm{(const bf16*)(ws + WS_YA), (const bf16*)(ws + WS_WUPA), T, 2048, 512}; pg8::StaticOrder S; S.init(T, 2048, G, bx); EpiMix<0> E{ws}; GEMM_PHASE(EpiMix<0>, gm, S, E); }
        { pg8::Gemm gm{(const bf16*)(ws + WS_YB), (const bf16*)(ws + WS_WUPB), T, 2048, 1024}; pg8::StaticOrder S; S.init(T, 2048, G, bx); EpiMix<1> E{ws}; GEMM_PHASE(EpiMix<1>, gm, S, E); }
    }
    SEAM(4);
    if (IN(5)) {
        pg8::Gemm gm{(const bf16*)(ws + WS_MIX), (const bf16*)(ws + WS_WOUT), T, 2048, 2048}; pg8::StaticOrder S; S.init(T, 2048, G, bx);
        EpiRes E{a.in[0], a.out, (bf16*)(ws + WS_H1G), a.in[13], (float*)(ws + WS_SUMSQ1)}; GEMM_PHASE(EpiRes, gm, S, E);
    }
    SEAM(5);
    if (IN(6)) {
        pg8::Gemm gm{(const bf16*)(ws + WS_H1G), (const bf16*)(ws + WS_WXQ), T, 512, 2048}; pg8::StaticOrder S; S.init(T, 512, G, bx);
        EpiScaleRow E{(bf16*)(ws + WS_QX), 512, (const float*)(ws + WS_SUMSQ1)}; GEMM_PHASE(EpiScaleRow, gm, S, E);
        if (G > 64 && bx >= 64) convert_experts(a, (size_t)(bx - 64) * (NWAVES * 64) + tid, (size_t)(G - 64) * (NWAVES * 64));
        else if (G <= 64) convert_experts(a, (size_t)bx * (NWAVES * 64) + tid, (size_t)G * (NWAVES * 64));
    }
    SEAM(6);
    if (IN(7)) { for (int it = gw; it < 1024; it += NGW) cross_item(ws, it, lane); }
    SEAM(7);
    if (IN(8)) {
        pg8::Gemm gm{(const bf16*)(ws + WS_OX), (const bf16*)(ws + WS_WXO), T, 2048, 512}; pg8::StaticOrder S; S.init(T, 2048, G, bx);
        EpiRes E{a.out, a.out, (bf16*)(ws + WS_H2G), a.in[18], (float*)(ws + WS_SUMSQ2)}; GEMM_PHASE(EpiRes, gm, S, E);
    }
    SEAM(8);
    if (IN(9)) {
        pg8::Gemm gm{(const bf16*)(ws + WS_H2G), (const bf16*)(ws + WS_WPQ), T, 2048, 2048}; pg8::StaticOrder S; S.init(T, 2048, G, bx);
        EpiScaleRow E{(bf16*)(ws + WS_PQ), 2048, (const float*)(ws + WS_SUMSQ2)}; GEMM_PHASE(EpiScaleRow, gm, S, E);
    }
    SEAM(9);
    if (IN(10)) { LAS float* scr = (LAS float*)(lds + wave * 8192); for (int it = gw; it < 2048; it += NGW) peer_topk_item(ws, it, scr, lane); }
    SEAM(10);
    if (IN(11)) { for (int t = gw; t < T; t += NGW) peer_gather_token(a, t, lane); }
#undef IN
#undef SEAM
#undef GEMM_PHASE
}

extern "C" void kernel_launch(void* const* d_in, const int* in_sizes, int n_in, void* d_out, int out_size, void* d_ws, size_t ws_size, hipStream_t stream) {
    static int grid = 0;
    if (grid == 0) {
        if (n_in != 25 || out_size != T * DM || ws_size < WS_END) { fprintf(stderr, "kernel_launch: unexpected problem (n_in %d, out %d, ws %zu < %zu)\n", n_in, out_size, ws_size, (size_t)WS_END); grid = -1; return; }
        int dev = 0, cus = 0, per_cu = 0;
        if (hipGetDevice(&dev) != hipSuccess || hipDeviceGetAttribute(&cus, hipDeviceAttributeMultiprocessorCount, dev) != hipSuccess) { grid = -1; return; }
        if (hipFuncSetAttribute((const void*)fwd_kernel, hipFuncAttributeMaxDynamicSharedMemorySize, LDS_BYTES) != hipSuccess) { fprintf(stderr, "kernel_launch: hipFuncSetAttribute failed\n"); grid = -1; return; }
        if (hipOccupancyMaxActiveBlocksPerMultiprocessor(&per_cu, (const void*)fwd_kernel, NWAVES * 64, LDS_BYTES) != hipSuccess || per_cu < 1) { fprintf(stderr, "kernel_launch: occupancy query says %d\n", per_cu); per_cu = 1; }
        (void)hipGetLastError();
        grid = cus;
    }
    if (grid < 0) return;
    (void)hipMemsetAsync((char*)d_ws, 0, CTL_ZERO_BYTES, stream);
    Args a{};
    for (int i = 0; i < 25; ++i) a.in[i] = (const float*)d_in[i];
    a.out = (float*)d_out; a.ws = (unsigned char*)d_ws;
#if ONE_LAUNCH
    a.ph_lo = 0; a.ph_hi = NPHASES;
    void* kargs[] = {&a};
    hipError_t e = hipLaunchCooperativeKernel((const void*)fwd_kernel, dim3(grid), dim3(NWAVES * 64), kargs, LDS_BYTES, stream);
    if (e != hipSuccess) fprintf(stderr, "kernel_launch: cooperative launch failed: %s (grid %d)\n", hipGetErrorString(e), grid);
#else
    for (int ph = 0; ph < NPHASES; ++ph) { a.ph_lo = ph; a.ph_hi = ph + 1; hipLaunchKernelGGL(fwd_kernel, dim3(grid), dim3(NWAVES * 64), LDS_BYTES, stream, a); }
#endif
}
```

```cpp
#include <hip/hip_runtime.h>
#include <hip/hip_cooperative_groups.h>
#include <cstdio>
#include <cstdint>
namespace cg = cooperative_groups;

#ifndef ONE_LAUNCH
#define ONE_LAUNCH 1
#endif

namespace pg8 {
#define PG8_LAS __attribute__((address_space(3)))
typedef unsigned short bf16_t;
typedef short bf16x8 __attribute__((ext_vector_type(8)));
typedef float f32x4 __attribute__((ext_vector_type(4)));
typedef unsigned u32x4 __attribute__((ext_vector_type(4)));
constexpr int BM = 256, BK = 64, HALF = 128, HTB = HALF * BK * 2  , STAGE_BYTES = 8 * HTB, NXCD = 8, WGM = 8;

__host__ __device__ __forceinline__ int lds_byte(int r, int c) { const int st = (r >> 4) * 2 + (c >> 5), rr = r & 15, cc = c & 31, ob = rr * 64 + cc * 2; return st * 1024 + (ob ^ (((ob >> 9) & 1) << 5)); }
__host__ __device__ __forceinline__ void stage_rc(int b, int& R, int& C) { const int st = b / 1024, sb = b % 1024, swz = sb ^ (((sb >> 9) & 1) << 5); R = (st >> 1) * 16 + swz / 64; C = (st & 1) * 32 + (swz % 64) / 2; }
__host__ __device__ __forceinline__ int perm32(int rho) { const int n = rho >> 4, i = rho & 15; return 8 * (i >> 2) + 4 * n + (i & 3); }

struct Unit { int pm, pn; };
struct Gemm { const bf16_t* A; const bf16_t* Bt; int M, N, K; };

struct StaticOrder {
    int nM, nN, nwg, G, c;
    __host__ __device__ void init(int M, int N, int G_, int c_) { nM = M / BM; nN = N / BM; nwg = nM * nN; G = G_; c = c_; }
    __host__ __device__ bool next(int i, Unit& u) const {
        const long L = (long)i * G + c; if (L >= nwg) return false;
        int wgid = (int)L; { const int q = nwg / NXCD, r = nwg % NXCD, xcd = wgid % NXCD, off = wgid / NXCD; wgid = (xcd < r ? xcd * (q + 1) : r * (q + 1) + (xcd - r) * q) + off; }
        const int nig = WGM * nN, gid = wgid / nig, fm = gid * WGM, gsz = (nM - fm) < WGM ? (nM - fm) : WGM;
        u.pm = fm + ((wgid % nig) % gsz); u.pn = (wgid % nig) / gsz; return true;
    }
    __device__ __forceinline__ void a_ready(const Unit&) const {}
    __device__ __forceinline__ void done(const Unit&) const {}
};

__device__ __forceinline__ unsigned cvt_pk_bf16(float lo, float hi) { typedef float f2_t __attribute__((ext_vector_type(2))); typedef __bf16 b2_t __attribute__((ext_vector_type(2)));
    f2_t v = {lo, hi}; b2_t b = __builtin_convertvector(v, b2_t); return __builtin_bit_cast(unsigned, b); }
template <class Epi, class Sched, bool ALIGN_EPI = false, bool SP2 = false>
__device__ __forceinline__ void gemm_phase(PG8_LAS unsigned char* lds, const Gemm g, const Sched& S, const Epi& E) {
    const int tid = threadIdx.x, wid = __builtin_amdgcn_readfirstlane(tid >> 6), lane = tid & 63, wr = wid >> 2, wc = wid & 3, fr = lane & 15, fq = lane >> 4;
    const int K = g.K, nt = K / BK;
    unsigned voffA[2], voffB[2];
#pragma unroll
    for (int i = 0; i < 2; ++i) { int R, C; stage_rc(tid * 16 + i * 8192, R, C); const int Rb = Epi::PERM ? ((R & ~31) + perm32(R & 31)) : R;
        voffA[i] = (unsigned)(R * K + C) * 2u; voffB[i] = (unsigned)(Rb * K + C) * 2u; }
    const size_t kstep = (size_t)(BK * 2);
    const size_t hstep = (size_t)HALF * K * 2;
    const size_t tstep = 2 * hstep;
    const unsigned ldsw = (unsigned)wid * 1024u;
    const int aoff = lds_byte(wr * 64 + fr, fq * 8), boff = lds_byte(wc * 32 + fr, fq * 8);
#define PG8_SA(b, h) (((b) * 2 + (h)) * HTB)
#define PG8_SB(b, h) ((4 + (b) * 2 + (h)) * HTB)
#define PG8_STAGE(bufoff, gbase, voff) do { _Pragma("unroll") for (int _i = 0; _i < 2; ++_i) \
        __builtin_amdgcn_global_load_lds((const unsigned*)((const char*)(gbase) + (voff)[_i]), (PG8_LAS unsigned*)(lds + (bufoff) + ldsw + _i * 8192), 16, 0, 0); } while (0)
#define PG8_LDA(dst, b, h) do { _Pragma("unroll") for (int m = 0; m < 4; ++m) _Pragma("unroll") for (int k = 0; k < 2; ++k) dst[m][k] = *(const PG8_LAS bf16x8*)(lds + PG8_SA(b, h) + aoff + m * 2048 + k * 1024); } while (0)
#define PG8_LDB(dst, b, h) do { _Pragma("unroll") for (int n = 0; n < 2; ++n) _Pragma("unroll") for (int k = 0; k < 2; ++k) dst[n][k] = *(const PG8_LAS bf16x8*)(lds + PG8_SB(b, h) + boff + n * 2048 + k * 1024); } while (0)
#define PG8_MMA(ai, bj, At, Bt) do { __builtin_amdgcn_s_setprio(1); _Pragma("unroll") for (int m = 0; m < 4; ++m) _Pragma("unroll") for (int n = 0; n < 2; ++n) _Pragma("unroll") for (int k = 0; k < 2; ++k) \
        acc[ai][bj][m][n] = __builtin_amdgcn_mfma_f32_16x16x32_bf16(Bt[n][k], At[m][k], acc[ai][bj][m][n], 0, 0, 0); __builtin_amdgcn_s_setprio(0); } while (0)
#define PG8_WAIT_V(n) asm volatile("s_waitcnt vmcnt(" #n ")" ::: "memory")
#define PG8_WAIT_L(n) asm volatile("s_waitcnt lgkmcnt(" #n ")" ::: "memory")
#define PG8_BAR __builtin_amdgcn_s_barrier()
#define PG8_SCHED __builtin_amdgcn_sched_barrier(0)
    Unit cur, nxt; int ui = 0;
    if (!S.next(0, cur)) return;
    f32x4 acc[2][2][4][2];
#pragma unroll
    for (int a = 0; a < 2; ++a)
#pragma unroll
        for (int b = 0; b < 2; ++b)
#pragma unroll
            for (int m = 0; m < 4; ++m)
#pragma unroll
                for (int n = 0; n < 2; ++n) acc[a][b][m][n] = (f32x4){0.f, 0.f, 0.f, 0.f};
    bf16x8 At[4][2], B0[2][2], B1[2][2];
    const char* cA = (const char*)g.A + (size_t)cur.pm * tstep; const char* cB = (const char*)g.Bt + (size_t)cur.pn * tstep;
    S.a_ready(cur);
    if constexpr (SP2) {
        PG8_STAGE(PG8_SB(0, 0), cB, voffB); PG8_STAGE(PG8_SB(0, 1), cB + hstep, voffB); PG8_STAGE(PG8_SA(0, 0), cA, voffA); PG8_STAGE(PG8_SA(0, 1), cA + hstep, voffA);
        if (wr == 1) PG8_BAR;
        PG8_WAIT_V(2); PG8_BAR;
        PG8_STAGE(PG8_SB(1, 0), cB + kstep, voffB); PG8_STAGE(PG8_SA(1, 0), cA + kstep, voffA); PG8_STAGE(PG8_SB(1, 1), cB + hstep + kstep, voffB);
        PG8_WAIT_V(6); PG8_BAR;
    } else {
        PG8_STAGE(PG8_SB(0, 0), cB, voffB); PG8_STAGE(PG8_SA(0, 0), cA, voffA); PG8_STAGE(PG8_SB(0, 1), cB + hstep, voffB); PG8_STAGE(PG8_SA(0, 1), cA + hstep, voffA);
        if (wr == 1) PG8_BAR;
        PG8_WAIT_V(4); PG8_BAR;
        PG8_STAGE(PG8_SB(1, 0), cB + kstep, voffB); PG8_STAGE(PG8_SA(1, 0), cA + kstep, voffA); PG8_STAGE(PG8_SB(1, 1), cB + hstep + kstep, voffB);
        PG8_WAIT_V(6); PG8_BAR;
    }
    for (;;) {
        const bool has_next = S.next(ui + 1, nxt);
        const char* nA = has_next ? (const char*)g.A + (size_t)nxt.pm * tstep : cA; const char* nB = has_next ? (const char*)g.Bt + (size_t)nxt.pn * tstep : cB;
        for (int t = 0; t < nt; t += 2) {
            const bool last = (t == nt - 2);
            const char* a1 = cA + (size_t)(t + 1) * kstep;
            const char* a2 = last ? nA : cA + (size_t)(t + 2) * kstep; const char* b2 = last ? nB : cB + (size_t)(t + 2) * kstep;
            const char* a3 = a2 + kstep; const char* b3 = b2 + kstep;
            if (last && has_next) S.a_ready(nxt);
            if constexpr (SP2) {
            PG8_LDB(B0, 0, 0); PG8_LDB(B1, 0, 1); PG8_SCHED; PG8_LDA(At, 0, 0); PG8_STAGE(PG8_SA(1, 1), a1 + hstep, voffA);
            PG8_WAIT_V(8); PG8_WAIT_L(0); PG8_BAR; PG8_MMA(0, 0, At, B0); PG8_MMA(0, 1, At, B1); PG8_BAR; PG8_SCHED;
            PG8_LDA(At, 0, 1); PG8_STAGE(PG8_SB(0, 0), b2, voffB); PG8_STAGE(PG8_SB(0, 1), b2 + hstep, voffB); PG8_STAGE(PG8_SA(0, 0), a2, voffA);
            PG8_WAIT_V(8); PG8_WAIT_L(0); PG8_BAR; PG8_MMA(1, 0, At, B0); PG8_MMA(1, 1, At, B1); PG8_BAR; PG8_SCHED;
            PG8_LDB(B0, 1, 0); PG8_LDB(B1, 1, 1); PG8_SCHED; PG8_LDA(At, 1, 0); PG8_STAGE(PG8_SA(0, 1), a2 + hstep, voffA);
            PG8_WAIT_V(8); PG8_WAIT_L(0); PG8_BAR; PG8_MMA(0, 0, At, B0); PG8_MMA(0, 1, At, B1); PG8_BAR; PG8_SCHED;
            PG8_LDA(At, 1, 1); PG8_STAGE(PG8_SB(1, 0), b3, voffB); PG8_STAGE(PG8_SB(1, 1), b3 + hstep, voffB); PG8_STAGE(PG8_SA(1, 0), a3, voffA);
            PG8_WAIT_V(8); PG8_WAIT_L(0); PG8_BAR; PG8_MMA(1, 0, At, B0); PG8_MMA(1, 1, At, B1); PG8_BAR; PG8_SCHED;
            } else {
            PG8_LDB(B0, 0, 0); PG8_SCHED; PG8_LDA(At, 0, 0); PG8_STAGE(PG8_SA(1, 1), a1 + hstep, voffA);
            PG8_WAIT_L(8); PG8_BAR; PG8_WAIT_L(0); PG8_MMA(0, 0, At, B0); PG8_BAR; PG8_SCHED;
            PG8_LDB(B1, 0, 1); PG8_STAGE(PG8_SB(0, 0), b2, voffB);
            PG8_BAR; PG8_WAIT_L(0); PG8_MMA(0, 1, At, B1); PG8_BAR;
            PG8_LDA(At, 0, 1); PG8_STAGE(PG8_SA(0, 0), a2, voffA);
            PG8_BAR; PG8_WAIT_L(0); PG8_MMA(1, 0, At, B0); PG8_BAR; PG8_SCHED;
            PG8_STAGE(PG8_SB(0, 1), b2 + hstep, voffB);
            PG8_WAIT_V(6); PG8_BAR; PG8_MMA(1, 1, At, B1); PG8_BAR;
            PG8_LDB(B0, 1, 0); PG8_SCHED; PG8_LDA(At, 1, 0); PG8_STAGE(PG8_SA(0, 1), a2 + hstep, voffA);
            PG8_WAIT_L(8); PG8_BAR; PG8_WAIT_L(0); PG8_MMA(0, 0, At, B0); PG8_BAR; PG8_SCHED;
            PG8_LDB(B1, 1, 1); PG8_STAGE(PG8_SB(1, 0), b3, voffB);
            PG8_BAR; PG8_WAIT_L(0); PG8_MMA(0, 1, At, B1); PG8_BAR;
            PG8_LDA(At, 1, 1); PG8_STAGE(PG8_SA(1, 0), a3, voffA);
            PG8_BAR; PG8_WAIT_L(0); PG8_MMA(1, 0, At, B0); PG8_BAR; PG8_SCHED;
            PG8_STAGE(PG8_SB(1, 1), b3 + hstep, voffB);
            PG8_WAIT_V(6); PG8_BAR; PG8_MMA(1, 1, At, B1); PG8_BAR;
            }
        }
        if constexpr (ALIGN_EPI) { if (wr == 0) PG8_BAR; }
        if constexpr (!Epi::AFTER_DRAIN) { E(acc, cur, wr, wc, fr, fq); S.done(cur); }
        if (!has_next) break;
#pragma unroll
        for (int a = 0; a < 2; ++a)
#pragma unroll
            for (int b = 0; b < 2; ++b)
#pragma unroll
                for (int m = 0; m < 4; ++m)
#pragma unroll
                    for (int n = 0; n < 2; ++n) acc[a][b][m][n] = (f32x4){0.f, 0.f, 0.f, 0.f};
        cur = nxt; cA = nA; cB = nB; ++ui;
        if constexpr (ALIGN_EPI) { if (wr == 1) PG8_BAR; }
    }
    PG8_WAIT_V(0);
    if constexpr (!ALIGN_EPI) { if (wr == 0) PG8_BAR; }
    PG8_BAR;
    if constexpr (Epi::AFTER_DRAIN) { E.fused(acc, cur, wr, wc, fr, fq, lds, wid, lane); S.done(cur); }
#undef PG8_SA
#undef PG8_SB
#undef PG8_STAGE
#undef PG8_LDA
#undef PG8_LDB
#undef PG8_MMA
#undef PG8_WAIT_V
#undef PG8_WAIT_L
#undef PG8_BAR
#undef PG8_SCHED
}
}
#define LAS __attribute__((address_space(3)))
#define DI __device__ __forceinline__
typedef unsigned short bf16;
typedef short bf16x8 __attribute__((ext_vector_type(8)));
typedef short s16x4 __attribute__((ext_vector_type(4)));
typedef float f32x2 __attribute__((ext_vector_type(2)));
typedef float f32x4 __attribute__((ext_vector_type(4)));
typedef float f32x16 __attribute__((ext_vector_type(16)));
typedef unsigned u32x2 __attribute__((ext_vector_type(2)));
typedef unsigned u32x4 __attribute__((ext_vector_type(4)));
using pg8::cvt_pk_bf16;
#define MFMA32(a, b, c) __builtin_amdgcn_mfma_f32_32x32x16_bf16((a), (b), (c), 0, 0, 0)

constexpr int T = 8192, DM = 2048, NWAVES = 8;
constexpr int NIN = 10544, NINP = 10752;
constexpr float LOG2E = 1.4426950408889634f, LN2 = 0.6931471805599453f, NEGBIG = -1e30f, EPS = 1e-6f;

constexpr size_t MiB = 1u << 20;
constexpr size_t WS_SUMSQ1 = 0, WS_SUMSQ2 = 32768, WS_BAR = 65536, CTL_ZERO_BYTES = 65536 + 16384;
constexpr size_t WS_WCK1T = 1 * MiB, WS_WCV1T = 1 * MiB + 512 * 1024, WS_WCK2T = 2 * MiB, WS_WCV2T = 2 * MiB + 16384, WS_SK1 = 2 * MiB + 32768, WS_SK2 = 2 * MiB + 65536,
                 WS_PEBK = 2 * MiB + 98304, WS_PEBV = 2 * MiB + 98304 + 512, WS_KX = 3 * MiB, WS_VXT = 3 * MiB + 262144, WS_KC = 3 * MiB + 524288, WS_VCT = 3 * MiB + 524288 + 131072,
                 WS_LSE = 4 * MiB, WS_GINV = 5 * MiB, WS_MN = 6 * MiB;
constexpr size_t WS_WIN = 8 * MiB, WS_WUPA = 50 * MiB, WS_WUPB = 52 * MiB, WS_WOUT = 56 * MiB, WS_WXQ = 64 * MiB, WS_WXKV = 66 * MiB, WS_WXO = 70 * MiB, WS_WPQ = 72 * MiB;
constexpr size_t WS_EU = 80 * MiB, WS_EV = 112 * MiB;
constexpr size_t WS_N = 208 * MiB, WS_MIXTMP = 208 * MiB, WS_AQ = 240 * MiB, WS_AK = 264 * MiB, WS_AVT = 288 * MiB, WS_BQ = 312 * MiB;
constexpr size_t WS_KCS = 328 * MiB, WS_VCS = 330 * MiB, WS_KS = 332 * MiB, WS_VST = 334 * MiB, WS_KW = 336 * MiB, WS_VWT = 338 * MiB, WS_BG = 340 * MiB, WS_MG = 342 * MiB;
constexpr size_t WS_OA = 406 * MiB, WS_YA = 431 * MiB, WS_YB = 439 * MiB, WS_MIX = 455 * MiB, WS_END = 487 * MiB;
constexpr size_t WS_H1G = 240 * MiB, WS_QX = 272 * MiB, WS_OX = 280 * MiB, WS_H2G = 288 * MiB, WS_PQ = 320 * MiB, WS_EID = 352 * MiB, WS_GW = 356 * MiB;
constexpr int LDSCTL_OFF = 131072;
constexpr int LDS_BYTES = 147456;

struct Args { const float* in[25]; float* out; unsigned char* ws; int ph_lo, ph_hi; };

DI float bflo(unsigned w) { return __uint_as_float(w << 16); }
DI float bfhi(unsigned w) { return __uint_as_float(w & 0xffff0000u); }
DI float bf2f(bf16 b) { return __uint_as_float(((unsigned)b) << 16); }
DI bf16 f2bf(float f) { return (bf16)(cvt_pk_bf16(f, 0.f) & 0xffffu); }
DI float fexp2(float x) { return __builtin_amdgcn_exp2f(x); }
DI float sigm(float x) { return 1.f / (1.f + __expf(-x)); }
DI float gelu_tanh(float x) { const float u = 0.7978845608028654f * (x + 0.044715f * x * x * x); return x / (1.f + __expf(-2.f * u)); }
DI int crow(int r, int h) { return (r & 3) + 8 * (r >> 2) + 4 * h; }
DI float wave_sum(float v) {
#pragma unroll
    for (int o = 1; o < 64; o <<= 1) v += __shfl_xor(v, o);
    return v;
}
DI u32x4 pack8(const f32x4& a, const f32x4& b) { u32x4 w; w.x = cvt_pk_bf16(a[0], a[1]); w.y = cvt_pk_bf16(a[2], a[3]); w.z = cvt_pk_bf16(b[0], b[1]); w.w = cvt_pk_bf16(b[2], b[3]); return w; }
DI bf16x8 pack8f(const float* p) { u32x4 w; w.x = cvt_pk_bf16(p[0], p[1]); w.y = cvt_pk_bf16(p[2], p[3]); w.z = cvt_pk_bf16(p[4], p[5]); w.w = cvt_pk_bf16(p[6], p[7]); return __builtin_bit_cast(bf16x8, w); }
DI bf16x8 cat4(s16x4 a, s16x4 b) { return (bf16x8){a[0], a[1], a[2], a[3], b[0], b[1], b[2], b[3]}; }

struct EpiProj {
    static constexpr bool PERM = true, AFTER_DRAIN = false;
    unsigned char* ws;
    DI void operator()(const f32x4 (&acc)[2][2][4][2], const pg8::Unit& u, int wr, int wc, int fr, int fq) const {
#pragma unroll
        for (int bj = 0; bj < 2; ++bj) {
            const int c8 = u.pn * 256 + bj * 128 + wc * 32 + 8 * fq;
            if (c8 >= NIN) continue;
            const int r0 = u.pm * 256 + wr * 64 + fr;
            if (c8 < 4608) {
                const int qkv = c8 / 1536, rem = c8 % 1536, g = rem / 512, hh = (rem % 512) / 128, d = rem % 128, ld = 2 * g, dm1 = (1 << ld) - 1;
                if (qkv < 2) {
                    bf16* base = (bf16*)(ws + (qkv == 0 ? WS_AQ : WS_AK)) + (size_t)(g * 4 + hh) * T * 128 + d;
#pragma unroll
                    for (int ai = 0; ai < 2; ++ai)
#pragma unroll
                        for (int m = 0; m < 4; ++m) { const int t = r0 + ai * 128 + m * 16, tp = ((t & dm1) << (13 - ld)) + (t >> ld);
                            *(u32x4*)(base + (size_t)tp * 128) = pack8(acc[ai][bj][m][0], acc[ai][bj][m][1]); }
                } else {
                    bf16* base = (bf16*)(ws + WS_AVT) + (size_t)((g * 4 + hh) * 128 + d) * T;
#pragma unroll
                    for (int ai = 0; ai < 2; ++ai)
#pragma unroll
                        for (int m = 0; m < 4; ++m) { const int t = r0 + ai * 128 + m * 16, tp = ((t & dm1) << (13 - ld)) + (t >> ld);
#pragma unroll
                            for (int e = 0; e < 8; ++e) base[(size_t)e * T + tp] = f2bf(acc[ai][bj][m][e >> 2][e & 3]); }
                }
            } else if (c8 < 5632) {
                bf16* base = (bf16*)(ws + WS_BQ) + (c8 - 4608);
#pragma unroll
                for (int ai = 0; ai < 2; ++ai)
#pragma unroll
                    for (int m = 0; m < 4; ++m) { const int t = r0 + ai * 128 + m * 16; *(u32x4*)(base + (size_t)t * 1024) = pack8(acc[ai][bj][m][0], acc[ai][bj][m][1]); }
            } else if (c8 < 6400) {
                const int c = c8 - 5632, br = c / 256, kv = (c % 256) / 128, G = (c % 128) / 64, d = c % 64;
                if (kv == 0 || br == 0) {
                    const size_t off = kv == 0 ? (br == 0 ? WS_KCS : br == 1 ? WS_KS : WS_KW) : WS_VCS;
                    bf16* base = (bf16*)(ws + off) + (size_t)G * T * 64 + d;
#pragma unroll
                    for (int ai = 0; ai < 2; ++ai)
#pragma unroll
                        for (int m = 0; m < 4; ++m) { const int t = r0 + ai * 128 + m * 16; *(u32x4*)(base + (size_t)t * 64) = pack8(acc[ai][bj][m][0], acc[ai][bj][m][1]); }
                } else {
                    bf16* base = (bf16*)(ws + (br == 1 ? WS_VST : WS_VWT)) + (size_t)(G * 64 + d) * T;
#pragma unroll
                    for (int ai = 0; ai < 2; ++ai)
#pragma unroll
                        for (int m = 0; m < 4; ++m) { const int t = r0 + ai * 128 + m * 16;
#pragma unroll
                            for (int e = 0; e < 8; ++e) base[(size_t)e * T + t] = f2bf(acc[ai][bj][m][e >> 2][e & 3]); }
                }
            } else if (c8 < 10496) {
                bf16* base = (bf16*)(ws + WS_MG) + (c8 - 6400);
#pragma unroll
                for (int ai = 0; ai < 2; ++ai)
#pragma unroll
                    for (int m = 0; m < 4; ++m) { const int t = r0 + ai * 128 + m * 16; f32x4 a = acc[ai][bj][m][0], b = acc[ai][bj][m][1];
#pragma unroll
                        for (int e = 0; e < 4; ++e) { a[e] = sigm(a[e]); b[e] = sigm(b[e]); }
                        *(u32x4*)(base + (size_t)t * 4096) = pack8(a, b); }
            } else {
                float* base = (float*)(ws + WS_BG) + (c8 - 10496);
#pragma unroll
                for (int ai = 0; ai < 2; ++ai)
#pragma unroll
                    for (int m = 0; m < 4; ++m) { const int t = r0 + ai * 128 + m * 16; f32x4 a = acc[ai][bj][m][0], b = acc[ai][bj][m][1];
#pragma unroll
                        for (int e = 0; e < 4; ++e) { a[e] = sigm(a[e]); b[e] = sigm(b[e]); }
                        *(f32x4*)(base + (size_t)t * 48) = a; *(f32x4*)(base + (size_t)t * 48 + 4) = b; }
            }
        }
    }
};
struct EpiKvx {
    static constexpr bool PERM = true, AFTER_DRAIN = false;
    unsigned char* ws;
    DI void operator()(const f32x4 (&acc)[2][2][4][2], const pg8::Unit& u, int wr, int wc, int fr, int fq) const {
#pragma unroll
        for (int bj = 0; bj < 2; ++bj) {
            const int c8 = u.pn * 256 + bj * 128 + wc * 32 + 8 * fq, kvi = c8 / 512, hx = (c8 % 512) / 128, d = c8 % 128, r0 = wr * 64 + fr;
#pragma unroll
            for (int ai = 0; ai < 2; ++ai)
#pragma unroll
                for (int m = 0; m < 4; ++m) { const int row = r0 + ai * 128 + m * 16;
                    if (kvi == 0) *(u32x4*)((bf16*)(ws + WS_KX) + (size_t)(hx * 256 + row) * 128 + d) = pack8(acc[ai][bj][m][0], acc[ai][bj][m][1]);
                    else {
#pragma unroll
                        for (int e = 0; e < 8; ++e) ((bf16*)(ws + WS_VXT))[(size_t)(hx * 128 + d + e) * 256 + row] = f2bf(acc[ai][bj][m][e >> 2][e & 3]); } }
        }
    }
};
template <int SECOND> struct EpiMix {
    static constexpr bool PERM = true, AFTER_DRAIN = false;
    unsigned char* ws;
    DI void operator()(const f32x4 (&acc)[2][2][4][2], const pg8::Unit& u, int wr, int wc, int fr, int fq) const {
#pragma unroll
        for (int bj = 0; bj < 2; ++bj) {
            const int c8 = u.pn * 256 + bj * 128 + wc * 32 + 8 * fq, r0 = u.pm * 256 + wr * 64 + fr;
#pragma unroll
            for (int ai = 0; ai < 2; ++ai)
#pragma unroll
                for (int m = 0; m < 4; ++m) { const int t = r0 + ai * 128 + m * 16;
                    const u32x4 gt = *(const u32x4*)((const bf16*)(ws + WS_MG) + (size_t)t * 4096 + SECOND * 2048 + c8);
                    f32x4 a = acc[ai][bj][m][0], b = acc[ai][bj][m][1];
                    a[0] *= bflo(gt.x); a[1] *= bfhi(gt.x); a[2] *= bflo(gt.y); a[3] *= bfhi(gt.y); b[0] *= bflo(gt.z); b[1] *= bfhi(gt.z); b[2] *= bflo(gt.w); b[3] *= bfhi(gt.w);
                    if (SECOND) { const u32x4 p = *(const u32x4*)((const bf16*)(ws + WS_MIXTMP) + (size_t)t * 2048 + c8);
                        a[0] += bflo(p.x); a[1] += bfhi(p.x); a[2] += bflo(p.y); a[3] += bfhi(p.y); b[0] += bflo(p.z); b[1] += bfhi(p.z); b[2] += bflo(p.w); b[3] += bfhi(p.w); }
                    *(u32x4*)((bf16*)(ws + (SECOND ? WS_MIX : WS_MIXTMP)) + (size_t)t * 2048 + c8) = pack8(a, b); }
        }
    }
};
struct EpiRes {
    static constexpr bool PERM = false, AFTER_DRAIN = false;
    const float* base; float* out; bf16* hg; const float* gain; float* sumsq;
    DI void operator()(const f32x4 (&acc)[2][2][4][2], const pg8::Unit& u, int wr, int wc, int fr, int fq) const {
        const int r0 = u.pm * 256 + wr * 64 + fr, c0 = u.pn * 256 + wc * 32 + 4 * fq;
#pragma unroll
        for (int ai = 0; ai < 2; ++ai)
#pragma unroll
            for (int m = 0; m < 4; ++m) { const int t = r0 + ai * 128 + m * 16; float ss = 0.f;
#pragma unroll
                for (int bj = 0; bj < 2; ++bj)
#pragma unroll
                    for (int n = 0; n < 2; ++n) { const int c = c0 + bj * 128 + 16 * n; const size_t off = (size_t)t * DM + c;
                        const f32x4 h = *(const f32x4*)(base + off) + acc[ai][bj][m][n]; const f32x4 g = *(const f32x4*)(gain + c);
                        *(f32x4*)(out + off) = h; ss += (h[0] * h[0] + h[1] * h[1]) + (h[2] * h[2] + h[3] * h[3]);
                        u32x2 w; w.x = cvt_pk_bf16(h[0] * g[0], h[1] * g[1]); w.y = cvt_pk_bf16(h[2] * g[2], h[3] * g[3]); *(u32x2*)(hg + off) = w; }
                ss += __shfl_xor(ss, 16); ss += __shfl_xor(ss, 32);
                if (fq == 0) atomicAdd(sumsq + t, ss); }
    }
};
struct EpiScaleRow {
    static constexpr bool PERM = true, AFTER_DRAIN = false;
    bf16* O; int ldc; const float* sumsq;
    DI void operator()(const f32x4 (&acc)[2][2][4][2], const pg8::Unit& u, int wr, int wc, int fr, int fq) const {
        const int r0 = u.pm * 256 + wr * 64 + fr;
#pragma unroll
        for (int ai = 0; ai < 2; ++ai)
#pragma unroll
            for (int m = 0; m < 4; ++m) { const int t = r0 + ai * 128 + m * 16; const float rs = __builtin_amdgcn_rsqf(sumsq[t] * (1.f / DM) + EPS);
#pragma unroll
                for (int bj = 0; bj < 2; ++bj) { const int c8 = u.pn * 256 + bj * 128 + wc * 32 + 8 * fq;
                    *(u32x4*)(O + (size_t)t * ldc + c8) = pack8(acc[ai][bj][m][0] * rs, acc[ai][bj][m][1] * rs); } }
    }
};
template <class RowMap>
DI void transpose_item(const float* W, int K, int N, bf16* WT, LAS float* scr, int item, int lane, RowMap rowmap) {
    const int nblk = (N + 63) / 64, kb = item / nblk, nb = item % nblk, k0 = 64 * kb, n0 = 64 * nb;
    const int nn = n0 + lane; const bool okn = nn < N;
    float v[64];
#pragma unroll
    for (int i = 0; i < 64; ++i) v[i] = okn ? W[(size_t)(k0 + i) * N + nn] : 0.f;
#pragma unroll
    for (int i = 0; i < 64; ++i) scr[i * 64 + (lane ^ (8 * ((i >> 3) & 3)))] = v[i];
    asm volatile("s_waitcnt lgkmcnt(0)" ::: "memory");
    const int c = lane & 7, sw = 8 * (c & 3);
#pragma unroll
    for (int j = 0; j < 8; ++j) { const int nl = (lane >> 3) + 8 * j, n = n0 + nl; const LAS float* s = scr + (8 * c) * 64 + (nl ^ sw);
        u32x4 o; o.x = cvt_pk_bf16(s[0 * 64], s[1 * 64]); o.y = cvt_pk_bf16(s[2 * 64], s[3 * 64]); o.z = cvt_pk_bf16(s[4 * 64], s[5 * 64]); o.w = cvt_pk_bf16(s[6 * 64], s[7 * 64]);
        if (n < N) *(u32x4*)(WT + (size_t)rowmap(n) * K + k0 + 8 * c) = o; }
    asm volatile("s_waitcnt lgkmcnt(0)" ::: "memory");
}
struct RowId { DI int operator()(int n) const { return n; } };
struct RowWin { DI int operator()(int n) const { return n < 6400 ? n : (n < 6448 ? n + 4096 : n - 48); } };

DI void rms_row_to_bf16(const float* xrow, const float* gain, bf16* orow, int lane) {
    f32x4 v[8]; float s = 0.f;
#pragma unroll
    for (int j = 0; j < 8; ++j) { v[j] = *(const f32x4*)(xrow + j * 256 + lane * 4); s += (v[j][0] * v[j][0] + v[j][1] * v[j][1]) + (v[j][2] * v[j][2] + v[j][3] * v[j][3]); }
    const float rs = __builtin_amdgcn_rsqf(wave_sum(s) * (1.f / DM) + EPS);
#pragma unroll
    for (int j = 0; j < 8; ++j) { const f32x4 g = *(const f32x4*)(gain + j * 256 + lane * 4); u32x2 w; w.x = cvt_pk_bf16(v[j][0] * rs * g[0], v[j][1] * rs * g[1]); w.y = cvt_pk_bf16(v[j][2] * rs * g[2], v[j][3] * rs * g[3]);
        *(u32x2*)(orow + j * 256 + lane * 4) = w; }
}
DI void phase_prologue(const Args& a, LAS unsigned char* lds, int gw, int NGW, int wave, int lane) {
    unsigned char* ws = a.ws;
    LAS float* scr = (LAS float*)(lds + wave * 16384);
    constexpr int I_WIN = 32 * 165, I_UPA = 8 * 32, I_UPB = 16 * 32, I_OUT = 32 * 32, I_XQ = 32 * 8, I_XKV = 32 * 16, I_XO = 8 * 32, I_PQ = 32 * 32, I_C1 = 32 * 2, I_C2 = 2 * 1;
    constexpr int NITEMS = I_WIN + I_UPA + I_UPB + I_OUT + I_XQ + I_XKV + I_XO + I_PQ + 2 * I_C1 + 2 * I_C2;
    for (int it = gw; it < NITEMS; it += NGW) {
        int r = it;
        if (r < I_WIN) { transpose_item(a.in[3], 2048, NIN, (bf16*)(ws + WS_WIN), scr, r, lane, RowWin()); continue; } r -= I_WIN;
        if (r < I_UPA) { transpose_item(a.in[10], 512, 2048, (bf16*)(ws + WS_WUPA), scr, r, lane, RowId()); continue; } r -= I_UPA;
        if (r < I_UPB) { transpose_item(a.in[11], 1024, 2048, (bf16*)(ws + WS_WUPB), scr, r, lane, RowId()); continue; } r -= I_UPB;
        if (r < I_OUT) { transpose_item(a.in[12], 2048, 2048, (bf16*)(ws + WS_WOUT), scr, r, lane, RowId()); continue; } r -= I_OUT;
        if (r < I_XQ) { transpose_item(a.in[15], 2048, 512, (bf16*)(ws + WS_WXQ), scr, r, lane, RowId()); continue; } r -= I_XQ;
        if (r < I_XKV) { transpose_item(a.in[16], 2048, 1024, (bf16*)(ws + WS_WXKV), scr, r, lane, RowId()); continue; } r -= I_XKV;
        if (r < I_XO) { transpose_item(a.in[17], 512, 2048, (bf16*)(ws + WS_WXO), scr, r, lane, RowId()); continue; } r -= I_XO;
        if (r < I_PQ) { transpose_item(a.in[19], 2048, 2048, (bf16*)(ws + WS_WPQ), scr, r, lane, RowId()); continue; } r -= I_PQ;
        if (r < I_C1) { transpose_item(a.in[4], 2048, 128, (bf16*)(ws + WS_WCK1T), scr, r, lane, RowId()); continue; } r -= I_C1;
        if (r < I_C1) { transpose_item(a.in[7], 2048, 128, (bf16*)(ws + WS_WCV1T), scr, r, lane, RowId()); continue; } r -= I_C1;
        if (r < I_C2) { transpose_item(a.in[5], 128, 64, (bf16*)(ws + WS_WCK2T), scr, r, lane, RowId()); continue; } r -= I_C2;
        transpose_item(a.in[8], 128, 64, (bf16*)(ws + WS_WCV2T), scr, r, lane, RowId());
    }
    { u32x4* p = (u32x4*)((bf16*)(ws + WS_WIN) + (size_t)NIN * 2048); const int n16 = (NINP - NIN) * 2048 / 8;
      for (int i = gw * 64 + lane; i < n16; i += NGW * 64) p[i] = (u32x4){0u, 0u, 0u, 0u}; }
    for (int m = gw; m < T + 256; m += NGW) {
        if (m < T) rms_row_to_bf16(a.in[0] + (size_t)m * DM, a.in[2], (bf16*)(ws + WS_N) + (size_t)m * DM, lane);
        else rms_row_to_bf16(a.in[1] + (size_t)(m - T) * DM, a.in[14], (bf16*)(ws + WS_MN) + (size_t)(m - T) * DM, lane);
    }
    {   const size_t tid = (size_t)gw * 64 + lane, nth = (size_t)NGW * 64;
        for (int tb = 0; tb < 2; ++tb) { const f32x4* src = (const f32x4*)a.in[20 + tb]; u32x4* dst = (u32x4*)(ws + (tb ? WS_SK2 : WS_SK1));
            for (size_t i = tid; i < 128 * 128 / 8; i += nth) dst[i] = pack8(src[2 * i], src[2 * i + 1]); }
    }
    for (int o = gw; o < 256; o += NGW) { const int kv = o >> 7, j = o & 127; const float* pe = a.in[kv ? 9 : 6]; const float* w1 = a.in[kv ? 7 : 4]; float s = 0.f;
        for (int i = lane; i < 2048; i += 64) s += pe[i] * w1[(size_t)i * 128 + j];
        s = wave_sum(s); if (lane == 0) ((float*)(ws + (kv ? WS_PEBV : WS_PEBK)))[j] = s; }
}
constexpr float EU_SCALE = 64.f, EV_SCALE = 8.f;
DI unsigned pk4_fp8(const f32x4 v, float sc) {
    const float a = __builtin_amdgcn_fmed3f(v[0] * sc, -448.f, 448.f), b = __builtin_amdgcn_fmed3f(v[1] * sc, -448.f, 448.f), c = __builtin_amdgcn_fmed3f(v[2] * sc, -448.f, 448.f), d = __builtin_amdgcn_fmed3f(v[3] * sc, -448.f, 448.f);
    int w = __builtin_amdgcn_cvt_pk_fp8_f32(a, b, 0, false); w = __builtin_amdgcn_cvt_pk_fp8_f32(c, d, w, true); return (unsigned)w;
}
DI void convert_experts(const Args& a, size_t tid, size_t nth) {
    const size_t n16 = (size_t)16384 * 2048 / 16;
    for (int tb = 0; tb < 2; ++tb) { const f32x4* src = (const f32x4*)a.in[22 + tb]; u32x4* dst = (u32x4*)(a.ws + (tb ? WS_EV : WS_EU)); const float sc = tb ? EV_SCALE : EU_SCALE;
        for (size_t i = tid; i < n16; i += nth) { const f32x4 x0 = __builtin_nontemporal_load(src + 4 * i), x1 = __builtin_nontemporal_load(src + 4 * i + 1), x2 = __builtin_nontemporal_load(src + 4 * i + 2), x3 = __builtin_nontemporal_load(src + 4 * i + 3);
            u32x4 w; w.x = pk4_fp8(x0, sc); w.y = pk4_fp8(x1, sc); w.z = pk4_fp8(x2, sc); w.w = pk4_fp8(x3, sc); dst[i] = w; } }
}
template <int HD, class SF>
DI void attn_tile(const bf16x8 (&q)[HD / 16], const bf16* kptr, const bf16* vptr, size_t vs32, float& m, float& l, f32x16 (&o)[HD / 32], SF sf) {
    f32x16 s;
#pragma unroll
    for (int r = 0; r < 16; ++r) s[r] = 0.f;
#pragma unroll
    for (int ks = 0; ks < HD / 16; ++ks) s = MFMA32(*(const bf16x8*)(kptr + 16 * ks), q[ks], s);
    float v[16]; float tmax = NEGBIG;
#pragma unroll
    for (int r = 0; r < 16; ++r) { v[r] = sf(r, s[r]); tmax = fmaxf(tmax, v[r]); }
    tmax = fmaxf(tmax, __shfl_xor(tmax, 32));
    const float mn = fmaxf(m, tmax), alpha = fexp2(m - mn);
    float p[16]; float ps = 0.f;
#pragma unroll
    for (int r = 0; r < 16; ++r) { p[r] = v[r] > -1e29f ? fexp2(v[r] - mn) : 0.f; ps += p[r]; }
    ps += __shfl_xor(ps, 32);
    l = l * alpha + ps; m = mn;
    const bf16x8 pf0 = pack8f(p), pf1 = pack8f(p + 8);
#pragma unroll
    for (int dt = 0; dt < HD / 32; ++dt) {
        const bf16* vp = vptr + dt * vs32;
        const s16x4 a0 = *(const s16x4*)(vp), a1 = *(const s16x4*)(vp + 8), b0 = *(const s16x4*)(vp + 16), b1 = *(const s16x4*)(vp + 24);
        o[dt] = o[dt] * alpha;
        o[dt] = MFMA32(cat4(a0, a1), pf0, o[dt]);
        o[dt] = MFMA32(cat4(b0, b1), pf1, o[dt]);
    }
}
template <int NT>
DI void store_ot(bf16* orow, const f32x16 (&o)[NT], float scale, int h) {
#pragma unroll
    for (int dt = 0; dt < NT; ++dt)
#pragma unroll
        for (int rg = 0; rg < 4; ++rg) { u32x2 w; w.x = cvt_pk_bf16(o[dt][4 * rg] * scale, o[dt][4 * rg + 1] * scale); w.y = cvt_pk_bf16(o[dt][4 * rg + 2] * scale, o[dt][4 * rg + 3] * scale);
            *(u32x2*)(orow + 32 * dt + 8 * rg + 4 * h) = w; }
}

DI void dilated_item(unsigned char* ws, int item, int w, int lane) {
    const int g = item >> 8, rem = item & 255, hh = rem >> 6, nb = rem & 63, ld = 2 * g, dil = 1 << ld, nbk = 64 >> ld, n = nb / nbk, b = nb % nbk, L = T >> ld;
    const int i32 = lane & 31, h = lane >> 5, iq = 32 * w + i32, rowbase = n * L + 128 * b, gh = g * 4 + hh;
    const bf16* Q = (const bf16*)(ws + WS_AQ) + ((size_t)gh * T + rowbase + iq) * 128 + 8 * h;
    const bf16* K = (const bf16*)(ws + WS_AK) + ((long)gh * T + rowbase - 128 + i32) * 128 + 8 * h;
    const bf16* V = (const bf16*)(ws + WS_AVT) + ((long)gh * 128 + i32) * T + (rowbase - 128) + 4 * h;
    bf16x8 q[8];
#pragma unroll
    for (int ks = 0; ks < 8; ++ks) q[ks] = *(const bf16x8*)(Q + 16 * ks);
    const float slope = exp2f(-8.f * (float)(gh + 1) / 12.f), sl2 = slope * (float)dil * LOG2E, sc2 = 0.08838834764831845f * LOG2E;
    f32x16 o[4];
#pragma unroll
    for (int dt = 0; dt < 4; ++dt)
#pragma unroll
        for (int r = 0; r < 16; ++r) o[dt][r] = 0.f;
    float m = NEGBIG, l = 0.f;
#pragma unroll 1
    for (int tt = 0; tt < 5; ++tt) {
        const int j0 = 32 * w + 32 * tt;
        if (b == 0 && j0 < 128) continue;
        attn_tile<128>(q, K + (size_t)j0 * 128, V + j0, (size_t)32 * T, m, l, o, [&](int r, float raw) {
            const int rel = iq + 128 - (j0 + crow(r, h)); return (rel >= 0 && rel <= 128) ? raw * sc2 - sl2 * (float)rel : NEGBIG; });
    }
    const int t = (128 * b + iq) * dil + n;
    store_ot<4>((bf16*)(ws + WS_OA) + ((size_t)g * T + t) * 512 + hh * 128, o, 1.f / l, h);
    if (h == 0) ((float*)(ws + WS_LSE))[((size_t)g * T + t) * 4 + hh] = (m + __log2f(l)) * LN2;
}
DI void compress_block(unsigned char* ws, int item, LAS unsigned char* lds, int wave, int lane, int tid) {
    const int kv = item >> 5, G = (item >> 4) & 1, rt = item & 15, i32 = lane & 31, h = lane >> 5;
    const int c = rt * 32 + i32, cc = c < 511 ? c : 510;
    LAS float* red = (LAS float*)lds;
    const bf16* A = (const bf16*)(ws + (kv ? WS_VCS : WS_KCS)) + (size_t)G * T * 64 + (size_t)cc * 1024 + 8 * h + wave * 256;
    const bf16* W1 = (const bf16*)(ws + (kv ? WS_WCV1T : WS_WCK1T)) + (size_t)i32 * 2048 + 8 * h + wave * 256;
    f32x16 hid[4];
#pragma unroll
    for (int jt = 0; jt < 4; ++jt)
#pragma unroll
        for (int r = 0; r < 16; ++r) hid[jt][r] = 0.f;
#pragma unroll 4
    for (int ks = 0; ks < 16; ++ks) {
        const bf16x8 af = *(const bf16x8*)(A + 16 * ks);
#pragma unroll
        for (int jt = 0; jt < 4; ++jt) hid[jt] = MFMA32(*(const bf16x8*)(W1 + (size_t)jt * 32 * 2048 + 16 * ks), af, hid[jt]);
    }
#pragma unroll
    for (int jt = 0; jt < 4; ++jt)
#pragma unroll
        for (int r = 0; r < 16; ++r) red[wave * 4096 + (jt * 16 + r) * 64 + lane] = hid[jt][r];
    __syncthreads();
    if (wave < 2) {
        const int dt = wave;
        const float* peb = (const float*)(ws + (kv ? WS_PEBV : WS_PEBK));
        const bf16* W2 = (const bf16*)(ws + (kv ? WS_WCV2T : WS_WCK2T)) + (size_t)(dt * 32 + i32) * 128 + 4 * h;
        f32x16 o;
#pragma unroll
        for (int r = 0; r < 16; ++r) o[r] = 0.f;
#pragma unroll
        for (int jt = 0; jt < 4; ++jt) { float gl[16];
#pragma unroll
            for (int r = 0; r < 16; ++r) { float sacc = red[(jt * 16 + r) * 64 + lane];
#pragma unroll
                for (int w8 = 1; w8 < 8; ++w8) sacc += red[w8 * 4096 + (jt * 16 + r) * 64 + lane];
                gl[r] = gelu_tanh(sacc + peb[jt * 32 + crow(r, h)]); }
            const bf16* wp = W2 + jt * 32;
            o = MFMA32(cat4(*(const s16x4*)(wp), *(const s16x4*)(wp + 8)), pack8f(gl), o);
            o = MFMA32(cat4(*(const s16x4*)(wp + 16), *(const s16x4*)(wp + 24)), pack8f(gl + 8), o); }
        const float keep = c < 511 ? 1.f : 0.f;
        if (kv == 0) { bf16* orow = (bf16*)(ws + WS_KC) + ((size_t)G * 512 + c) * 64 + 32 * dt;
#pragma unroll
            for (int rg = 0; rg < 4; ++rg) { u32x2 w; w.x = cvt_pk_bf16(o[4 * rg] * keep, o[4 * rg + 1] * keep); w.y = cvt_pk_bf16(o[4 * rg + 2] * keep, o[4 * rg + 3] * keep); *(u32x2*)(orow + 8 * rg + 4 * h) = w; }
        } else { bf16* vt = (bf16*)(ws + WS_VCT) + (size_t)G * 64 * 512 + c;
#pragma unroll
            for (int r = 0; r < 16; ++r) vt[(size_t)(32 * dt + crow(r, h)) * 512] = f2bf(o[r] * keep); }
    }
    __syncthreads();
}
DI void nsa_item(unsigned char* ws, int G, int chunk, LAS float* pc  , int lane) {
    const int i32 = lane & 31, h = lane >> 5, tok = i32 >> 3, hh = G * 8 + (i32 & 7), t0 = chunk * 4, t = t0 + tok;
    const float slope = exp2f(-0.5f * (float)(hh + 1)), sl2 = slope * LOG2E, sc2 = 0.125f * LOG2E;
    bf16x8 q[4];
    { const bf16* Q = (const bf16*)(ws + WS_BQ) + (size_t)t * 1024 + hh * 64 + 8 * h;
#pragma unroll
      for (int ks = 0; ks < 4; ++ks) q[ks] = *(const bf16x8*)(Q + 16 * ks); }
    const float* gate = (const float*)(ws + WS_BG) + (size_t)t * 48 + hh * 3;
    const float g_c = gate[0], g_s = gate[1], g_w = gate[2];
    f32x16 y[2], o[2];
#pragma unroll
    for (int dt = 0; dt < 2; ++dt)
#pragma unroll
        for (int r = 0; r < 16; ++r) { y[dt][r] = 0.f; o[dt][r] = 0.f; }
    const int cv = t >= 31 ? ((t - 31) >> 4) : -1;
    const int cmaxw = t0 + 3 >= 31 ? ((t0 + 3 - 31) >> 4) : -1;
    const int nct = cmaxw >= 0 ? (cmaxw >> 5) + 1 : 0;
    const bf16* KC = (const bf16*)(ws + WS_KC) + ((size_t)G * 512 + i32) * 64 + 8 * h;
    const bf16* VC = (const bf16*)(ws + WS_VCT) + ((size_t)G * 64 + i32) * 512 + 4 * h;
    float m = NEGBIG, l = 0.f;
    for (int ct = 0; ct < nct; ++ct) {
        f32x16 s;
#pragma unroll
        for (int r = 0; r < 16; ++r) s[r] = 0.f;
#pragma unroll
        for (int ks = 0; ks < 4; ++ks) s = MFMA32(*(const bf16x8*)(KC + (size_t)ct * 32 * 64 + 16 * ks), q[ks], s);
        float v[16]; float tmax = NEGBIG;
#pragma unroll
        for (int r = 0; r < 16; ++r) { const int c = ct * 32 + crow(r, h); v[r] = c <= cv ? s[r] * sc2 - sl2 * (float)(t - 16 * c - 31) : NEGBIG; tmax = fmaxf(tmax, v[r]); }
        tmax = fmaxf(tmax, __shfl_xor(tmax, 32));
        const float mn = fmaxf(m, tmax); float ps = 0.f;
#pragma unroll
        for (int r = 0; r < 16; ++r) ps += v[r] > -1e29f ? fexp2(v[r] - mn) : 0.f;
        ps += __shfl_xor(ps, 32);
        l = l * fexp2(m - mn) + ps; m = mn;
    }
    const float inv_c = l > 0.f ? 1.f / l : 0.f;
    for (int ct = 0; ct < nct; ++ct) {
        f32x16 s;
#pragma unroll
        for (int r = 0; r < 16; ++r) s[r] = 0.f;
#pragma unroll
        for (int ks = 0; ks < 4; ++ks) s = MFMA32(*(const bf16x8*)(KC + (size_t)ct * 32 * 64 + 16 * ks), q[ks], s);
        float p[16];
#pragma unroll
        for (int r = 0; r < 16; ++r) { const int c = ct * 32 + crow(r, h); p[r] = c <= cv ? fexp2(s[r] * sc2 - sl2 * (float)(t - 16 * c - 31) - m) * inv_c : 0.f; }
        const bf16x8 pf0 = pack8f(p), pf1 = pack8f(p + 8);
#pragma unroll
        for (int dt = 0; dt < 2; ++dt) { const bf16* vp = VC + (size_t)dt * 32 * 512 + ct * 32;
            o[dt] = MFMA32(cat4(*(const s16x4*)(vp), *(const s16x4*)(vp + 8)), pf0, o[dt]);
            o[dt] = MFMA32(cat4(*(const s16x4*)(vp + 16), *(const s16x4*)(vp + 24)), pf1, o[dt]); }
#pragma unroll
        for (int r = 0; r < 16; ++r) { float x = p[r]; x += __shfl_xor(x, 1); x += __shfl_xor(x, 2); x += __shfl_xor(x, 4);
            if ((i32 & 7) == 0) pc[tok * 512 + ct * 32 + crow(r, h)] = x; }
    }
#pragma unroll
    for (int dt = 0; dt < 2; ++dt)
#pragma unroll
        for (int r = 0; r < 16; ++r) { y[dt][r] = g_c * o[dt][r]; o[dt][r] = 0.f; }
    asm volatile("s_waitcnt lgkmcnt(0)" ::: "memory");
    unsigned msk[4] = {0u, 0u, 0u, 0u};
    {   const int ts = lane >> 4, l16 = lane & 15, tsel = t0 + ts, cur = tsel >> 6;
        float cand[8];
#pragma unroll
        for (int e = 0; e < 8; ++e) { const int j = l16 * 8 + e; const bool valid = j >= 1 && j <= cur - 2; const LAS float* pp = pc + ts * 512 + 4 * j;
            const int jm = valid ? -1 : 0;
            cand[e] = valid ? (pp[0] + pp[1]) + pp[2] + 0.5f * (pp[3] + pp[jm]) : -1.f; }
        msk[0] |= 1u;
#pragma unroll
        for (int w = 0; w < 4; ++w) { if ((cur >> 5) == w) msk[w] |= 1u << (cur & 31); if (cur >= 1 && ((cur - 1) >> 5) == w) msk[w] |= 1u << ((cur - 1) & 31); }
        for (int round = 0; round < 13; ++round) {
            float bv = -3.f; int bi = 1 << 20;
#pragma unroll
            for (int e = 0; e < 8; ++e) if (cand[e] > bv) { bv = cand[e]; bi = l16 * 8 + e; }
#pragma unroll
            for (int off = 1; off < 16; off <<= 1) { const float ov = __shfl_xor(bv, off); const int oi = __shfl_xor(bi, off); if (ov > bv || (ov == bv && oi < bi)) { bv = ov; bi = oi; } }
            if (bv >= 0.f) {
#pragma unroll
                for (int w = 0; w < 4; ++w) if ((bi >> 5) == w) msk[w] |= 1u << (bi & 31);
#pragma unroll
                for (int e = 0; e < 8; ++e) if (l16 * 8 + e == bi) cand[e] = -2.f;
            }
        }
    }
    unsigned mk[4], U[4];
#pragma unroll
    for (int w = 0; w < 4; ++w) { mk[w] = __shfl(msk[w], tok * 16);
        U[w] = __builtin_amdgcn_readlane(msk[w], 0) | __builtin_amdgcn_readlane(msk[w], 16) | __builtin_amdgcn_readlane(msk[w], 32) | __builtin_amdgcn_readlane(msk[w], 48); }
    const bf16* KS = (const bf16*)(ws + WS_KS) + ((size_t)G * T + i32) * 64 + 8 * h;
    const bf16* VS = (const bf16*)(ws + WS_VST) + ((size_t)G * 64 + i32) * T + 4 * h;
    m = NEGBIG; l = 0.f;
#pragma unroll
    for (int w = 0; w < 4; ++w) {
        unsigned bits = U[w];
        while (bits) {
            const int jb = __builtin_ctz(bits); bits &= bits - 1u;
            const bool mine = (mk[w] >> jb) & 1u;
            for (int half = 0; half < 2; ++half) {
                const int key0 = 64 * (w * 32 + jb) + 32 * half;
                if (key0 > t0 + 3) continue;
                attn_tile<64>(q, KS + (size_t)key0 * 64, VS + key0, (size_t)32 * T, m, l, o, [&](int r, float raw) {
                    const int pos = key0 + crow(r, h); return (mine && pos <= t) ? raw * sc2 - sl2 * (float)(t - pos) : NEGBIG; });
            }
        }
    }
    { const float sc = l > 0.f ? g_s / l : 0.f;
#pragma unroll
      for (int dt = 0; dt < 2; ++dt)
#pragma unroll
          for (int r = 0; r < 16; ++r) { y[dt][r] += sc * o[dt][r]; o[dt][r] = 0.f; } }
    const bf16* KW = (const bf16*)(ws + WS_KW) + ((size_t)G * T + i32) * 64 + 8 * h;
    const bf16* VW = (const bf16*)(ws + WS_VWT) + ((size_t)G * 64 + i32) * T + 4 * h;
    m = NEGBIG; l = 0.f;
    { const int lo = (t0 - 511 > 0 ? t0 - 511 : 0) & ~31;
      for (int key0 = lo; key0 <= t0 + 3; key0 += 32)
          attn_tile<64>(q, KW + (size_t)key0 * 64, VW + key0, (size_t)32 * T, m, l, o, [&](int r, float raw) {
              const int dd = t - (key0 + crow(r, h)); return (dd >= 0 && dd < 512) ? raw * sc2 - sl2 * (float)dd : NEGBIG; }); }
    { const float sc = l > 0.f ? g_w / l : 0.f;
#pragma unroll
      for (int dt = 0; dt < 2; ++dt)
#pragma unroll
          for (int r = 0; r < 16; ++r) y[dt][r] += sc * o[dt][r]; }
    store_ot<2>((bf16*)(ws + WS_YB) + (size_t)t * 1024 + hh * 64, y, 1.f, h);
}
DI void dilated_combine(unsigned char* ws, size_t tid, size_t nth) {
    const float* lse = (const float*)(ws + WS_LSE); const bf16* oa = (const bf16*)(ws + WS_OA); bf16* ya = (bf16*)(ws + WS_YA);
    for (size_t i = tid; i < (size_t)T * 64; i += nth) {
        const size_t t = i >> 6; const int c8 = (int)(i & 63) * 8, hh = c8 >> 7;
        const float l0 = lse[(0 * (size_t)T + t) * 4 + hh], l1 = lse[(1 * (size_t)T + t) * 4 + hh], l2 = lse[(2 * (size_t)T + t) * 4 + hh];
        const float mx = fmaxf(l0, fmaxf(l1, l2)), e0 = __expf(l0 - mx), e1 = __expf(l1 - mx), e2 = __expf(l2 - mx), inv = 1.f / (e0 + e1 + e2);
        const u32x4 a = *(const u32x4*)(oa + (0 * (size_t)T + t) * 512 + c8), b = *(const u32x4*)(oa + (1 * (size_t)T + t) * 512 + c8), c = *(const u32x4*)(oa + (2 * (size_t)T + t) * 512 + c8);
        const float w0 = e0 * inv, w1 = e1 * inv, w2 = e2 * inv; u32x4 r;
        r.x = cvt_pk_bf16(w0 * bflo(a.x) + w1 * bflo(b.x) + w2 * bflo(c.x), w0 * bfhi(a.x) + w1 * bfhi(b.x) + w2 * bfhi(c.x));
        r.y = cvt_pk_bf16(w0 * bflo(a.y) + w1 * bflo(b.y) + w2 * bflo(c.y), w0 * bfhi(a.y) + w1 * bfhi(b.y) + w2 * bfhi(c.y));
        r.z = cvt_pk_bf16(w0 * bflo(a.z) + w1 * bflo(b.z) + w2 * bflo(c.z), w0 * bfhi(a.z) + w1 * bfhi(b.z) + w2 * bfhi(c.z));
        r.w = cvt_pk_bf16(w0 * bflo(a.w) + w1 * bflo(b.w) + w2 * bflo(c.w), w0 * bfhi(a.w) + w1 * bfhi(b.w) + w2 * bfhi(c.w));
        *(u32x4*)(ya + t * 512 + c8) = r;
    }
}
DI void cross_item(unsigned char* ws, int item, int lane) {
    const int hx = item & 3, qt = item >> 2, i32 = lane & 31, h = lane >> 5, t = qt * 32 + i32;
    const bf16* Q = (const bf16*)(ws + WS_QX) + (size_t)t * 512 + hx * 128 + 8 * h;
    bf16x8 q[8];
#pragma unroll
    for (int ks = 0; ks < 8; ++ks) q[ks] = *(const bf16x8*)(Q + 16 * ks);
    const bf16* K = (const bf16*)(ws + WS_KX) + ((size_t)hx * 256 + i32) * 128 + 8 * h;
    const bf16* V = (const bf16*)(ws + WS_VXT) + ((size_t)hx * 128 + i32) * 256 + 4 * h;
    f32x16 o[4];
#pragma unroll
    for (int dt = 0; dt < 4; ++dt)
#pragma unroll
        for (int r = 0; r < 16; ++r) o[dt][r] = 0.f;
    float m = NEGBIG, l = 0.f; const float sc2 = 0.08838834764831845f * LOG2E;
    for (int kt = 0; kt < 8; ++kt)
        attn_tile<128>(q, K + (size_t)kt * 32 * 128, V + kt * 32, (size_t)32 * 256, m, l, o, [&](int r, float raw) { return raw * sc2; });
    store_ot<4>((bf16*)(ws + WS_OX) + (size_t)t * 512 + hx * 128, o, 1.f / l, h);
}
DI void peer_topk_item(unsigned char* ws, int item, LAS float* scr, int lane) {
    const int hp = item & 7, tt = item >> 3, i32 = lane & 31, h = lane >> 5, t = tt * 32 + i32;
    const bf16* Q = (const bf16*)(ws + WS_PQ) + (size_t)t * 2048 + hp * 256 + 8 * h;
    LAS float* my = scr + i32 * 64;
#pragma unroll 1
    for (int z = 0; z < 2; ++z) {
        bf16x8 q[8];
#pragma unroll
        for (int ks = 0; ks < 8; ++ks) q[ks] = *(const bf16x8*)(Q + z * 128 + 16 * ks);
        const bf16* SK = (const bf16*)(ws + (z ? WS_SK2 : WS_SK1)) + (size_t)i32 * 128 + 8 * h;
        f32x16 s[4];
#pragma unroll
        for (int kt = 0; kt < 4; ++kt) {
#pragma unroll
            for (int r = 0; r < 16; ++r) s[kt][r] = 0.f;
#pragma unroll
            for (int ks = 0; ks < 8; ++ks) s[kt] = MFMA32(*(const bf16x8*)(SK + (size_t)kt * 32 * 128 + 16 * ks), q[ks], s[kt]);
        }
#pragma unroll 1
        for (int round = 0; round < 16; ++round) {
            float bv = -3.0e38f; int bi = 1 << 20;
#pragma unroll
            for (int kt = 0; kt < 4; ++kt)
#pragma unroll
                for (int r = 0; r < 16; ++r) if (s[kt][r] > bv) { bv = s[kt][r]; bi = kt * 32 + crow(r, h); }
            { const float ov = __shfl_xor(bv, 32); const int oi = __shfl_xor(bi, 32); if (ov > bv || (ov == bv && oi < bi)) { bv = ov; bi = oi; } }
#pragma unroll
            for (int kt = 0; kt < 4; ++kt)
#pragma unroll
                for (int r = 0; r < 16; ++r) if (kt * 32 + crow(r, h) == bi) s[kt][r] = -3.0e38f;
            if (h == 0) { my[(z * 16 + round) * 2] = bv; my[(z * 16 + round) * 2 + 1] = __int_as_float(bi); }
        }
    }
    asm volatile("s_waitcnt lgkmcnt(0)" ::: "memory");
    float v1[16], v2[16];
#pragma unroll
    for (int k = 0; k < 16; ++k) { v1[k] = my[k * 2]; v2[k] = my[(16 + k) * 2]; }
    float cand[50]; int n = 0;
#pragma unroll
    for (int a = 0; a < 16; ++a)
#pragma unroll
        for (int b = 0; b < 16 / (a + 1); ++b) cand[n++] = v1[a] + v2[b];
    int* eid = (int*)(ws + WS_EID) + (size_t)t * 128 + hp * 16; float* gw = (float*)(ws + WS_GW) + (size_t)t * 128 + hp * 16;
    float vmax = 0.f, esum = 0.f;
#pragma unroll 1
    for (int round = 0; round < 16; ++round) {
        float bv = -3.0e38f; int bc = 0; n = 0;
#pragma unroll
        for (int a = 0; a < 16; ++a)
#pragma unroll
            for (int b = 0; b < 16 / (a + 1); ++b) { if (cand[n] > bv) { bv = cand[n]; bc = a * 16 + b; } ++n; }
        n = 0;
#pragma unroll
        for (int a = 0; a < 16; ++a)
#pragma unroll
            for (int b = 0; b < 16 / (a + 1); ++b) { if (a * 16 + b == bc) cand[n] = -3.0e38f; ++n; }
        if (round == 0) vmax = bv;
        const float e = __expf(bv - vmax); esum += e;
        const int e1 = __float_as_int(my[(bc >> 4) * 2 + 1]), e2 = __float_as_int(my[(16 + (bc & 15)) * 2 + 1]);
        if (h == 0) { eid[round] = e1 * 128 + e2; gw[round] = e; }
    }
    if (h == 0) ((float*)(ws + WS_GINV))[(size_t)t * 8 + hp] = 1.f / esum;
}
DI void peer_load(u32x4 (&R)[4][2], const unsigned char* E, int eA, int eB, int b) {
#pragma unroll
    for (int k = 0; k < 4; ++k) { const int p = 4 * b + k; const int e = b < 16 ? __builtin_amdgcn_readlane(eA, p & 63) : __builtin_amdgcn_readlane(eB, p & 63);
        const unsigned char* rp = E + (size_t)e * DM; R[k][0] = *(const u32x4*)(rp); R[k][1] = *(const u32x4*)(rp + 1024); }
}
DI float peer_dots(const u32x4 (&U)[4][2], const f32x2 (&xs)[16], int lane) {
    float d[4];
#pragma unroll
    for (int k = 0; k < 4; ++k) { f32x2 acc = {0.f, 0.f};
#pragma unroll
        for (int c = 0; c < 2; ++c)
#pragma unroll
            for (int wd = 0; wd < 4; ++wd) { const int w = (int)U[k][c][wd];
                acc = __builtin_elementwise_fma(__builtin_amdgcn_cvt_pk_f32_fp8(w, false), xs[c * 8 + wd * 2], acc);
                acc = __builtin_elementwise_fma(__builtin_amdgcn_cvt_pk_f32_fp8(w, true), xs[c * 8 + wd * 2 + 1], acc); }
        d[k] = acc.x + acc.y; }
    const bool hi32 = lane & 32, hi16 = lane & 16;
    float k0 = hi32 ? d[2] : d[0], k1 = hi32 ? d[3] : d[1];
    k0 += __shfl_xor(hi32 ? d[0] : d[2], 32); k1 += __shfl_xor(hi32 ? d[1] : d[3], 32);
    float kk = hi16 ? k1 : k0; kk += __shfl_xor(hi16 ? k0 : k1, 16);
    kk += __shfl_xor(kk, 8); kk += __shfl_xor(kk, 4); kk += __shfl_xor(kk, 2); kk += __shfl_xor(kk, 1);
    return kk;
}
DI void peer_axpy(const u32x4 (&V)[4][2], float kk, f32x2 (&y)[16], int gA, int gB, int b, float arg_scale) {
#pragma unroll
    for (int k = 0; k < 4; ++k) { const int p = 4 * b + k;
        const float dot = __int_as_float(__builtin_amdgcn_readlane(__float_as_int(kk), 16 * k));
        const float g = __int_as_float(b < 16 ? __builtin_amdgcn_readlane(gA, p & 63) : __builtin_amdgcn_readlane(gB, p & 63));
        const float coef = g * gelu_tanh(dot * arg_scale); const f32x2 cf = {coef, coef};
#pragma unroll
        for (int c = 0; c < 2; ++c)
#pragma unroll
            for (int wd = 0; wd < 4; ++wd) { const int w = (int)V[k][c][wd];
                y[c * 8 + wd * 2] = __builtin_elementwise_fma(__builtin_amdgcn_cvt_pk_f32_fp8(w, false), cf, y[c * 8 + wd * 2]);
                y[c * 8 + wd * 2 + 1] = __builtin_elementwise_fma(__builtin_amdgcn_cvt_pk_f32_fp8(w, true), cf, y[c * 8 + wd * 2 + 1]); } }
}
DI void peer_gather_token(const Args& a, int t, int lane, float* outp) {
    unsigned char* ws = a.ws;
    const bf16* xg = (const bf16*)(ws + WS_H2G) + (size_t)t * DM + lane * 16;
    f32x2 xs[16];
#pragma unroll
    for (int c = 0; c < 2; ++c)
#pragma unroll
        for (int q = 0; q < 2; ++q) { const u32x4 w = *(const u32x4*)(xg + c * 1024 + q * 8);
            xs[c * 8 + q * 4 + 0] = (f32x2){bflo(w.x), bfhi(w.x)}; xs[c * 8 + q * 4 + 1] = (f32x2){bflo(w.y), bfhi(w.y)}; xs[c * 8 + q * 4 + 2] = (f32x2){bflo(w.z), bfhi(w.z)}; xs[c * 8 + q * 4 + 3] = (f32x2){bflo(w.w), bfhi(w.w)}; }
    const float rs2 = __builtin_amdgcn_rsqf(((const float*)(ws + WS_SUMSQ2))[t] * (1.f / DM) + EPS);
    const int* eidp = (const int*)(ws + WS_EID) + (size_t)t * 128; const float* gwp = (const float*)(ws + WS_GW) + (size_t)t * 128; const float* ginv = (const float*)(ws + WS_GINV) + (size_t)t * 8;
    const int eA = eidp[lane], eB = eidp[64 + lane];
    const int gA = __float_as_int(gwp[lane] * ginv[lane >> 4] * (1.f / EV_SCALE)), gB = __float_as_int(gwp[64 + lane] * ginv[4 + (lane >> 4)] * (1.f / EV_SCALE));
    f32x2 y[16];
#pragma unroll
    for (int i = 0; i < 16; ++i) y[i] = (f32x2){0.f, 0.f};
    const unsigned char* EU = ws + WS_EU + lane * 16; const unsigned char* EV = ws + WS_EV + lane * 16;
    const float arg_scale = rs2 * (1.f / EU_SCALE);
    u32x4 U0[4][2], V0[4][2], U1[4][2], V1[4][2];
    peer_load(U0, EU, eA, eB, 0); peer_load(V0, EV, eA, eB, 0);
#pragma unroll 1
    for (int b = 0; b < 32; b += 2) {
        peer_load(U1, EU, eA, eB, b + 1);
        const float ka = peer_dots(U0, xs, lane);
        asm volatile("" ::: "memory");
        peer_load(V1, EV, eA, eB, b + 1);
        peer_axpy(V0, ka, y, gA, gB, b, arg_scale);
        asm volatile("" ::: "memory");
        if (b + 2 < 32) peer_load(U0, EU, eA, eB, b + 2);
        const float kb = peer_dots(U1, xs, lane);
        asm volatile("" ::: "memory");
        if (b + 2 < 32) peer_load(V0, EV, eA, eB, b + 2);
        peer_axpy(V1, kb, y, gA, gB, b + 1, arg_scale);
        asm volatile("" ::: "memory");
    }
    const float* hrow = a.out + (size_t)t * DM + lane * 16; float* orow = outp + (size_t)t * DM + lane * 16; const float* gf = a.in[24] + lane * 16; float ss = 0.f;
#pragma unroll
    for (int c = 0; c < 2; ++c)
#pragma unroll
        for (int q = 0; q < 4; ++q) { const f32x4 hv = *(const f32x4*)(hrow + c * 1024 + q * 4);
            f32x2& y0 = y[c * 8 + q * 2]; f32x2& y1 = y[c * 8 + q * 2 + 1];
            y0.x += hv[0]; y0.y += hv[1]; y1.x += hv[2]; y1.y += hv[3]; ss += (y0.x * y0.x + y0.y * y0.y) + (y1.x * y1.x + y1.y * y1.y); }
    const float rs = __builtin_amdgcn_rsqf(wave_sum(ss) * (1.f / DM) + EPS);
#pragma unroll
    for (int c = 0; c < 2; ++c)
#pragma unroll
        for (int q = 0; q < 4; ++q) { const f32x4 gv = *(const f32x4*)(gf + c * 1024 + q * 4); const f32x2 y0 = y[c * 8 + q * 2], y1 = y[c * 8 + q * 2 + 1];
            *(f32x4*)(orow + c * 1024 + q * 4) = (f32x4){y0.x * rs * gv[0], y0.y * rs * gv[1], y1.x * rs * gv[2], y1.y * rs * gv[3]}; }
}
#define XB_TMO      128
#define XB_XCNT(j)  (256  + 64 * (j))
#define XB_XSUB(j)  (1280 + 64 * (j))
#define XB_XGEN(j)  (2304 + 64 * (j))
#define XB_TOP      3328
#define XB_TOPGEN   3392
#define XCD_BAR_WORDS 3456
#define XB_SPIN_CAP (1u << 18)

__device__ __forceinline__ unsigned xb_ld(unsigned* p)              { return __hip_atomic_load(p, __ATOMIC_RELAXED, __HIP_MEMORY_SCOPE_AGENT); }
__device__ __forceinline__ unsigned xb_add(unsigned* p, unsigned v) { return __hip_atomic_fetch_add(p, v, __ATOMIC_RELAXED, __HIP_MEMORY_SCOPE_AGENT); }
__device__ __forceinline__ unsigned xb_xcc_id() { return (unsigned)__builtin_amdgcn_s_getreg((3 << 11) | 20) & 0xFu; }
#define XB_SPIN(cond, bar) do { unsigned _sp = 0; while (cond) { __builtin_amdgcn_s_sleep(1); \
    if ((++_sp & 255u) == 0u) { if (xb_ld(&(bar)[XB_TMO])) break; if (_sp > XB_SPIN_CAP) { atomicAdd(&(bar)[XB_TMO], 1u); break; } } } } while (0)

struct XcdBarrier {
    unsigned* bar; unsigned x;
    volatile LAS unsigned* st;
};

__device__ __forceinline__ XcdBarrier xcd_barrier_post(unsigned* bar, volatile LAS unsigned* st) {
    XcdBarrier b; b.bar = bar; b.x = xb_xcc_id(); b.st = st;
    if (threadIdx.x == 0) (void)xb_add(&bar[XB_XCNT(b.x)], 1u);
    return b;
}
__device__ __forceinline__ void xcd_barrier_complete(unsigned* bar, unsigned x, unsigned& nloc, unsigned& nx) {
    const unsigned G = gridDim.x * gridDim.y * gridDim.z;
    unsigned sum, cnt, mine, sp = 0u;
    for (;;) {
        sum = 0u; cnt = 0u; mine = 0u;
#pragma unroll
        for (unsigned j = 0; j < 16; ++j) { const unsigned c = xb_ld(&bar[XB_XCNT(j)]); sum += c; cnt += (c > 0u) ? 1u : 0u; mine = (j == x) ? c : mine; }
        if (sum == G) break;
        __builtin_amdgcn_s_sleep(1);
        if ((++sp & 255u) == 0u) { if (xb_ld(&bar[XB_TMO])) break; if (sp > XB_SPIN_CAP) { atomicAdd(&bar[XB_TMO], 1u); break; } }
    }
    nloc = mine > 0u ? mine : 1u; nx = cnt > 0u ? cnt : 1u;
}

__device__ __forceinline__ void xcd_barrier(const XcdBarrier& b) {
    asm volatile("s_waitcnt vmcnt(0)" ::: "memory");
    __syncthreads();
    if (threadIdx.x == 0) {
        unsigned* bar = b.bar;
        __builtin_amdgcn_s_waitcnt(0);
        unsigned nloc = b.st[0], nx = b.st[1];
        if (nloc == 0u) { xcd_barrier_complete(bar, b.x, nloc, nx); b.st[0] = nloc; b.st[1] = nx; }
        const unsigned old = xb_add(&bar[XB_XSUB(b.x)], 1u);
        const unsigned gen = old / nloc;
        if (old + 1u == (gen + 1u) * nloc) {
            __builtin_amdgcn_fence(__ATOMIC_RELEASE, "agent");
            asm volatile("s_waitcnt vmcnt(0)" ::: "memory");
            const unsigned og = xb_add(&bar[XB_TOP], 1u);
            const unsigned tg = og / nx;
            if (og + 1u == (tg + 1u) * nx) xb_add(&bar[XB_TOPGEN], 1u);
            else XB_SPIN(xb_ld(&bar[XB_TOPGEN]) == tg, bar);
            __builtin_amdgcn_fence(__ATOMIC_ACQUIRE, "agent");
            xb_add(&bar[XB_XGEN(b.x)], 1u);
            asm volatile("s_waitcnt vmcnt(0)" ::: "memory");
        } else {
            XB_SPIN(xb_ld(&bar[XB_XGEN(b.x)]) == gen, bar);
            __builtin_amdgcn_fence(__ATOMIC_ACQUIRE, "agent");
            asm volatile("s_waitcnt vmcnt(0)" ::: "memory");
        }
    }
    __syncthreads();
}

constexpr int NPHASES = 12;
__global__ void __launch_bounds__(NWAVES * 64, 2) fwd_kernel(Args a) {
    extern __shared__ __attribute__((aligned(16))) unsigned char lds_raw[];
    LAS unsigned char* lds = (LAS unsigned char*)lds_raw;
    const int tid = threadIdx.x, lane = tid & 63, wave = __builtin_amdgcn_readfirstlane(tid >> 6);
    const int G = gridDim.x, bx = blockIdx.x, gw = bx * NWAVES + wave, NGW = G * NWAVES;
    unsigned char* ws = a.ws;
    const int lo = a.ph_lo, hi = a.ph_hi;
    for (int u = tid; u < (LDS_BYTES - LDSCTL_OFF) / 4; u += NWAVES * 64) ((LAS unsigned*)(lds + LDSCTL_OFF))[u] = 0u;
    __syncthreads();
    XcdBarrier bar; bar.bar = (unsigned*)(ws + WS_BAR); bar.x = 0; bar.st = nullptr;
    if (hi - lo > 1) bar = xcd_barrier_post((unsigned*)(ws + WS_BAR), (volatile LAS unsigned*)(lds + LDSCTL_OFF + 64));
#ifndef PHM
#define PHM 0xfff
#endif
#define IN(k) (((PHM >> (k)) & 1) && lo <= (k) && (k) < hi)
#ifndef REPM
#define REPM 0
#endif
#define NREP(k) (1 + ((REPM >> (k)) & 1))
#define SEAM(k) do { if (IN(k) && IN((k) + 1)) { if ((k) == 0) cg::this_grid().sync(); else xcd_barrier(bar); } } while (0)
#define GEMM_PHASE(EPI, gm, S, E) pg8::gemm_phase<EPI, pg8::StaticOrder, true, true>(lds, gm, S, E)

    if (IN(0)) for (int rep = 0; rep < NREP(0); ++rep) phase_prologue(a, lds, gw, NGW, wave, lane);
    SEAM(0);
    if (IN(1)) for (int rep = 0; rep < NREP(1); ++rep) {
        { pg8::Gemm gm{(const bf16*)(ws + WS_N), (const bf16*)(ws + WS_WIN), T, NINP, 2048}; pg8::StaticOrder S; S.init(T, NINP, G, bx); EpiProj E{ws}; GEMM_PHASE(EpiProj, gm, S, E); }
        { pg8::Gemm gm{(const bf16*)(ws + WS_MN), (const bf16*)(ws + WS_WXKV), 256, 1024, 2048}; pg8::StaticOrder S; S.init(256, 1024, G, G - 1 - bx); EpiKvx E{ws}; GEMM_PHASE(EpiKvx, gm, S, E); }
    }
    SEAM(1);
    if (IN(2)) for (int rep = 0; rep < NREP(2); ++rep) {
        for (int it = bx; it < 64; it += G) compress_block(ws, it, lds, wave, lane, tid);
        for (int wi = NGW - 1 - gw; wi < 3072; wi += NGW) dilated_item(ws, wi >> 2, wi & 3, lane);
    }
    SEAM(2);
    if (IN(3)) for (int rep = 0; rep < NREP(3); ++rep) {
        LAS float* pc = (LAS float*)(lds + wave * 8192);
        for (int it = gw; it < 4096; it += NGW) { const int Gk = it >> 11, idx = it & 2047; nsa_item(ws, Gk, Gk ? 2047 - idx : idx, pc, lane); }
        dilated_combine(ws, (size_t)gw * 64 + lane, (size_t)NGW * 64);
    }
    SEAM(3);
    if (IN(4)) for (int rep = 0; rep < NREP(4); ++rep) {
        { pg8::Gemm gm{(const bf16*)(ws + WS_YA), (const bf16*)(ws + WS_WUPA), T, 2048, 512}; pg8::StaticOrder S; S.init(T, 2048, G, bx); EpiMix<0> E{ws}; GEMM_PHASE(EpiMix<0>, gm, S, E); }
        { pg8::Gemm gm{(const bf16*)(ws + WS_YB), (const bf16*)(ws + WS_WUPB), T, 2048, 1024}; pg8::StaticOrder S; S.init(T, 2048, G, bx); EpiMix<1> E{ws}; GEMM_PHASE(EpiMix<1>, gm, S, E); }
    }
    SEAM(4);
    if (IN(5)) {
        pg8::Gemm gm{(const bf16*)(ws + WS_MIX), (const bf16*)(ws + WS_WOUT), T, 2048, 2048}; pg8::StaticOrder S; S.init(T, 2048, G, bx);
        EpiRes E{a.in[0], a.out, (bf16*)(ws + WS_H1G), a.in[13], (float*)(ws + WS_SUMSQ1)}; GEMM_PHASE(EpiRes, gm, S, E);
    }
    SEAM(5);
    if (IN(6)) for (int rep = 0; rep < NREP(6); ++rep) {
        pg8::Gemm gm{(const bf16*)(ws + WS_H1G), (const bf16*)(ws + WS_WXQ), T, 512, 2048}; pg8::StaticOrder S; S.init(T, 512, G, bx);
        EpiScaleRow E{(bf16*)(ws + WS_QX), 512, (const float*)(ws + WS_SUMSQ1)}; GEMM_PHASE(EpiScaleRow, gm, S, E);
        if (G > 64 && bx >= 64) convert_experts(a, (size_t)(bx - 64) * (NWAVES * 64) + tid, (size_t)(G - 64) * (NWAVES * 64));
        else if (G <= 64) convert_experts(a, (size_t)bx * (NWAVES * 64) + tid, (size_t)G * (NWAVES * 64));
    }
    SEAM(6);
    if (IN(7)) for (int rep = 0; rep < NREP(7); ++rep) { for (int it = gw; it < 1024; it += NGW) cross_item(ws, it, lane); }
    SEAM(7);
    if (IN(8)) {
        pg8::Gemm gm{(const bf16*)(ws + WS_OX), (const bf16*)(ws + WS_WXO), T, 2048, 512}; pg8::StaticOrder S; S.init(T, 2048, G, bx);
        EpiRes E{a.out, a.out, (bf16*)(ws + WS_H2G), a.in[18], (float*)(ws + WS_SUMSQ2)}; GEMM_PHASE(EpiRes, gm, S, E);
    }
    SEAM(8);
    if (IN(9)) for (int rep = 0; rep < NREP(9); ++rep) {
        pg8::Gemm gm{(const bf16*)(ws + WS_H2G), (const bf16*)(ws + WS_WPQ), T, 2048, 2048}; pg8::StaticOrder S; S.init(T, 2048, G, bx);
        EpiScaleRow E{(bf16*)(ws + WS_PQ), 2048, (const float*)(ws + WS_SUMSQ2)}; GEMM_PHASE(EpiScaleRow, gm, S, E);
    }
    SEAM(9);
    if (IN(10)) for (int rep = 0; rep < NREP(10); ++rep) { LAS float* scr = (LAS float*)(lds + wave * 8192); for (int it = gw; it < 2048; it += NGW) peer_topk_item(ws, it, scr, lane); }
    SEAM(10);
    if (IN(11)) {
        if (NREP(11) > 1) for (int t = gw; t < T; t += NGW) peer_gather_token(a, t, lane, (float*)(ws + WS_OA));
        for (int t = gw; t < T; t += NGW) peer_gather_token(a, t, lane, a.out);
    }
#undef IN
#undef SEAM
#undef GEMM_PHASE
}

extern "C" void kernel_launch(void* const* d_in, const int* in_sizes, int n_in, void* d_out, int out_size, void* d_ws, size_t ws_size, hipStream_t stream) {
    static int grid = 0;
    if (grid == 0) {
        if (n_in != 25 || out_size != T * DM || ws_size < WS_END) { fprintf(stderr, "kernel_launch: unexpected problem (n_in %d, out %d, ws %zu < %zu)\n", n_in, out_size, ws_size, (size_t)WS_END); grid = -1; return; }
        int dev = 0, cus = 0, per_cu = 0;
        if (hipGetDevice(&dev) != hipSuccess || hipDeviceGetAttribute(&cus, hipDeviceAttributeMultiprocessorCount, dev) != hipSuccess) { grid = -1; return; }
        if (hipFuncSetAttribute((const void*)fwd_kernel, hipFuncAttributeMaxDynamicSharedMemorySize, LDS_BYTES) != hipSuccess) { fprintf(stderr, "kernel_launch: hipFuncSetAttribute failed\n"); grid = -1; return; }
        if (hipOccupancyMaxActiveBlocksPerMultiprocessor(&per_cu, (const void*)fwd_kernel, NWAVES * 64, LDS_BYTES) != hipSuccess || per_cu < 1) { fprintf(stderr, "kernel_launch: occupancy query says %d\n", per_cu); per_cu = 1; }
        (void)hipGetLastError();
        grid = cus;
    }
    if (grid < 0) return;
    (void)hipMemsetAsync((char*)d_ws, 0, CTL_ZERO_BYTES, stream);
    Args a{};
    for (int i = 0; i < 25; ++i) a.in[i] = (const float*)d_in[i];
    a.out = (float*)d_out; a.ws = (unsigned char*)d_ws;
#if ONE_LAUNCH
    a.ph_lo = 0; a.ph_hi = NPHASES;
    void* kargs[] = {&a};
    hipError_t e = hipLaunchCooperativeKernel((const void*)fwd_kernel, dim3(grid), dim3(NWAVES * 64), kargs, LDS_BYTES, stream);
    if (e != hipSuccess) fprintf(stderr, "kernel_launch: cooperative launch failed: %s (grid %d)\n", hipGetErrorString(e), grid);
#else
    for (int ph = 0; ph < NPHASES; ++ph) { a.ph_lo = ph; a.ph_hi = ph + 1; hipLaunchKernelGGL(fwd_kernel, dim3(grid), dim3(NWAVES * 64), LDS_BYTES, stream, a); }
#endif
}
```

```cpp
#include <hip/hip_runtime.h>
#include <hip/hip_cooperative_groups.h>
#include <cstdio>
#include <cstdint>
namespace cg = cooperative_groups;

#ifndef ONE_LAUNCH
#define ONE_LAUNCH 1
#endif

namespace pg8 {
#define PG8_LAS __attribute__((address_space(3)))
typedef unsigned short bf16_t;
typedef short bf16x8 __attribute__((ext_vector_type(8)));
typedef float f32x4 __attribute__((ext_vector_type(4)));
typedef unsigned u32x4 __attribute__((ext_vector_type(4)));
constexpr int BM = 256, BK = 64, HALF = 128, HTB = HALF * BK * 2  , STAGE_BYTES = 8 * HTB, NXCD = 8, WGM = 8;

__host__ __device__ __forceinline__ int lds_byte(int r, int c) { const int st = (r >> 4) * 2 + (c >> 5), rr = r & 15, cc = c & 31, ob = rr * 64 + cc * 2; return st * 1024 + (ob ^ (((ob >> 9) & 1) << 5)); }
__host__ __device__ __forceinline__ void stage_rc(int b, int& R, int& C) { const int st = b / 1024, sb = b % 1024, swz = sb ^ (((sb >> 9) & 1) << 5); R = (st >> 1) * 16 + swz / 64; C = (st & 1) * 32 + (swz % 64) / 2; }
__host__ __device__ __forceinline__ int perm32(int rho) { const int n = rho >> 4, i = rho & 15; return 8 * (i >> 2) + 4 * n + (i & 3); }

struct Unit { int pm, pn; };
struct Gemm { const bf16_t* A; const bf16_t* Bt; int M, N, K; };

struct StaticOrder {
    int nM, nN, nwg, G, c;
    __host__ __device__ void init(int M, int N, int G_, int c_) { nM = M / BM; nN = N / BM; nwg = nM * nN; G = G_; c = c_; }
    __host__ __device__ bool next(int i, Unit& u) const {
        const long L = (long)i * G + c; if (L >= nwg) return false;
        int wgid = (int)L; { const int q = nwg / NXCD, r = nwg % NXCD, xcd = wgid % NXCD, off = wgid / NXCD; wgid = (xcd < r ? xcd * (q + 1) : r * (q + 1) + (xcd - r) * q) + off; }
        const int nig = WGM * nN, gid = wgid / nig, fm = gid * WGM, gsz = (nM - fm) < WGM ? (nM - fm) : WGM;
        u.pm = fm + ((wgid % nig) % gsz); u.pn = (wgid % nig) / gsz; return true;
    }
    __device__ __forceinline__ void a_ready(const Unit&) const {}
    __device__ __forceinline__ void done(const Unit&) const {}
};

__device__ __forceinline__ unsigned cvt_pk_bf16(float lo, float hi) { typedef float f2_t __attribute__((ext_vector_type(2))); typedef __bf16 b2_t __attribute__((ext_vector_type(2)));
    f2_t v = {lo, hi}; b2_t b = __builtin_convertvector(v, b2_t); return __builtin_bit_cast(unsigned, b); }
template <class Epi, class Sched, bool ALIGN_EPI = false, bool SP2 = false>
__device__ __forceinline__ void gemm_phase(PG8_LAS unsigned char* lds, const Gemm g, const Sched& S, const Epi& E) {
    const int tid = threadIdx.x, wid = __builtin_amdgcn_readfirstlane(tid >> 6), lane = tid & 63, wr = wid >> 2, wc = wid & 3, fr = lane & 15, fq = lane >> 4;
    const int K = g.K, nt = K / BK;
    unsigned voffA[2], voffB[2];
#pragma unroll
    for (int i = 0; i < 2; ++i) { int R, C; stage_rc(tid * 16 + i * 8192, R, C); const int Rb = Epi::PERM ? ((R & ~31) + perm32(R & 31)) : R;
        voffA[i] = (unsigned)(R * K + C) * 2u; voffB[i] = (unsigned)(Rb * K + C) * 2u; }
    const size_t kstep = (size_t)(BK * 2);
    const size_t hstep = (size_t)HALF * K * 2;
    const size_t tstep = 2 * hstep;
    const unsigned ldsw = (unsigned)wid * 1024u;
    const int aoff = lds_byte(wr * 64 + fr, fq * 8), boff = lds_byte(wc * 32 + fr, fq * 8);
#define PG8_SA(b, h) (((b) * 2 + (h)) * HTB)
#define PG8_SB(b, h) ((4 + (b) * 2 + (h)) * HTB)
#define PG8_STAGE(bufoff, gbase, voff) do { _Pragma("unroll") for (int _i = 0; _i < 2; ++_i) \
        __builtin_amdgcn_global_load_lds((const unsigned*)((const char*)(gbase) + (voff)[_i]), (PG8_LAS unsigned*)(lds + (bufoff) + ldsw + _i * 8192), 16, 0, 0); } while (0)
#define PG8_LDA(dst, b, h) do { _Pragma("unroll") for (int m = 0; m < 4; ++m) _Pragma("unroll") for (int k = 0; k < 2; ++k) dst[m][k] = *(const PG8_LAS bf16x8*)(lds + PG8_SA(b, h) + aoff + m * 2048 + k * 1024); } while (0)
#define PG8_LDB(dst, b, h) do { _Pragma("unroll") for (int n = 0; n < 2; ++n) _Pragma("unroll") for (int k = 0; k < 2; ++k) dst[n][k] = *(const PG8_LAS bf16x8*)(lds + PG8_SB(b, h) + boff + n * 2048 + k * 1024); } while (0)
#define PG8_MMA(ai, bj, At, Bt) do { __builtin_amdgcn_s_setprio(1); _Pragma("unroll") for (int m = 0; m < 4; ++m) _Pragma("unroll") for (int n = 0; n < 2; ++n) _Pragma("unroll") for (int k = 0; k < 2; ++k) \
        acc[ai][bj][m][n] = __builtin_amdgcn_mfma_f32_16x16x32_bf16(Bt[n][k], At[m][k], acc[ai][bj][m][n], 0, 0, 0); __builtin_amdgcn_s_setprio(0); } while (0)
#define PG8_WAIT_V(n) asm volatile("s_waitcnt vmcnt(" #n ")" ::: "memory")
#define PG8_WAIT_L(n) asm volatile("s_waitcnt lgkmcnt(" #n ")" ::: "memory")
#define PG8_BAR __builtin_amdgcn_s_barrier()
#define PG8_SCHED __builtin_amdgcn_sched_barrier(0)
    Unit cur, nxt; int ui = 0;
    if (!S.next(0, cur)) return;
    f32x4 acc[2][2][4][2];
#pragma unroll
    for (int a = 0; a < 2; ++a)
#pragma unroll
        for (int b = 0; b < 2; ++b)
#pragma unroll
            for (int m = 0; m < 4; ++m)
#pragma unroll
                for (int n = 0; n < 2; ++n) acc[a][b][m][n] = (f32x4){0.f, 0.f, 0.f, 0.f};
    bf16x8 At[4][2], B0[2][2], B1[2][2];
    const char* cA = (const char*)g.A + (size_t)cur.pm * tstep; const char* cB = (const char*)g.Bt + (size_t)cur.pn * tstep;
    S.a_ready(cur);
    if constexpr (SP2) {
        PG8_STAGE(PG8_SB(0, 0), cB, voffB); PG8_STAGE(PG8_SB(0, 1), cB + hstep, voffB); PG8_STAGE(PG8_SA(0, 0), cA, voffA); PG8_STAGE(PG8_SA(0, 1), cA + hstep, voffA);
        if (wr == 1) PG8_BAR;
        PG8_WAIT_V(2); PG8_BAR;
        PG8_STAGE(PG8_SB(1, 0), cB + kstep, voffB); PG8_STAGE(PG8_SA(1, 0), cA + kstep, voffA); PG8_STAGE(PG8_SB(1, 1), cB + hstep + kstep, voffB);
        PG8_WAIT_V(6); PG8_BAR;
    } else {
        PG8_STAGE(PG8_SB(0, 0), cB, voffB); PG8_STAGE(PG8_SA(0, 0), cA, voffA); PG8_STAGE(PG8_SB(0, 1), cB + hstep, voffB); PG8_STAGE(PG8_SA(0, 1), cA + hstep, voffA);
        if (wr == 1) PG8_BAR;
        PG8_WAIT_V(4); PG8_BAR;
        PG8_STAGE(PG8_SB(1, 0), cB + kstep, voffB); PG8_STAGE(PG8_SA(1, 0), cA + kstep, voffA); PG8_STAGE(PG8_SB(1, 1), cB + hstep + kstep, voffB);
        PG8_WAIT_V(6); PG8_BAR;
    }
    for (;;) {
        const bool has_next = S.next(ui + 1, nxt);
        const char* nA = has_next ? (const char*)g.A + (size_t)nxt.pm * tstep : cA; const char* nB = has_next ? (const char*)g.Bt + (size_t)nxt.pn * tstep : cB;
        for (int t = 0; t < nt; t += 2) {
            const bool last = (t == nt - 2);
            const char* a1 = cA + (size_t)(t + 1) * kstep;
            const char* a2 = last ? nA : cA + (size_t)(t + 2) * kstep; const char* b2 = last ? nB : cB + (size_t)(t + 2) * kstep;
            const char* a3 = a2 + kstep; const char* b3 = b2 + kstep;
            if (last && has_next) S.a_ready(nxt);
            if constexpr (SP2) {
            PG8_LDB(B0, 0, 0); PG8_LDB(B1, 0, 1); PG8_SCHED; PG8_LDA(At, 0, 0); PG8_STAGE(PG8_SA(1, 1), a1 + hstep, voffA);
            PG8_WAIT_V(8); PG8_WAIT_L(0); PG8_BAR; PG8_MMA(0, 0, At, B0); PG8_MMA(0, 1, At, B1); PG8_BAR; PG8_SCHED;
            PG8_LDA(At, 0, 1); PG8_STAGE(PG8_SB(0, 0), b2, voffB); PG8_STAGE(PG8_SB(0, 1), b2 + hstep, voffB); PG8_STAGE(PG8_SA(0, 0), a2, voffA);
            PG8_WAIT_V(8); PG8_WAIT_L(0); PG8_BAR; PG8_MMA(1, 0, At, B0); PG8_MMA(1, 1, At, B1); PG8_BAR; PG8_SCHED;
            PG8_LDB(B0, 1, 0); PG8_LDB(B1, 1, 1); PG8_SCHED; PG8_LDA(At, 1, 0); PG8_STAGE(PG8_SA(0, 1), a2 + hstep, voffA);
            PG8_WAIT_V(8); PG8_WAIT_L(0); PG8_BAR; PG8_MMA(0, 0, At, B0); PG8_MMA(0, 1, At, B1); PG8_BAR; PG8_SCHED;
            PG8_LDA(At, 1, 1); PG8_STAGE(PG8_SB(1, 0), b3, voffB); PG8_STAGE(PG8_SB(1, 1), b3 + hstep, voffB); PG8_STAGE(PG8_SA(1, 0), a3, voffA);
            PG8_WAIT_V(8); PG8_WAIT_L(0); PG8_BAR; PG8_MMA(1, 0, At, B0); PG8_MMA(1, 1, At, B1); PG8_BAR; PG8_SCHED;
            } else {
            PG8_LDB(B0, 0, 0); PG8_SCHED; PG8_LDA(At, 0, 0); PG8_STAGE(PG8_SA(1, 1), a1 + hstep, voffA);
            PG8_WAIT_L(8); PG8_BAR; PG8_WAIT_L(0); PG8_MMA(0, 0, At, B0); PG8_BAR; PG8_SCHED;
            PG8_LDB(B1, 0, 1); PG8_STAGE(PG8_SB(0, 0), b2, voffB);
            PG8_BAR; PG8_WAIT_L(0); PG8_MMA(0, 1, At, B1); PG8_BAR;
            PG8_LDA(At, 0, 1); PG8_STAGE(PG8_SA(0, 0), a2, voffA);
            PG8_BAR; PG8_WAIT_L(0); PG8_MMA(1, 0, At, B0); PG8_BAR; PG8_SCHED;
            PG8_STAGE(PG8_SB(0, 1), b2 + hstep, voffB);
            PG8_WAIT_V(6); PG8_BAR; PG8_MMA(1, 1, At, B1); PG8_BAR;
            PG8_LDB(B0, 1, 0); PG8_SCHED; PG8_LDA(At, 1, 0); PG8_STAGE(PG8_SA(0, 1), a2 + hstep, voffA);
            PG8_WAIT_L(8); PG8_BAR; PG8_WAIT_L(0); PG8_MMA(0, 0, At, B0); PG8_BAR; PG8_SCHED;
            PG8_LDB(B1, 1, 1); PG8_STAGE(PG8_SB(1, 0), b3, voffB);
            PG8_BAR; PG8_WAIT_L(0); PG8_MMA(0, 1, At, B1); PG8_BAR;
            PG8_LDA(At, 1, 1); PG8_STAGE(PG8_SA(1, 0), a3, voffA);
            PG8_BAR; PG8_WAIT_L(0); PG8_MMA(1, 0, At, B0); PG8_BAR; PG8_SCHED;
            PG8_STAGE(PG8_SB(1, 1), b3 + hstep, voffB);
            PG8_WAIT_V(6); PG8_BAR; PG8_MMA(1, 1, At, B1); PG8_BAR;
            }
        }
        if constexpr (ALIGN_EPI) { if (wr == 0) PG8_BAR; }
        if constexpr (!Epi::AFTER_DRAIN) { E(acc, cur, wr, wc, fr, fq); S.done(cur); }
        if (!has_next) break;
#pragma unroll
        for (int a = 0; a < 2; ++a)
#pragma unroll
            for (int b = 0; b < 2; ++b)
#pragma unroll
                for (int m = 0; m < 4; ++m)
#pragma unroll
                    for (int n = 0; n < 2; ++n) acc[a][b][m][n] = (f32x4){0.f, 0.f, 0.f, 0.f};
        cur = nxt; cA = nA; cB = nB; ++ui;
        if constexpr (ALIGN_EPI) { if (wr == 1) PG8_BAR; }
    }
    PG8_WAIT_V(0);
    if constexpr (!ALIGN_EPI) { if (wr == 0) PG8_BAR; }
    PG8_BAR;
    if constexpr (Epi::AFTER_DRAIN) { E.fused(acc, cur, wr, wc, fr, fq, lds, wid, lane); S.done(cur); }
#undef PG8_SA
#undef PG8_SB
#undef PG8_STAGE
#undef PG8_LDA
#undef PG8_LDB
#undef PG8_MMA
#undef PG8_WAIT_V
#undef PG8_WAIT_L
#undef PG8_BAR
#undef PG8_SCHED
}
}
#define LAS __attribute__((address_space(3)))
#define DI __device__ __forceinline__
typedef unsigned short bf16;
typedef short bf16x8 __attribute__((ext_vector_type(8)));
typedef short s16x4 __attribute__((ext_vector_type(4)));
typedef float f32x2 __attribute__((ext_vector_type(2)));
typedef float f32x4 __attribute__((ext_vector_type(4)));
typedef float f32x16 __attribute__((ext_vector_type(16)));
typedef unsigned u32x2 __attribute__((ext_vector_type(2)));
typedef unsigned u32x4 __attribute__((ext_vector_type(4)));
using pg8::cvt_pk_bf16;
#define MFMA32(a, b, c) __builtin_amdgcn_mfma_f32_32x32x16_bf16((a), (b), (c), 0, 0, 0)

constexpr int T = 8192, DM = 2048, NWAVES = 8;
constexpr int NIN = 10544, NINP = 10752;
constexpr float LOG2E = 1.4426950408889634f, LN2 = 0.6931471805599453f, NEGBIG = -1e30f, EPS = 1e-6f;

constexpr size_t MiB = 1u << 20;
constexpr size_t WS_SUMSQ1 = 0, WS_SUMSQ2 = 32768, WS_BAR = 65536, CTL_ZERO_BYTES = 65536 + 16384;
constexpr size_t WS_WCK1T = 1 * MiB, WS_WCV1T = 1 * MiB + 512 * 1024, WS_WCK2T = 2 * MiB, WS_WCV2T = 2 * MiB + 16384, WS_SK1 = 2 * MiB + 32768, WS_SK2 = 2 * MiB + 65536,
                 WS_PEBK = 2 * MiB + 98304, WS_PEBV = 2 * MiB + 98304 + 512, WS_KX = 3 * MiB, WS_VXT = 3 * MiB + 262144, WS_KC = 3 * MiB + 524288, WS_VCT = 3 * MiB + 524288 + 131072,
                 WS_LSE = 4 * MiB, WS_GINV = 5 * MiB, WS_MN = 6 * MiB;
constexpr size_t WS_WIN = 8 * MiB, WS_WUPA = 50 * MiB, WS_WUPB = 52 * MiB, WS_WOUT = 56 * MiB, WS_WXQ = 64 * MiB, WS_WXKV = 66 * MiB, WS_WXO = 70 * MiB, WS_WPQ = 72 * MiB;
constexpr size_t WS_SSQ1 = 144 * MiB, WS_SSQ2 = 145 * MiB;
constexpr size_t WS_EU = 80 * MiB, WS_EV = 112 * MiB;
constexpr size_t WS_N = 208 * MiB, WS_MIXTMP = 208 * MiB, WS_AQ = 240 * MiB, WS_AK = 264 * MiB, WS_AVT = 288 * MiB, WS_BQ = 312 * MiB;
constexpr size_t WS_KCS = 328 * MiB, WS_VCS = 330 * MiB, WS_KS = 332 * MiB, WS_VST = 334 * MiB, WS_KW = 336 * MiB, WS_VWT = 338 * MiB, WS_BG = 340 * MiB, WS_MG = 342 * MiB;
constexpr size_t WS_OA = 406 * MiB, WS_YA = 431 * MiB, WS_YB = 439 * MiB, WS_MIX = 455 * MiB, WS_END = 487 * MiB;
constexpr size_t WS_H1G = 240 * MiB, WS_QX = 272 * MiB, WS_OX = 280 * MiB, WS_H2G = 288 * MiB, WS_PQ = 320 * MiB, WS_EID = 352 * MiB, WS_GW = 356 * MiB;
constexpr int LDSCTL_OFF = 131072;
constexpr int LDS_BYTES = 147456;

struct Args { const float* in[25]; float* out; unsigned char* ws; int ph_lo, ph_hi; };

DI float bflo(unsigned w) { return __uint_as_float(w << 16); }
DI float bfhi(unsigned w) { return __uint_as_float(w & 0xffff0000u); }
DI float bf2f(bf16 b) { return __uint_as_float(((unsigned)b) << 16); }
DI bf16 f2bf(float f) { return (bf16)(cvt_pk_bf16(f, 0.f) & 0xffffu); }
DI float fexp2(float x) { return __builtin_amdgcn_exp2f(x); }
DI float sigm(float x) { return 1.f / (1.f + __expf(-x)); }
DI float gelu_tanh(float x) { const float u = 0.7978845608028654f * (x + 0.044715f * x * x * x); return x / (1.f + __expf(-2.f * u)); }
DI int crow(int r, int h) { return (r & 3) + 8 * (r >> 2) + 4 * h; }
DI float wave_sum(float v) {
#pragma unroll
    for (int o = 1; o < 64; o <<= 1) v += __shfl_xor(v, o);
    return v;
}
DI u32x4 pack8(const f32x4& a, const f32x4& b) { u32x4 w; w.x = cvt_pk_bf16(a[0], a[1]); w.y = cvt_pk_bf16(a[2], a[3]); w.z = cvt_pk_bf16(b[0], b[1]); w.w = cvt_pk_bf16(b[2], b[3]); return w; }
DI bf16x8 pack8f(const float* p) { u32x4 w; w.x = cvt_pk_bf16(p[0], p[1]); w.y = cvt_pk_bf16(p[2], p[3]); w.z = cvt_pk_bf16(p[4], p[5]); w.w = cvt_pk_bf16(p[6], p[7]); return __builtin_bit_cast(bf16x8, w); }
DI bf16x8 cat4(s16x4 a, s16x4 b) { return (bf16x8){a[0], a[1], a[2], a[3], b[0], b[1], b[2], b[3]}; }

struct EpiProj {
    static constexpr bool PERM = true, AFTER_DRAIN = false;
    unsigned char* ws;
    DI void operator()(const f32x4 (&acc)[2][2][4][2], const pg8::Unit& u, int wr, int wc, int fr, int fq) const {
#pragma unroll
        for (int bj = 0; bj < 2; ++bj) {
            const int c8 = u.pn * 256 + bj * 128 + wc * 32 + 8 * fq;
            if (c8 >= NIN) continue;
            const int r0 = u.pm * 256 + wr * 64 + fr;
            if (c8 < 4608) {
                const int qkv = c8 / 1536, rem = c8 % 1536, g = rem / 512, hh = (rem % 512) / 128, d = rem % 128, ld = 2 * g, dm1 = (1 << ld) - 1;
                {
                    bf16* base = (bf16*)(ws + (qkv == 0 ? WS_AQ : qkv == 1 ? WS_AK : WS_AVT)) + (size_t)(g * 4 + hh) * T * 128 + d;
#pragma unroll
                    for (int ai = 0; ai < 2; ++ai)
#pragma unroll
                        for (int m = 0; m < 4; ++m) { const int t = r0 + ai * 128 + m * 16, tp = ((t & dm1) << (13 - ld)) + (t >> ld);
                            *(u32x4*)(base + (size_t)tp * 128) = pack8(acc[ai][bj][m][0], acc[ai][bj][m][1]); }
                }
            } else if (c8 < 5632) {
                bf16* base = (bf16*)(ws + WS_BQ) + (c8 - 4608);
#pragma unroll
                for (int ai = 0; ai < 2; ++ai)
#pragma unroll
                    for (int m = 0; m < 4; ++m) { const int t = r0 + ai * 128 + m * 16; *(u32x4*)(base + (size_t)t * 1024) = pack8(acc[ai][bj][m][0], acc[ai][bj][m][1]); }
            } else if (c8 < 6400) {
                const int c = c8 - 5632, br = c / 256, kv = (c % 256) / 128, G = (c % 128) / 64, d = c % 64;
                {
                    const size_t off = kv == 0 ? (br == 0 ? WS_KCS : br == 1 ? WS_KS : WS_KW) : (br == 0 ? WS_VCS : br == 1 ? WS_VST : WS_VWT);
                    bf16* base = (bf16*)(ws + off) + (size_t)G * T * 64 + d;
#pragma unroll
                    for (int ai = 0; ai < 2; ++ai)
#pragma unroll
                        for (int m = 0; m < 4; ++m) { const int t = r0 + ai * 128 + m * 16; *(u32x4*)(base + (size_t)t * 64) = pack8(acc[ai][bj][m][0], acc[ai][bj][m][1]); }
                }
            } else if (c8 < 10496) {
                bf16* base = (bf16*)(ws + WS_MG) + (c8 - 6400);
#pragma unroll
                for (int ai = 0; ai < 2; ++ai)
#pragma unroll
                    for (int m = 0; m < 4; ++m) { const int t = r0 + ai * 128 + m * 16; f32x4 a = acc[ai][bj][m][0], b = acc[ai][bj][m][1];
#pragma unroll
                        for (int e = 0; e < 4; ++e) { a[e] = sigm(a[e]); b[e] = sigm(b[e]); }
                        *(u32x4*)(base + (size_t)t * 4096) = pack8(a, b); }
            } else {
                float* base = (float*)(ws + WS_BG) + (c8 - 10496);
#pragma unroll
                for (int ai = 0; ai < 2; ++ai)
#pragma unroll
                    for (int m = 0; m < 4; ++m) { const int t = r0 + ai * 128 + m * 16; f32x4 a = acc[ai][bj][m][0], b = acc[ai][bj][m][1];
#pragma unroll
                        for (int e = 0; e < 4; ++e) { a[e] = sigm(a[e]); b[e] = sigm(b[e]); }
                        *(f32x4*)(base + (size_t)t * 48) = a; *(f32x4*)(base + (size_t)t * 48 + 4) = b; }
            }
        }
    }
};
struct EpiKvx {
    static constexpr bool PERM = true, AFTER_DRAIN = false;
    unsigned char* ws;
    DI void operator()(const f32x4 (&acc)[2][2][4][2], const pg8::Unit& u, int wr, int wc, int fr, int fq) const {
#pragma unroll
        for (int bj = 0; bj < 2; ++bj) {
            const int c8 = u.pn * 256 + bj * 128 + wc * 32 + 8 * fq, kvi = c8 / 512, hx = (c8 % 512) / 128, d = c8 % 128, r0 = wr * 64 + fr;
#pragma unroll
            for (int ai = 0; ai < 2; ++ai)
#pragma unroll
                for (int m = 0; m < 4; ++m) { const int row = r0 + ai * 128 + m * 16;
                    *(u32x4*)((bf16*)(ws + (kvi == 0 ? WS_KX : WS_VXT)) + (size_t)(hx * 256 + row) * 128 + d) = pack8(acc[ai][bj][m][0], acc[ai][bj][m][1]); }
        }
    }
};
template <int SECOND> struct EpiMix {
    static constexpr bool PERM = true, AFTER_DRAIN = false;
    unsigned char* ws;
    DI void operator()(const f32x4 (&acc)[2][2][4][2], const pg8::Unit& u, int wr, int wc, int fr, int fq) const {
#pragma unroll
        for (int bj = 0; bj < 2; ++bj) {
            const int c8 = u.pn * 256 + bj * 128 + wc * 32 + 8 * fq, r0 = u.pm * 256 + wr * 64 + fr;
#pragma unroll
            for (int ai = 0; ai < 2; ++ai)
#pragma unroll
                for (int m = 0; m < 4; ++m) { const int t = r0 + ai * 128 + m * 16;
                    const u32x4 gt = *(const u32x4*)((const bf16*)(ws + WS_MG) + (size_t)t * 4096 + SECOND * 2048 + c8);
                    f32x4 a = acc[ai][bj][m][0], b = acc[ai][bj][m][1];
                    a[0] *= bflo(gt.x); a[1] *= bfhi(gt.x); a[2] *= bflo(gt.y); a[3] *= bfhi(gt.y); b[0] *= bflo(gt.z); b[1] *= bfhi(gt.z); b[2] *= bflo(gt.w); b[3] *= bfhi(gt.w);
                    if (SECOND) { const u32x4 p = *(const u32x4*)((const bf16*)(ws + WS_MIXTMP) + (size_t)t * 2048 + c8);
                        a[0] += bflo(p.x); a[1] += bfhi(p.x); a[2] += bflo(p.y); a[3] += bfhi(p.y); b[0] += bflo(p.z); b[1] += bfhi(p.z); b[2] += bflo(p.w); b[3] += bfhi(p.w); }
                    *(u32x4*)((bf16*)(ws + (SECOND ? WS_MIX : WS_MIXTMP)) + (size_t)t * 2048 + c8) = pack8(a, b); }
        }
    }
};
DI float row_rs(const float* part) {
    float s = 0.f;
#pragma unroll
    for (int i = 0; i < 8; ++i) { const f32x4 p = *(const f32x4*)(part + 4 * i); s += (p[0] + p[1]) + (p[2] + p[3]); }
    return __builtin_amdgcn_rsqf(s * (1.f / DM) + EPS);
}
struct EpiRes {
    static constexpr bool PERM = false, AFTER_DRAIN = false;
    const float* base; float* out; bf16* hg; const float* gain; float* sumsq;
    DI void operator()(const f32x4 (&acc)[2][2][4][2], const pg8::Unit& u, int wr, int wc, int fr, int fq) const {
        const int r0 = u.pm * 256 + wr * 64 + fr, c0 = u.pn * 256 + wc * 32 + 4 * fq;
#pragma unroll
        for (int ai = 0; ai < 2; ++ai)
#pragma unroll
            for (int m = 0; m < 4; ++m) { const int t = r0 + ai * 128 + m * 16; float ss = 0.f;
#pragma unroll
                for (int bj = 0; bj < 2; ++bj)
#pragma unroll
                    for (int n = 0; n < 2; ++n) { const int c = c0 + bj * 128 + 16 * n; const size_t off = (size_t)t * DM + c;
                        const f32x4 h = *(const f32x4*)(base + off) + acc[ai][bj][m][n]; const f32x4 g = *(const f32x4*)(gain + c);
                        *(f32x4*)(out + off) = h; ss += (h[0] * h[0] + h[1] * h[1]) + (h[2] * h[2] + h[3] * h[3]);
                        u32x2 w; w.x = cvt_pk_bf16(h[0] * g[0], h[1] * g[1]); w.y = cvt_pk_bf16(h[2] * g[2], h[3] * g[3]); *(u32x2*)(hg + off) = w; }
                ss += __shfl_xor(ss, 16); ss += __shfl_xor(ss, 32);
                if (fq == 0) sumsq[(size_t)t * 32 + u.pn * 4 + wc] = ss; }
    }
};
struct EpiScaleRow {
    static constexpr bool PERM = true, AFTER_DRAIN = false;
    bf16* O; int ldc; const float* sumsq;
    DI void operator()(const f32x4 (&acc)[2][2][4][2], const pg8::Unit& u, int wr, int wc, int fr, int fq) const {
        const int r0 = u.pm * 256 + wr * 64 + fr;
#pragma unroll
        for (int ai = 0; ai < 2; ++ai)
#pragma unroll
            for (int m = 0; m < 4; ++m) { const int t = r0 + ai * 128 + m * 16; const float rs = row_rs(sumsq + (size_t)t * 32);
#pragma unroll
                for (int bj = 0; bj < 2; ++bj) { const int c8 = u.pn * 256 + bj * 128 + wc * 32 + 8 * fq;
                    *(u32x4*)(O + (size_t)t * ldc + c8) = pack8(acc[ai][bj][m][0] * rs, acc[ai][bj][m][1] * rs); } }
    }
};
template <class RowMap>
DI void transpose_item(const float* W, int K, int N, bf16* WT, LAS float* scr, int item, int lane, RowMap rowmap) {
    const int nblk = (N + 63) / 64, kb = item / nblk, nb = item % nblk, k0 = 64 * kb, n0 = 64 * nb;
    const int nn = n0 + lane; const bool okn = nn < N;
    float v[64];
#pragma unroll
    for (int i = 0; i < 64; ++i) v[i] = okn ? W[(size_t)(k0 + i) * N + nn] : 0.f;
#pragma unroll
    for (int i = 0; i < 64; ++i) scr[i * 64 + (lane ^ (8 * ((i >> 3) & 3)))] = v[i];
    asm volatile("s_waitcnt lgkmcnt(0)" ::: "memory");
    const int c = lane & 7, sw = 8 * (c & 3);
#pragma unroll
    for (int j = 0; j < 8; ++j) { const int nl = (lane >> 3) + 8 * j, n = n0 + nl; const LAS float* s = scr + (8 * c) * 64 + (nl ^ sw);
        u32x4 o; o.x = cvt_pk_bf16(s[0 * 64], s[1 * 64]); o.y = cvt_pk_bf16(s[2 * 64], s[3 * 64]); o.z = cvt_pk_bf16(s[4 * 64], s[5 * 64]); o.w = cvt_pk_bf16(s[6 * 64], s[7 * 64]);
        if (n < N) *(u32x4*)(WT + (size_t)rowmap(n) * K + k0 + 8 * c) = o; }
    asm volatile("s_waitcnt lgkmcnt(0)" ::: "memory");
}
struct RowId { DI int operator()(int n) const { return n; } };
struct RowWin { DI int operator()(int n) const { return n < 6400 ? n : (n < 6448 ? n + 4096 : n - 48); } };

DI void rms_row_to_bf16(const float* xrow, const float* gain, bf16* orow, int lane) {
    f32x4 v[8]; float s = 0.f;
#pragma unroll
    for (int j = 0; j < 8; ++j) { v[j] = *(const f32x4*)(xrow + j * 256 + lane * 4); s += (v[j][0] * v[j][0] + v[j][1] * v[j][1]) + (v[j][2] * v[j][2] + v[j][3] * v[j][3]); }
    const float rs = __builtin_amdgcn_rsqf(wave_sum(s) * (1.f / DM) + EPS);
#pragma unroll
    for (int j = 0; j < 8; ++j) { const f32x4 g = *(const f32x4*)(gain + j * 256 + lane * 4); u32x2 w; w.x = cvt_pk_bf16(v[j][0] * rs * g[0], v[j][1] * rs * g[1]); w.y = cvt_pk_bf16(v[j][2] * rs * g[2], v[j][3] * rs * g[3]);
        *(u32x2*)(orow + j * 256 + lane * 4) = w; }
}
DI void phase_prologue(const Args& a, LAS unsigned char* lds, int gw, int NGW, int wave, int lane) {
    unsigned char* ws = a.ws;
    LAS float* scr = (LAS float*)(lds + wave * 16384);
    constexpr int I_WIN = 32 * 165, I_UPA = 8 * 32, I_UPB = 16 * 32, I_OUT = 32 * 32, I_XQ = 32 * 8, I_XKV = 32 * 16, I_XO = 8 * 32, I_PQ = 32 * 32, I_C1 = 32 * 2, I_C2 = 2 * 1;
    constexpr int NITEMS = I_WIN + I_UPA + I_UPB + I_OUT + I_XQ + I_XKV + I_XO + I_PQ + 2 * I_C1 + 2 * I_C2;
    for (int it = gw; it < NITEMS; it += NGW) {
        int r = it;
        if (r < I_WIN) { transpose_item(a.in[3], 2048, NIN, (bf16*)(ws + WS_WIN), scr, r, lane, RowWin()); continue; } r -= I_WIN;
        if (r < I_UPA) { transpose_item(a.in[10], 512, 2048, (bf16*)(ws + WS_WUPA), scr, r, lane, RowId()); continue; } r -= I_UPA;
        if (r < I_UPB) { transpose_item(a.in[11], 1024, 2048, (bf16*)(ws + WS_WUPB), scr, r, lane, RowId()); continue; } r -= I_UPB;
        if (r < I_OUT) { transpose_item(a.in[12], 2048, 2048, (bf16*)(ws + WS_WOUT), scr, r, lane, RowId()); continue; } r -= I_OUT;
        if (r < I_XQ) { transpose_item(a.in[15], 2048, 512, (bf16*)(ws + WS_WXQ), scr, r, lane, RowId()); continue; } r -= I_XQ;
        if (r < I_XKV) { transpose_item(a.in[16], 2048, 1024, (bf16*)(ws + WS_WXKV), scr, r, lane, RowId()); continue; } r -= I_XKV;
        if (r < I_XO) { transpose_item(a.in[17], 512, 2048, (bf16*)(ws + WS_WXO), scr, r, lane, RowId()); continue; } r -= I_XO;
        if (r < I_PQ) { transpose_item(a.in[19], 2048, 2048, (bf16*)(ws + WS_WPQ), scr, r, lane, RowId()); continue; } r -= I_PQ;
        if (r < I_C1) { transpose_item(a.in[4], 2048, 128, (bf16*)(ws + WS_WCK1T), scr, r, lane, RowId()); continue; } r -= I_C1;
        if (r < I_C1) { transpose_item(a.in[7], 2048, 128, (bf16*)(ws + WS_WCV1T), scr, r, lane, RowId()); continue; } r -= I_C1;
        if (r < I_C2) { transpose_item(a.in[5], 128, 64, (bf16*)(ws + WS_WCK2T), scr, r, lane, RowId()); continue; } r -= I_C2;
        transpose_item(a.in[8], 128, 64, (bf16*)(ws + WS_WCV2T), scr, r, lane, RowId());
    }
    { u32x4* p = (u32x4*)((bf16*)(ws + WS_WIN) + (size_t)NIN * 2048); const int n16 = (NINP - NIN) * 2048 / 8;
      for (int i = gw * 64 + lane; i < n16; i += NGW * 64) p[i] = (u32x4){0u, 0u, 0u, 0u}; }
    for (int m = gw; m < T + 256; m += NGW) {
        if (m < T) rms_row_to_bf16(a.in[0] + (size_t)m * DM, a.in[2], (bf16*)(ws + WS_N) + (size_t)m * DM, lane);
        else rms_row_to_bf16(a.in[1] + (size_t)(m - T) * DM, a.in[14], (bf16*)(ws + WS_MN) + (size_t)(m - T) * DM, lane);
    }
    {   const size_t tid = (size_t)gw * 64 + lane, nth = (size_t)NGW * 64;
        for (int tb = 0; tb < 2; ++tb) { const f32x4* src = (const f32x4*)a.in[20 + tb]; u32x4* dst = (u32x4*)(ws + (tb ? WS_SK2 : WS_SK1));
            for (size_t i = tid; i < 128 * 128 / 8; i += nth) dst[i] = pack8(src[2 * i], src[2 * i + 1]); }
    }
    for (int o = gw; o < 256; o += NGW) { const int kv = o >> 7, j = o & 127; const float* pe = a.in[kv ? 9 : 6]; const float* w1 = a.in[kv ? 7 : 4]; float s = 0.f;
        for (int i = lane; i < 2048; i += 64) s += pe[i] * w1[(size_t)i * 128 + j];
        s = wave_sum(s); if (lane == 0) ((float*)(ws + (kv ? WS_PEBV : WS_PEBK)))[j] = s; }
}
constexpr float EU_SCALE = 64.f, EV_SCALE = 8.f;
DI unsigned pk4_fp8(const f32x4 v, float sc) {
    const float a = __builtin_amdgcn_fmed3f(v[0] * sc, -448.f, 448.f), b = __builtin_amdgcn_fmed3f(v[1] * sc, -448.f, 448.f), c = __builtin_amdgcn_fmed3f(v[2] * sc, -448.f, 448.f), d = __builtin_amdgcn_fmed3f(v[3] * sc, -448.f, 448.f);
    int w = __builtin_amdgcn_cvt_pk_fp8_f32(a, b, 0, false); w = __builtin_amdgcn_cvt_pk_fp8_f32(c, d, w, true); return (unsigned)w;
}
DI void convert_experts(const Args& a, size_t tid, size_t nth) {
    const size_t n16 = (size_t)16384 * 2048 / 16;
    for (int tb = 0; tb < 2; ++tb) { const f32x4* src = (const f32x4*)a.in[22 + tb]; u32x4* dst = (u32x4*)(a.ws + (tb ? WS_EV : WS_EU)); const float sc = tb ? EV_SCALE : EU_SCALE;
        for (size_t i = tid; i < n16; i += nth) { const f32x4 x0 = __builtin_nontemporal_load(src + 4 * i), x1 = __builtin_nontemporal_load(src + 4 * i + 1), x2 = __builtin_nontemporal_load(src + 4 * i + 2), x3 = __builtin_nontemporal_load(src + 4 * i + 3);
            u32x4 w; w.x = pk4_fp8(x0, sc); w.y = pk4_fp8(x1, sc); w.z = pk4_fp8(x2, sc); w.w = pk4_fp8(x3, sc); dst[i] = w; } }
}
typedef short v4i16_t __attribute__((ext_vector_type(4)));
template <int HD> struct Stage { u32x4 rk[HD / 16], rv[HD / 16]; };
template <int HD, bool WITH_V> DI void st_load(Stage<HD>& S, const bf16* Ktile, const bf16* Vtile, int lane) {
#pragma unroll
    for (int j = 0; j < HD / 16; ++j) { S.rk[j] = *(const u32x4*)((const char*)Ktile + j * 1024 + lane * 16); if (WITH_V) S.rv[j] = *(const u32x4*)((const char*)Vtile + j * 1024 + lane * 16); }
}
template <int HD, bool WITH_V> DI void st_write(const Stage<HD>& S, LAS unsigned char* buf, int lane) {
#pragma unroll
    for (int j = 0; j < HD / 16; ++j) { const int b = j * 1024 + lane * 16, row = b / (2 * HD), ch = (b >> 4) & (HD / 8 - 1);
        *(LAS u32x4*)(buf + row * (2 * HD) + ((ch ^ (row & (HD / 8 - 1))) << 4)) = S.rk[j];
        if (WITH_V) *(LAS u32x4*)(buf + 64 * HD + b) = S.rv[j]; }
}
template <int HD> DI bf16x8 k_frag(const LAS unsigned char* buf, int ks, int lane) { const int row = lane & 31, ch = 2 * ks + (lane >> 5);
    return *(const LAS bf16x8*)(buf + row * (2 * HD) + ((ch ^ (row & (HD / 8 - 1))) << 4)); }
template <int HD> DI bf16x8 v_frag(const LAS unsigned char* buf, int dt, int s, int lane) {
    const int gl = lane & 15, q = gl >> 2, p = gl & 3, h = lane >> 5;
    const LAS unsigned char* a0 = buf + 64 * HD + (16 * s + 4 * h + q) * (2 * HD) + (dt * 32 + 16 * ((lane >> 4) & 1) + 4 * p) * 2;
    const s16x4 lo = __builtin_bit_cast(s16x4, __builtin_amdgcn_ds_read_tr16_b64_v4i16((LAS v4i16_t*)a0));
    const s16x4 hi = __builtin_bit_cast(s16x4, __builtin_amdgcn_ds_read_tr16_b64_v4i16((LAS v4i16_t*)(a0 + 8 * (2 * HD))));
    return cat4(lo, hi);
}
template <int HD> DI f32x16 qk_tile(const bf16x8 (&q)[HD / 16], const LAS unsigned char* buf, int lane) {
    f32x16 s;
#pragma unroll
    for (int r = 0; r < 16; ++r) s[r] = 0.f;
#pragma unroll
    for (int ks = 0; ks < HD / 16; ++ks) s = MFMA32(k_frag<HD>(buf, ks, lane), q[ks], s);
    return s;
}
template <int HD> DI void pv_tile(const float (&p)[16], const LAS unsigned char* buf, f32x16 (&o)[HD / 32], int lane) {
    const bf16x8 pf0 = pack8f(p), pf1 = pack8f(p + 8);
#pragma unroll
    for (int dt = 0; dt < HD / 32; ++dt) { o[dt] = MFMA32(v_frag<HD>(buf, dt, 0, lane), pf0, o[dt]); o[dt] = MFMA32(v_frag<HD>(buf, dt, 1, lane), pf1, o[dt]); }
}
template <int HD, class SF>
DI void attn_compute(const bf16x8 (&q)[HD / 16], const LAS unsigned char* buf, float& m, float& l, f32x16 (&o)[HD / 32], int lane, SF sf) {
    const f32x16 s = qk_tile<HD>(q, buf, lane);
    float v[16]; float tmax = NEGBIG;
#pragma unroll
    for (int r = 0; r < 16; ++r) { v[r] = sf(r, s[r]); tmax = fmaxf(tmax, v[r]); }
    tmax = fmaxf(tmax, __shfl_xor(tmax, 32));
    const float mn = fmaxf(m, tmax), alpha = fexp2(m - mn);
    float p[16]; float ps = 0.f;
#pragma unroll
    for (int r = 0; r < 16; ++r) { p[r] = v[r] > -1e29f ? fexp2(v[r] - mn) : 0.f; ps += p[r]; }
    ps += __shfl_xor(ps, 32);
    l = l * alpha + ps; m = mn;
#pragma unroll
    for (int dt = 0; dt < HD / 32; ++dt) o[dt] = o[dt] * alpha;
    pv_tile<HD>(p, buf, o, lane);
}
template <int HD, class KeyF, class MaskF>
DI void attn_run(const bf16x8 (&q)[HD / 16], const bf16* K, const bf16* V, LAS unsigned char* buf, int ntiles, KeyF keyf, float& m, float& l, f32x16 (&o)[HD / 32], int lane, MaskF maskf) {
    if (ntiles <= 0) return;
    Stage<HD> S; int k0 = keyf(0);
    st_load<HD, true>(S, K + (long)k0 * HD, V + (long)k0 * HD, lane);
    st_write<HD, true>(S, buf, lane);
#pragma unroll 1
    for (int i = 0; i < ntiles; ++i) {
        int k1 = k0;
        if (i + 1 < ntiles) { k1 = keyf(i + 1); st_load<HD, true>(S, K + (long)k1 * HD, V + (long)k1 * HD, lane); }
        attn_compute<HD>(q, buf, m, l, o, lane, [&](int r, float raw) { return maskf(k0, r, raw); });
        if (i + 1 < ntiles) st_write<HD, true>(S, buf, lane);
        k0 = k1;
    }
}
template <int NT>
DI void store_ot(bf16* orow, const f32x16 (&o)[NT], float scale, int h) {
#pragma unroll
    for (int dt = 0; dt < NT; ++dt)
#pragma unroll
        for (int rg = 0; rg < 4; ++rg) { u32x2 w; w.x = cvt_pk_bf16(o[dt][4 * rg] * scale, o[dt][4 * rg + 1] * scale); w.y = cvt_pk_bf16(o[dt][4 * rg + 2] * scale, o[dt][4 * rg + 3] * scale);
            *(u32x2*)(orow + 32 * dt + 8 * rg + 4 * h) = w; }
}

DI void dilated_item(unsigned char* ws, int item, int w, LAS unsigned char* buf, int lane) {
    const int g = item >> 8, rem = item & 255, hh = rem >> 6, nb = rem & 63, ld = 2 * g, dil = 1 << ld, nbk = 64 >> ld, n = nb / nbk, b = nb % nbk, L = T >> ld;
    const int i32 = lane & 31, h = lane >> 5, iq = 32 * w + i32, rowbase = n * L + 128 * b, gh = g * 4 + hh;
    const bf16* Q = (const bf16*)(ws + WS_AQ) + ((size_t)gh * T + rowbase + iq) * 128 + 8 * h;
    const bf16* K = (const bf16*)(ws + WS_AK) + ((long)gh * T + rowbase - 128) * 128;
    const bf16* V = (const bf16*)(ws + WS_AVT) + ((long)gh * T + rowbase - 128) * 128;
    bf16x8 q[8];
#pragma unroll
    for (int ks = 0; ks < 8; ++ks) q[ks] = *(const bf16x8*)(Q + 16 * ks);
    const float slope = exp2f(-8.f * (float)(gh + 1) / 12.f), sl2 = slope * (float)dil * LOG2E, sc2 = 0.08838834764831845f * LOG2E;
    f32x16 o[4];
#pragma unroll
    for (int dt = 0; dt < 4; ++dt)
#pragma unroll
        for (int r = 0; r < 16; ++r) o[dt][r] = 0.f;
    float m = NEGBIG, l = 0.f;
    { const int first = (b == 0 && 32 * w < 128) ? 128 : 32 * w, ntiles = (32 * w + 160 - first) >> 5;
      attn_run<128>(q, K, V, buf, ntiles, [&](int i) { return first + 32 * i; }, m, l, o, lane, [&](int j0, int r, float raw) {
          const int rel = iq + 128 - (j0 + crow(r, h)); return (rel >= 0 && rel <= 128) ? raw * sc2 - sl2 * (float)rel : NEGBIG; }); }
    const int t = (128 * b + iq) * dil + n;
    store_ot<4>((bf16*)(ws + WS_OA) + ((size_t)g * T + t) * 512 + hh * 128, o, 1.f / l, h);
    if (h == 0) ((float*)(ws + WS_LSE))[((size_t)g * T + t) * 4 + hh] = (m + __log2f(l)) * LN2;
}
DI void compress_block(unsigned char* ws, int item, LAS unsigned char* lds, int wave, int lane, int tid) {
    const int kv = item >> 5, G = (item >> 4) & 1, rt = item & 15, i32 = lane & 31, h = lane >> 5;
    const int c = rt * 32 + i32, cc = c < 511 ? c : 510;
    LAS float* red = (LAS float*)lds;
    const bf16* A = (const bf16*)(ws + (kv ? WS_VCS : WS_KCS)) + (size_t)G * T * 64 + (size_t)cc * 1024 + 8 * h + wave * 256;
    const bf16* W1 = (const bf16*)(ws + (kv ? WS_WCV1T : WS_WCK1T)) + (size_t)i32 * 2048 + 8 * h + wave * 256;
    f32x16 hid[4];
#pragma unroll
    for (int jt = 0; jt < 4; ++jt)
#pragma unroll
        for (int r = 0; r < 16; ++r) hid[jt][r] = 0.f;
#pragma unroll 4
    for (int ks = 0; ks < 16; ++ks) {
        const bf16x8 af = *(const bf16x8*)(A + 16 * ks);
#pragma unroll
        for (int jt = 0; jt < 4; ++jt) hid[jt] = MFMA32(*(const bf16x8*)(W1 + (size_t)jt * 32 * 2048 + 16 * ks), af, hid[jt]);
    }
#pragma unroll
    for (int jt = 0; jt < 4; ++jt)
#pragma unroll
        for (int r = 0; r < 16; ++r) red[wave * 4096 + (jt * 16 + r) * 64 + lane] = hid[jt][r];
    __syncthreads();
    if (wave < 2) {
        const int dt = wave;
        const float* peb = (const float*)(ws + (kv ? WS_PEBV : WS_PEBK));
        const bf16* W2 = (const bf16*)(ws + (kv ? WS_WCV2T : WS_WCK2T)) + (size_t)(dt * 32 + i32) * 128 + 4 * h;
        f32x16 o;
#pragma unroll
        for (int r = 0; r < 16; ++r) o[r] = 0.f;
#pragma unroll
        for (int jt = 0; jt < 4; ++jt) { float gl[16];
#pragma unroll
            for (int r = 0; r < 16; ++r) { float sacc = red[(jt * 16 + r) * 64 + lane];
#pragma unroll
                for (int w8 = 1; w8 < 8; ++w8) sacc += red[w8 * 4096 + (jt * 16 + r) * 64 + lane];
                gl[r] = gelu_tanh(sacc + peb[jt * 32 + crow(r, h)]); }
            const bf16* wp = W2 + jt * 32;
            o = MFMA32(cat4(*(const s16x4*)(wp), *(const s16x4*)(wp + 8)), pack8f(gl), o);
            o = MFMA32(cat4(*(const s16x4*)(wp + 16), *(const s16x4*)(wp + 24)), pack8f(gl + 8), o); }
        const float keep = c < 511 ? 1.f : 0.f;
        { bf16* orow = (bf16*)(ws + (kv ? WS_VCT : WS_KC)) + ((size_t)G * 512 + c) * 64 + 32 * dt;
#pragma unroll
            for (int rg = 0; rg < 4; ++rg) { u32x2 w; w.x = cvt_pk_bf16(o[4 * rg] * keep, o[4 * rg + 1] * keep); w.y = cvt_pk_bf16(o[4 * rg + 2] * keep, o[4 * rg + 3] * keep); *(u32x2*)(orow + 8 * rg + 4 * h) = w; } }
    }
    __syncthreads();
}
DI void nsa_item(unsigned char* ws, int G, int chunk, LAS float* pc  , LAS unsigned char* buf  , int lane) {
    const int i32 = lane & 31, h = lane >> 5, tok = i32 >> 3, hh = G * 8 + (i32 & 7), t0 = chunk * 4, t = t0 + tok;
    const float slope = exp2f(-0.5f * (float)(hh + 1)), sl2 = slope * LOG2E, sc2 = 0.125f * LOG2E;
    bf16x8 q[4];
    { const bf16* Q = (const bf16*)(ws + WS_BQ) + (size_t)t * 1024 + hh * 64 + 8 * h;
#pragma unroll
      for (int ks = 0; ks < 4; ++ks) q[ks] = *(const bf16x8*)(Q + 16 * ks); }
    const float* gate = (const float*)(ws + WS_BG) + (size_t)t * 48 + hh * 3;
    const float g_c = gate[0], g_s = gate[1], g_w = gate[2];
    f32x16 y[2], o[2];
#pragma unroll
    for (int dt = 0; dt < 2; ++dt)
#pragma unroll
        for (int r = 0; r < 16; ++r) { y[dt][r] = 0.f; o[dt][r] = 0.f; }
    const int cv = t >= 31 ? ((t - 31) >> 4) : -1;
    const int cmaxw = t0 + 3 >= 31 ? ((t0 + 3 - 31) >> 4) : -1;
    const int nct = cmaxw >= 0 ? (cmaxw >> 5) + 1 : 0;
    const bf16* KC = (const bf16*)(ws + WS_KC) + (size_t)G * 512 * 64;
    const bf16* VC = (const bf16*)(ws + WS_VCT) + (size_t)G * 512 * 64;
    float m = NEGBIG, l = 0.f;
    if (nct > 0) {
        Stage<64> S;
        st_load<64, false>(S, KC, VC, lane); st_write<64, false>(S, buf, lane);
#pragma unroll 1
        for (int ct = 0; ct < nct; ++ct) {
            if (ct + 1 < nct) st_load<64, false>(S, KC + (size_t)(ct + 1) * 32 * 64, VC, lane);
            const f32x16 s = qk_tile<64>(q, buf, lane);
            float v[16]; float tmax = NEGBIG;
#pragma unroll
            for (int r = 0; r < 16; ++r) { const int c = ct * 32 + crow(r, h); v[r] = c <= cv ? s[r] * sc2 - sl2 * (float)(t - 16 * c - 31) : NEGBIG; tmax = fmaxf(tmax, v[r]); }
            tmax = fmaxf(tmax, __shfl_xor(tmax, 32));
            const float mn = fmaxf(m, tmax); float ps = 0.f;
#pragma unroll
            for (int r = 0; r < 16; ++r) ps += v[r] > -1e29f ? fexp2(v[r] - mn) : 0.f;
            ps += __shfl_xor(ps, 32);
            l = l * fexp2(m - mn) + ps; m = mn;
            if (ct + 1 < nct) st_write<64, false>(S, buf, lane);
        }
        const float inv_c = l > 0.f ? 1.f / l : 0.f;
        st_load<64, true>(S, KC, VC, lane); st_write<64, true>(S, buf, lane);
#pragma unroll 1
        for (int ct = 0; ct < nct; ++ct) {
            if (ct + 1 < nct) st_load<64, true>(S, KC + (size_t)(ct + 1) * 32 * 64, VC + (size_t)(ct + 1) * 32 * 64, lane);
            const f32x16 s = qk_tile<64>(q, buf, lane);
            float p[16];
#pragma unroll
            for (int r = 0; r < 16; ++r) { const int c = ct * 32 + crow(r, h); p[r] = c <= cv ? fexp2(s[r] * sc2 - sl2 * (float)(t - 16 * c - 31) - m) * inv_c : 0.f; }
            pv_tile<64>(p, buf, o, lane);
#pragma unroll
            for (int r = 0; r < 16; ++r) { float x = p[r]; x += __shfl_xor(x, 1); x += __shfl_xor(x, 2); x += __shfl_xor(x, 4);
                if ((i32 & 7) == 0) pc[tok * 512 + ct * 32 + crow(r, h)] = x; }
            if (ct + 1 < nct) st_write<64, true>(S, buf, lane);
        }
    }
#pragma unroll
    for (int dt = 0; dt < 2; ++dt)
#pragma unroll
        for (int r = 0; r < 16; ++r) { y[dt][r] = g_c * o[dt][r]; o[dt][r] = 0.f; }
    asm volatile("s_waitcnt lgkmcnt(0)" ::: "memory");
    unsigned msk[4] = {0u, 0u, 0u, 0u};
    {   const int ts = lane >> 4, l16 = lane & 15, tsel = t0 + ts, cur = tsel >> 6;
        float cand[8];
#pragma unroll
        for (int e = 0; e < 8; ++e) { const int j = l16 * 8 + e; const bool valid = j >= 1 && j <= cur - 2; const LAS float* pp = pc + ts * 512 + 4 * j;
            const int jm = valid ? -1 : 0;
            cand[e] = valid ? (pp[0] + pp[1]) + pp[2] + 0.5f * (pp[3] + pp[jm]) : -1.f; }
        msk[0] |= 1u;
#pragma unroll
        for (int w = 0; w < 4; ++w) { if ((cur >> 5) == w) msk[w] |= 1u << (cur & 31); if (cur >= 1 && ((cur - 1) >> 5) == w) msk[w] |= 1u << ((cur - 1) & 31); }
        for (int round = 0; round < 13; ++round) {
            float bv = -3.f; int bi = 1 << 20;
#pragma unroll
            for (int e = 0; e < 8; ++e) if (cand[e] > bv) { bv = cand[e]; bi = l16 * 8 + e; }
#pragma unroll
            for (int off = 1; off < 16; off <<= 1) { const float ov = __shfl_xor(bv, off); const int oi = __shfl_xor(bi, off); if (ov > bv || (ov == bv && oi < bi)) { bv = ov; bi = oi; } }
            if (bv >= 0.f) {
#pragma unroll
                for (int w = 0; w < 4; ++w) if ((bi >> 5) == w) msk[w] |= 1u << (bi & 31);
#pragma unroll
                for (int e = 0; e < 8; ++e) if (l16 * 8 + e == bi) cand[e] = -2.f;
            }
        }
    }
    unsigned mk[4], U[4];
#pragma unroll
    for (int w = 0; w < 4; ++w) { mk[w] = __shfl(msk[w], tok * 16);
        U[w] = __builtin_amdgcn_readlane(msk[w], 0) | __builtin_amdgcn_readlane(msk[w], 16) | __builtin_amdgcn_readlane(msk[w], 32) | __builtin_amdgcn_readlane(msk[w], 48); }
    asm volatile("s_waitcnt lgkmcnt(0)" ::: "memory");
    m = NEGBIG; l = 0.f;
    {
        LAS int* tl = (LAS int*)pc;
        int base = 0;
#pragma unroll
        for (int w = 0; w < 4; ++w) { const unsigned bits = U[w]; if (lane < 32 && ((bits >> lane) & 1u)) { const int pos = base + __builtin_popcount(bits & ((1u << lane) - 1u)); tl[2 * pos] = 64 * (w * 32 + lane); tl[2 * pos + 1] = 64 * (w * 32 + lane) + 32; }
            base += __builtin_popcount(bits); }
        const int ntl = 2 * base - (((t0 + 3) & 63) < 32 ? 1 : 0);
        asm volatile("s_waitcnt lgkmcnt(0)" ::: "memory");
        attn_run<64>(q, (const bf16*)(ws + WS_KS) + (size_t)G * T * 64, (const bf16*)(ws + WS_VST) + (size_t)G * T * 64, buf, ntl, [&](int i) { return __builtin_amdgcn_readfirstlane(tl[i]); }, m, l, o, lane, [&](int key0, int r, float raw) {
            const int jb = key0 >> 6, wsel = jb >> 5; const unsigned mw = wsel == 0 ? mk[0] : wsel == 1 ? mk[1] : wsel == 2 ? mk[2] : mk[3];
            const int pos = key0 + crow(r, h); return (((mw >> (jb & 31)) & 1u) && pos <= t) ? raw * sc2 - sl2 * (float)(t - pos) : NEGBIG; });
    }
    { const float sc = l > 0.f ? g_s / l : 0.f;
#pragma unroll
      for (int dt = 0; dt < 2; ++dt)
#pragma unroll
          for (int r = 0; r < 16; ++r) { y[dt][r] += sc * o[dt][r]; o[dt][r] = 0.f; } }
    m = NEGBIG; l = 0.f;
    { const int lo = (t0 - 511 > 0 ? t0 - 511 : 0) & ~31, ntl = ((t0 + 3 - lo) >> 5) + 1;
      attn_run<64>(q, (const bf16*)(ws + WS_KW) + (size_t)G * T * 64, (const bf16*)(ws + WS_VWT) + (size_t)G * T * 64, buf, ntl, [&](int i) { return lo + 32 * i; }, m, l, o, lane, [&](int key0, int r, float raw) {
          const int dd = t - (key0 + crow(r, h)); return (dd >= 0 && dd < 512) ? raw * sc2 - sl2 * (float)dd : NEGBIG; }); }
    { const float sc = l > 0.f ? g_w / l : 0.f;
#pragma unroll
      for (int dt = 0; dt < 2; ++dt)
#pragma unroll
          for (int r = 0; r < 16; ++r) y[dt][r] += sc * o[dt][r]; }
    store_ot<2>((bf16*)(ws + WS_YB) + (size_t)t * 1024 + hh * 64, y, 1.f, h);
}
DI void dilated_combine(unsigned char* ws, size_t tid, size_t nth) {
    const float* lse = (const float*)(ws + WS_LSE); const bf16* oa = (const bf16*)(ws + WS_OA); bf16* ya = (bf16*)(ws + WS_YA);
    for (size_t i = tid; i < (size_t)T * 64; i += nth) {
        const size_t t = i >> 6; const int c8 = (int)(i & 63) * 8, hh = c8 >> 7;
        const float l0 = lse[(0 * (size_t)T + t) * 4 + hh], l1 = lse[(1 * (size_t)T + t) * 4 + hh], l2 = lse[(2 * (size_t)T + t) * 4 + hh];
        const float mx = fmaxf(l0, fmaxf(l1, l2)), e0 = __expf(l0 - mx), e1 = __expf(l1 - mx), e2 = __expf(l2 - mx), inv = 1.f / (e0 + e1 + e2);
        const u32x4 a = *(const u32x4*)(oa + (0 * (size_t)T + t) * 512 + c8), b = *(const u32x4*)(oa + (1 * (size_t)T + t) * 512 + c8), c = *(const u32x4*)(oa + (2 * (size_t)T + t) * 512 + c8);
        const float w0 = e0 * inv, w1 = e1 * inv, w2 = e2 * inv; u32x4 r;
        r.x = cvt_pk_bf16(w0 * bflo(a.x) + w1 * bflo(b.x) + w2 * bflo(c.x), w0 * bfhi(a.x) + w1 * bfhi(b.x) + w2 * bfhi(c.x));
        r.y = cvt_pk_bf16(w0 * bflo(a.y) + w1 * bflo(b.y) + w2 * bflo(c.y), w0 * bfhi(a.y) + w1 * bfhi(b.y) + w2 * bfhi(c.y));
        r.z = cvt_pk_bf16(w0 * bflo(a.z) + w1 * bflo(b.z) + w2 * bflo(c.z), w0 * bfhi(a.z) + w1 * bfhi(b.z) + w2 * bfhi(c.z));
        r.w = cvt_pk_bf16(w0 * bflo(a.w) + w1 * bflo(b.w) + w2 * bflo(c.w), w0 * bfhi(a.w) + w1 * bfhi(b.w) + w2 * bfhi(c.w));
        *(u32x4*)(ya + t * 512 + c8) = r;
    }
}
DI void cross_item(unsigned char* ws, int item, LAS unsigned char* buf, int lane) {
    const int hx = item & 3, qt = item >> 2, i32 = lane & 31, h = lane >> 5, t = qt * 32 + i32;
    const bf16* Q = (const bf16*)(ws + WS_QX) + (size_t)t * 512 + hx * 128 + 8 * h;
    bf16x8 q[8];
#pragma unroll
    for (int ks = 0; ks < 8; ++ks) q[ks] = *(const bf16x8*)(Q + 16 * ks);
    const bf16* K = (const bf16*)(ws + WS_KX) + (size_t)hx * 256 * 128;
    const bf16* V = (const bf16*)(ws + WS_VXT) + (size_t)hx * 256 * 128;
    f32x16 o[4];
#pragma unroll
    for (int dt = 0; dt < 4; ++dt)
#pragma unroll
        for (int r = 0; r < 16; ++r) o[dt][r] = 0.f;
    float m = NEGBIG, l = 0.f; const float sc2 = 0.08838834764831845f * LOG2E;
    attn_run<128>(q, K, V, buf, 8, [&](int i) { return 32 * i; }, m, l, o, lane, [&](int, int, float raw) { return raw * sc2; });
    store_ot<4>((bf16*)(ws + WS_OX) + (size_t)t * 512 + hx * 128, o, 1.f / l, h);
}
DI void peer_topk_item(unsigned char* ws, int item, LAS float* scr, int lane) {
    const int hp = item & 7, tt = item >> 3, i32 = lane & 31, h = lane >> 5, t = tt * 32 + i32;
    const bf16* Q = (const bf16*)(ws + WS_PQ) + (size_t)t * 2048 + hp * 256 + 8 * h;
    LAS float* my = scr + i32 * 64;
#pragma unroll 1
    for (int z = 0; z < 2; ++z) {
        bf16x8 q[8];
#pragma unroll
        for (int ks = 0; ks < 8; ++ks) q[ks] = *(const bf16x8*)(Q + z * 128 + 16 * ks);
        const bf16* SK = (const bf16*)(ws + (z ? WS_SK2 : WS_SK1)) + (size_t)i32 * 128 + 8 * h;
        f32x16 s[4];
#pragma unroll
        for (int kt = 0; kt < 4; ++kt) {
#pragma unroll
            for (int r = 0; r < 16; ++r) s[kt][r] = 0.f;
#pragma unroll
            for (int ks = 0; ks < 8; ++ks) s[kt] = MFMA32(*(const bf16x8*)(SK + (size_t)kt * 32 * 128 + 16 * ks), q[ks], s[kt]);
        }
#pragma unroll 1
        for (int round = 0; round < 16; ++round) {
            float bv = -3.0e38f; int bi = 1 << 20;
#pragma unroll
            for (int kt = 0; kt < 4; ++kt)
#pragma unroll
                for (int r = 0; r < 16; ++r) if (s[kt][r] > bv) { bv = s[kt][r]; bi = kt * 32 + crow(r, h); }
            { const float ov = __shfl_xor(bv, 32); const int oi = __shfl_xor(bi, 32); if (ov > bv || (ov == bv && oi < bi)) { bv = ov; bi = oi; } }
#pragma unroll
            for (int kt = 0; kt < 4; ++kt)
#pragma unroll
                for (int r = 0; r < 16; ++r) if (kt * 32 + crow(r, h) == bi) s[kt][r] = -3.0e38f;
            if (h == 0) { my[(z * 16 + round) * 2] = bv; my[(z * 16 + round) * 2 + 1] = __int_as_float(bi); }
        }
    }
    asm volatile("s_waitcnt lgkmcnt(0)" ::: "memory");
    float v1[16], v2[16];
#pragma unroll
    for (int k = 0; k < 16; ++k) { v1[k] = my[k * 2]; v2[k] = my[(16 + k) * 2]; }
    float cand[50]; int n = 0;
#pragma unroll
    for (int a = 0; a < 16; ++a)
#pragma unroll
        for (int b = 0; b < 16 / (a + 1); ++b) cand[n++] = v1[a] + v2[b];
    int* eid = (int*)(ws + WS_EID) + (size_t)t * 128 + hp * 16; float* gw = (float*)(ws + WS_GW) + (size_t)t * 128 + hp * 16;
    float vmax = 0.f, esum = 0.f;
#pragma unroll 1
    for (int round = 0; round < 16; ++round) {
        float bv = -3.0e38f; int bc = 0; n = 0;
#pragma unroll
        for (int a = 0; a < 16; ++a)
#pragma unroll
            for (int b = 0; b < 16 / (a + 1); ++b) { if (cand[n] > bv) { bv = cand[n]; bc = a * 16 + b; } ++n; }
        n = 0;
#pragma unroll
        for (int a = 0; a < 16; ++a)
#pragma unroll
            for (int b = 0; b < 16 / (a + 1); ++b) { if (a * 16 + b == bc) cand[n] = -3.0e38f; ++n; }
        if (round == 0) vmax = bv;
        const float e = __expf(bv - vmax); esum += e;
        const int e1 = __float_as_int(my[(bc >> 4) * 2 + 1]), e2 = __float_as_int(my[(16 + (bc & 15)) * 2 + 1]);
        if (h == 0) { eid[round] = e1 * 128 + e2; gw[round] = e; }
    }
    if (h == 0) ((float*)(ws + WS_GINV))[(size_t)t * 8 + hp] = 1.f / esum;
}
DI void peer_load(u32x4 (&R)[4][2], const unsigned char* E, int eA, int eB, int b) {
#pragma unroll
    for (int k = 0; k < 4; ++k) { const int p = 4 * b + k; const int e = b < 16 ? __builtin_amdgcn_readlane(eA, p & 63) : __builtin_amdgcn_readlane(eB, p & 63);
        const unsigned char* rp = E + (size_t)e * DM; R[k][0] = *(const u32x4*)(rp); R[k][1] = *(const u32x4*)(rp + 1024); }
}
DI float peer_dots(const u32x4 (&U)[4][2], const f32x2 (&xs)[16], int lane) {
    float d[4];
#pragma unroll
    for (int k = 0; k < 4; ++k) { f32x2 acc = {0.f, 0.f};
#pragma unroll
        for (int c = 0; c < 2; ++c)
#pragma unroll
            for (int wd = 0; wd < 4; ++wd) { const int w = (int)U[k][c][wd];
                acc = __builtin_elementwise_fma(__builtin_amdgcn_cvt_pk_f32_fp8(w, false), xs[c * 8 + wd * 2], acc);
                acc = __builtin_elementwise_fma(__builtin_amdgcn_cvt_pk_f32_fp8(w, true), xs[c * 8 + wd * 2 + 1], acc); }
        d[k] = acc.x + acc.y; }
    const bool hi32 = lane & 32, hi16 = lane & 16;
    float k0 = hi32 ? d[2] : d[0], k1 = hi32 ? d[3] : d[1];
    k0 += __shfl_xor(hi32 ? d[0] : d[2], 32); k1 += __shfl_xor(hi32 ? d[1] : d[3], 32);
    float kk = hi16 ? k1 : k0; kk += __shfl_xor(hi16 ? k0 : k1, 16);
    kk += __shfl_xor(kk, 8); kk += __shfl_xor(kk, 4); kk += __shfl_xor(kk, 2); kk += __shfl_xor(kk, 1);
    return kk;
}
DI void peer_axpy(const u32x4 (&V)[4][2], float kk, f32x2 (&y)[16], int gA, int gB, int b, float arg_scale) {
#pragma unroll
    for (int k = 0; k < 4; ++k) { const int p = 4 * b + k;
        const float dot = __int_as_float(__builtin_amdgcn_readlane(__float_as_int(kk), 16 * k));
        const float g = __int_as_float(b < 16 ? __builtin_amdgcn_readlane(gA, p & 63) : __builtin_amdgcn_readlane(gB, p & 63));
        const float coef = g * gelu_tanh(dot * arg_scale); const f32x2 cf = {coef, coef};
#pragma unroll
        for (int c = 0; c < 2; ++c)
#pragma unroll
            for (int wd = 0; wd < 4; ++wd) { const int w = (int)V[k][c][wd];
                y[c * 8 + wd * 2] = __builtin_elementwise_fma(__builtin_amdgcn_cvt_pk_f32_fp8(w, false), cf, y[c * 8 + wd * 2]);
                y[c * 8 + wd * 2 + 1] = __builtin_elementwise_fma(__builtin_amdgcn_cvt_pk_f32_fp8(w, true), cf, y[c * 8 + wd * 2 + 1]); } }
}
DI void peer_gather_token(const Args& a, int t, int lane, float* outp) {
    unsigned char* ws = a.ws;
    const bf16* xg = (const bf16*)(ws + WS_H2G) + (size_t)t * DM + lane * 16;
    f32x2 xs[16];
#pragma unroll
    for (int c = 0; c < 2; ++c)
#pragma unroll
        for (int q = 0; q < 2; ++q) { const u32x4 w = *(const u32x4*)(xg + c * 1024 + q * 8);
            xs[c * 8 + q * 4 + 0] = (f32x2){bflo(w.x), bfhi(w.x)}; xs[c * 8 + q * 4 + 1] = (f32x2){bflo(w.y), bfhi(w.y)}; xs[c * 8 + q * 4 + 2] = (f32x2){bflo(w.z), bfhi(w.z)}; xs[c * 8 + q * 4 + 3] = (f32x2){bflo(w.w), bfhi(w.w)}; }
    const float rs2 = row_rs((const float*)(ws + WS_SSQ2) + (size_t)t * 32);
    const int* eidp = (const int*)(ws + WS_EID) + (size_t)t * 128; const float* gwp = (const float*)(ws + WS_GW) + (size_t)t * 128; const float* ginv = (const float*)(ws + WS_GINV) + (size_t)t * 8;
    const int eA = eidp[lane], eB = eidp[64 + lane];
    const int gA = __float_as_int(gwp[lane] * ginv[lane >> 4] * (1.f / EV_SCALE)), gB = __float_as_int(gwp[64 + lane] * ginv[4 + (lane >> 4)] * (1.f / EV_SCALE));
    f32x2 y[16];
#pragma unroll
    for (int i = 0; i < 16; ++i) y[i] = (f32x2){0.f, 0.f};
    const unsigned char* EU = ws + WS_EU + lane * 16; const unsigned char* EV = ws + WS_EV + lane * 16;
    const float arg_scale = rs2 * (1.f / EU_SCALE);
    u32x4 U0[4][2], V0[4][2], U1[4][2], V1[4][2];
    peer_load(U0, EU, eA, eB, 0); peer_load(V0, EV, eA, eB, 0);
#pragma unroll 1
    for (int b = 0; b < 32; b += 2) {
        peer_load(U1, EU, eA, eB, b + 1);
        const float ka = peer_dots(U0, xs, lane);
        asm volatile("" ::: "memory");
        peer_load(V1, EV, eA, eB, b + 1);
        peer_axpy(V0, ka, y, gA, gB, b, arg_scale);
        asm volatile("" ::: "memory");
        if (b + 2 < 32) peer_load(U0, EU, eA, eB, b + 2);
        const float kb = peer_dots(U1, xs, lane);
        asm volatile("" ::: "memory");
        if (b + 2 < 32) peer_load(V0, EV, eA, eB, b + 2);
        peer_axpy(V1, kb, y, gA, gB, b + 1, arg_scale);
        asm volatile("" ::: "memory");
    }
    const float* hrow = a.out + (size_t)t * DM + lane * 16; float* orow = outp + (size_t)t * DM + lane * 16; const float* gf = a.in[24] + lane * 16; float ss = 0.f;
#pragma unroll
    for (int c = 0; c < 2; ++c)
#pragma unroll
        for (int q = 0; q < 4; ++q) { const f32x4 hv = *(const f32x4*)(hrow + c * 1024 + q * 4);
            f32x2& y0 = y[c * 8 + q * 2]; f32x2& y1 = y[c * 8 + q * 2 + 1];
            y0.x += hv[0]; y0.y += hv[1]; y1.x += hv[2]; y1.y += hv[3]; ss += (y0.x * y0.x + y0.y * y0.y) + (y1.x * y1.x + y1.y * y1.y); }
    const float rs = __builtin_amdgcn_rsqf(wave_sum(ss) * (1.f / DM) + EPS);
#pragma unroll
    for (int c = 0; c < 2; ++c)
#pragma unroll
        for (int q = 0; q < 4; ++q) { const f32x4 gv = *(const f32x4*)(gf + c * 1024 + q * 4); const f32x2 y0 = y[c * 8 + q * 2], y1 = y[c * 8 + q * 2 + 1];
            *(f32x4*)(orow + c * 1024 + q * 4) = (f32x4){y0.x * rs * gv[0], y0.y * rs * gv[1], y1.x * rs * gv[2], y1.y * rs * gv[3]}; }
}
#define XB_TMO      128
#define XB_XCNT(j)  (256  + 64 * (j))
#define XB_XSUB(j)  (1280 + 64 * (j))
#define XB_XGEN(j)  (2304 + 64 * (j))
#define XB_TOP      3328
#define XB_TOPGEN   3392
#define XCD_BAR_WORDS 3456
#define XB_SPIN_CAP (1u << 18)

__device__ __forceinline__ unsigned xb_ld(unsigned* p)              { return __hip_atomic_load(p, __ATOMIC_RELAXED, __HIP_MEMORY_SCOPE_AGENT); }
__device__ __forceinline__ unsigned xb_add(unsigned* p, unsigned v) { return __hip_atomic_fetch_add(p, v, __ATOMIC_RELAXED, __HIP_MEMORY_SCOPE_AGENT); }
__device__ __forceinline__ unsigned xb_xcc_id() { return (unsigned)__builtin_amdgcn_s_getreg((3 << 11) | 20) & 0xFu; }
#define XB_SPIN(cond, bar) do { unsigned _sp = 0; while (cond) { __builtin_amdgcn_s_sleep(1); \
    if ((++_sp & 255u) == 0u) { if (xb_ld(&(bar)[XB_TMO])) break; if (_sp > XB_SPIN_CAP) { atomicAdd(&(bar)[XB_TMO], 1u); break; } } } } while (0)

struct XcdBarrier {
    unsigned* bar; unsigned x;
    volatile LAS unsigned* st;
};

__device__ __forceinline__ XcdBarrier xcd_barrier_post(unsigned* bar, volatile LAS unsigned* st) {
    XcdBarrier b; b.bar = bar; b.x = xb_xcc_id(); b.st = st;
    if (threadIdx.x == 0) (void)xb_add(&bar[XB_XCNT(b.x)], 1u);
    return b;
}
__device__ __forceinline__ void xcd_barrier_complete(unsigned* bar, unsigned x, unsigned& nloc, unsigned& nx) {
    const unsigned G = gridDim.x * gridDim.y * gridDim.z;
    unsigned sum, cnt, mine, sp = 0u;
    for (;;) {
        sum = 0u; cnt = 0u; mine = 0u;
#pragma unroll
        for (unsigned j = 0; j < 16; ++j) { const unsigned c = xb_ld(&bar[XB_XCNT(j)]); sum += c; cnt += (c > 0u) ? 1u : 0u; mine = (j == x) ? c : mine; }
        if (sum == G) break;
        __builtin_amdgcn_s_sleep(1);
        if ((++sp & 255u) == 0u) { if (xb_ld(&bar[XB_TMO])) break; if (sp > XB_SPIN_CAP) { atomicAdd(&bar[XB_TMO], 1u); break; } }
    }
    nloc = mine > 0u ? mine : 1u; nx = cnt > 0u ? cnt : 1u;
}

__device__ __forceinline__ void xcd_barrier(const XcdBarrier& b) {
    asm volatile("s_waitcnt vmcnt(0)" ::: "memory");
    __syncthreads();
    if (threadIdx.x == 0) {
        unsigned* bar = b.bar;
        __builtin_amdgcn_s_waitcnt(0);
        unsigned nloc = b.st[0], nx = b.st[1];
        if (nloc == 0u) { xcd_barrier_complete(bar, b.x, nloc, nx); b.st[0] = nloc; b.st[1] = nx; }
        const unsigned old = xb_add(&bar[XB_XSUB(b.x)], 1u);
        const unsigned gen = old / nloc;
        if (old + 1u == (gen + 1u) * nloc) {
            __builtin_amdgcn_fence(__ATOMIC_RELEASE, "agent");
            asm volatile("s_waitcnt vmcnt(0)" ::: "memory");
            const unsigned og = xb_add(&bar[XB_TOP], 1u);
            const unsigned tg = og / nx;
            if (og + 1u == (tg + 1u) * nx) xb_add(&bar[XB_TOPGEN], 1u);
            else XB_SPIN(xb_ld(&bar[XB_TOPGEN]) == tg, bar);
            __builtin_amdgcn_fence(__ATOMIC_ACQUIRE, "agent");
            xb_add(&bar[XB_XGEN(b.x)], 1u);
            asm volatile("s_waitcnt vmcnt(0)" ::: "memory");
        } else {
            XB_SPIN(xb_ld(&bar[XB_XGEN(b.x)]) == gen, bar);
            __builtin_amdgcn_fence(__ATOMIC_ACQUIRE, "agent");
            asm volatile("s_waitcnt vmcnt(0)" ::: "memory");
        }
    }
    __syncthreads();
}

constexpr int NPHASES = 12;
__global__ void __launch_bounds__(NWAVES * 64, 2) fwd_kernel(Args a) {
    extern __shared__ __attribute__((aligned(16))) unsigned char lds_raw[];
    LAS unsigned char* lds = (LAS unsigned char*)lds_raw;
    const int tid = threadIdx.x, lane = tid & 63, wave = __builtin_amdgcn_readfirstlane(tid >> 6);
    const int G = gridDim.x, bx = blockIdx.x, gw = bx * NWAVES + wave, NGW = G * NWAVES;
    unsigned char* ws = a.ws;
    const int lo = a.ph_lo, hi = a.ph_hi;
    for (int u = tid; u < (LDS_BYTES - LDSCTL_OFF) / 4; u += NWAVES * 64) ((LAS unsigned*)(lds + LDSCTL_OFF))[u] = 0u;
    __syncthreads();
    XcdBarrier bar; bar.bar = (unsigned*)(ws + WS_BAR); bar.x = 0; bar.st = nullptr;
    if (hi - lo > 1) bar = xcd_barrier_post((unsigned*)(ws + WS_BAR), (volatile LAS unsigned*)(lds + LDSCTL_OFF + 64));
#ifndef PHM
#define PHM 0xfff
#endif
#define IN(k) (((PHM >> (k)) & 1) && lo <= (k) && (k) < hi)
#ifndef REPM
#define REPM 0
#endif
#define NREP(k) (1 + ((REPM >> (k)) & 1))
#define SEAM(k) do { if (IN(k) && IN((k) + 1)) { if ((k) == 0) cg::this_grid().sync(); else xcd_barrier(bar); } } while (0)
#define GEMM_PHASE(EPI, gm, S, E) pg8::gemm_phase<EPI, pg8::StaticOrder, true, true>(lds, gm, S, E)

    if (IN(0)) for (int rep = 0; rep < NREP(0); ++rep) phase_prologue(a, lds, gw, NGW, wave, lane);
    SEAM(0);
    if (IN(1)) for (int rep = 0; rep < NREP(1); ++rep) {
        { pg8::Gemm gm{(const bf16*)(ws + WS_N), (const bf16*)(ws + WS_WIN), T, NINP, 2048}; pg8::StaticOrder S; S.init(T, NINP, G, bx); EpiProj E{ws}; GEMM_PHASE(EpiProj, gm, S, E); }
        { pg8::Gemm gm{(const bf16*)(ws + WS_MN), (const bf16*)(ws + WS_WXKV), 256, 1024, 2048}; pg8::StaticOrder S; S.init(256, 1024, G, G - 1 - bx); EpiKvx E{ws}; GEMM_PHASE(EpiKvx, gm, S, E); }
    }
    SEAM(1);
    if (IN(2)) for (int rep = 0; rep < NREP(2); ++rep) {
        for (int it = bx; it < 64; it += G) compress_block(ws, it, lds, wave, lane, tid);
        for (int wi = NGW - 1 - gw; wi < 3072; wi += NGW) dilated_item(ws, wi >> 2, wi & 3, lds + wave * 16384, lane);
    }
    SEAM(2);
    if (IN(3)) for (int rep = 0; rep < NREP(3); ++rep) {
        LAS float* pc = (LAS float*)(lds + wave * 16384); LAS unsigned char* buf = lds + wave * 16384 + 8192;
        for (int it = gw; it < 4096; it += NGW) { const int Gk = it >> 11, idx = it & 2047; nsa_item(ws, Gk, Gk ? 2047 - idx : idx, pc, buf, lane); }
        dilated_combine(ws, (size_t)gw * 64 + lane, (size_t)NGW * 64);
    }
    SEAM(3);
    if (IN(4)) for (int rep = 0; rep < NREP(4); ++rep) {
        { pg8::Gemm gm{(const bf16*)(ws + WS_YA), (const bf16*)(ws + WS_WUPA), T, 2048, 512}; pg8::StaticOrder S; S.init(T, 2048, G, bx); EpiMix<0> E{ws}; GEMM_PHASE(EpiMix<0>, gm, S, E); }
        { pg8::Gemm gm{(const bf16*)(ws + WS_YB), (const bf16*)(ws + WS_WUPB), T, 2048, 1024}; pg8::StaticOrder S; S.init(T, 2048, G, bx); EpiMix<1> E{ws}; GEMM_PHASE(EpiMix<1>, gm, S, E); }
    }
    SEAM(4);
    if (IN(5)) {
        pg8::Gemm gm{(const bf16*)(ws + WS_MIX), (const bf16*)(ws + WS_WOUT), T, 2048, 2048}; pg8::StaticOrder S; S.init(T, 2048, G, bx);
        EpiRes E{a.in[0], a.out, (bf16*)(ws + WS_H1G), a.in[13], (float*)(ws + WS_SSQ1)}; GEMM_PHASE(EpiRes, gm, S, E);
    }
    SEAM(5);
    if (IN(6)) for (int rep = 0; rep < NREP(6); ++rep) {
        pg8::Gemm gm{(const bf16*)(ws + WS_H1G), (const bf16*)(ws + WS_WXQ), T, 512, 2048}; pg8::StaticOrder S; S.init(T, 512, G, bx);
        EpiScaleRow E{(bf16*)(ws + WS_QX), 512, (const float*)(ws + WS_SSQ1)}; GEMM_PHASE(EpiScaleRow, gm, S, E);
        if (G > 64 && bx >= 64) convert_experts(a, (size_t)(bx - 64) * (NWAVES * 64) + tid, (size_t)(G - 64) * (NWAVES * 64));
        else if (G <= 64) convert_experts(a, (size_t)bx * (NWAVES * 64) + tid, (size_t)G * (NWAVES * 64));
    }
    SEAM(6);
    if (IN(7)) for (int rep = 0; rep < NREP(7); ++rep) { for (int it = gw; it < 1024; it += NGW) cross_item(ws, it, lds + wave * 16384, lane); }
    SEAM(7);
    if (IN(8)) {
        pg8::Gemm gm{(const bf16*)(ws + WS_OX), (const bf16*)(ws + WS_WXO), T, 2048, 512}; pg8::StaticOrder S; S.init(T, 2048, G, bx);
        EpiRes E{a.out, a.out, (bf16*)(ws + WS_H2G), a.in[18], (float*)(ws + WS_SSQ2)}; GEMM_PHASE(EpiRes, gm, S, E);
    }
    SEAM(8);
    if (IN(9)) for (int rep = 0; rep < NREP(9); ++rep) {
        pg8::Gemm gm{(const bf16*)(ws + WS_H2G), (const bf16*)(ws + WS_WPQ), T, 2048, 2048}; pg8::StaticOrder S; S.init(T, 2048, G, bx);
        EpiScaleRow E{(bf16*)(ws + WS_PQ), 2048, (const float*)(ws + WS_SSQ2)}; GEMM_PHASE(EpiScaleRow, gm, S, E);
    }
    SEAM(9);
    if (IN(10)) for (int rep = 0; rep < NREP(10); ++rep) { LAS float* scr = (LAS float*)(lds + wave * 8192); for (int it = gw; it < 2048; it += NGW) peer_topk_item(ws, it, scr, lane); }
    SEAM(10);
    if (IN(11)) {
        if (NREP(11) > 1) for (int t = gw; t < T; t += NGW) peer_gather_token(a, t, lane, (float*)(ws + WS_OA));
        for (int t = gw; t < T; t += NGW) peer_gather_token(a, t, lane, a.out);
    }
#undef IN
#undef SEAM
#undef GEMM_PHASE
}

extern "C" void kernel_launch(void* const* d_in, const int* in_sizes, int n_in, void* d_out, int out_size, void* d_ws, size_t ws_size, hipStream_t stream) {
    static int grid = 0;
    if (grid == 0) {
        if (n_in != 25 || out_size != T * DM || ws_size < WS_END) { fprintf(stderr, "kernel_launch: unexpected problem (n_in %d, out %d, ws %zu < %zu)\n", n_in, out_size, ws_size, (size_t)WS_END); grid = -1; return; }
        int dev = 0, cus = 0, per_cu = 0;
        if (hipGetDevice(&dev) != hipSuccess || hipDeviceGetAttribute(&cus, hipDeviceAttributeMultiprocessorCount, dev) != hipSuccess) { grid = -1; return; }
        if (hipFuncSetAttribute((const void*)fwd_kernel, hipFuncAttributeMaxDynamicSharedMemorySize, LDS_BYTES) != hipSuccess) { fprintf(stderr, "kernel_launch: hipFuncSetAttribute failed\n"); grid = -1; return; }
        if (hipOccupancyMaxActiveBlocksPerMultiprocessor(&per_cu, (const void*)fwd_kernel, NWAVES * 64, LDS_BYTES) != hipSuccess || per_cu < 1) { fprintf(stderr, "kernel_launch: occupancy query says %d\n", per_cu); per_cu = 1; }
        (void)hipGetLastError();
        grid = cus;
    }
    if (grid < 0) return;
    (void)hipMemsetAsync((char*)d_ws, 0, CTL_ZERO_BYTES, stream);
    Args a{};
    for (int i = 0; i < 25; ++i) a.in[i] = (const float*)d_in[i];
    a.out = (float*)d_out; a.ws = (unsigned char*)d_ws;
#if ONE_LAUNCH
    a.ph_lo = 0; a.ph_hi = NPHASES;
    void* kargs[] = {&a};
    hipError_t e = hipLaunchCooperativeKernel((const void*)fwd_kernel, dim3(grid), dim3(NWAVES * 64), kargs, LDS_BYTES, stream);
    if (e != hipSuccess) fprintf(stderr, "kernel_launch: cooperative launch failed: %s (grid %d)\n", hipGetErrorString(e), grid);
#else
    for (int ph = 0; ph < NPHASES; ++ph) { a.ph_lo = ph; a.ph_hi = ph + 1; hipLaunchKernelGGL(fwd_kernel, dim3(grid), dim3(NWAVES * 64), LDS_BYTES, stream, a); }
#endif
}
```

```cpp
#include <hip/hip_runtime.h>
#include <hip/hip_cooperative_groups.h>
#include <cstdio>
#include <cstdint>
namespace cg = cooperative_groups;

#ifndef ONE_LAUNCH
#define ONE_LAUNCH 1
#endif

namespace pg8 {
#define PG8_LAS __attribute__((address_space(3)))
typedef unsigned short bf16_t;
typedef short bf16x8 __attribute__((ext_vector_type(8)));
typedef float f32x4 __attribute__((ext_vector_type(4)));
typedef unsigned u32x4 __attribute__((ext_vector_type(4)));
constexpr int BM = 256, BK = 64, HALF = 128, HTB = HALF * BK * 2  , STAGE_BYTES = 8 * HTB, NXCD = 8, WGM = 8;

__host__ __device__ __forceinline__ int lds_byte(int r, int c) { const int st = (r >> 4) * 2 + (c >> 5), rr = r & 15, cc = c & 31, ob = rr * 64 + cc * 2; return st * 1024 + (ob ^ (((ob >> 9) & 1) << 5)); }
__host__ __device__ __forceinline__ void stage_rc(int b, int& R, int& C) { const int st = b / 1024, sb = b % 1024, swz = sb ^ (((sb >> 9) & 1) << 5); R = (st >> 1) * 16 + swz / 64; C = (st & 1) * 32 + (swz % 64) / 2; }
__host__ __device__ __forceinline__ int perm32(int rho) { const int n = rho >> 4, i = rho & 15; return 8 * (i >> 2) + 4 * n + (i & 3); }

struct Unit { int pm, pn; };
struct Gemm { const bf16_t* A; const bf16_t* Bt; int M, N, K; };

struct StaticOrder {
    int nM, nN, nwg, G, c;
    __host__ __device__ void init(int M, int N, int G_, int c_) { nM = M / BM; nN = N / BM; nwg = nM * nN; G = G_; c = c_; }
    __host__ __device__ bool next(int i, Unit& u) const {
        const long L = (long)i * G + c; if (L >= nwg) return false;
        int wgid = (int)L; { const int q = nwg / NXCD, r = nwg % NXCD, xcd = wgid % NXCD, off = wgid / NXCD; wgid = (xcd < r ? xcd * (q + 1) : r * (q + 1) + (xcd - r) * q) + off; }
        const int nig = WGM * nN, gid = wgid / nig, fm = gid * WGM, gsz = (nM - fm) < WGM ? (nM - fm) : WGM;
        u.pm = fm + ((wgid % nig) % gsz); u.pn = (wgid % nig) / gsz; return true;
    }
    __device__ __forceinline__ void a_ready(const Unit&) const {}
    __device__ __forceinline__ void done(const Unit&) const {}
};

__device__ __forceinline__ unsigned cvt_pk_bf16(float lo, float hi) { typedef float f2_t __attribute__((ext_vector_type(2))); typedef __bf16 b2_t __attribute__((ext_vector_type(2)));
    f2_t v = {lo, hi}; b2_t b = __builtin_convertvector(v, b2_t); return __builtin_bit_cast(unsigned, b); }
template <class Epi, class Sched, bool ALIGN_EPI = false, bool SP2 = false>
__device__ __forceinline__ void gemm_phase(PG8_LAS unsigned char* lds, const Gemm g, const Sched& S, const Epi& E) {
    const int tid = threadIdx.x, wid = __builtin_amdgcn_readfirstlane(tid >> 6), lane = tid & 63, wr = wid >> 2, wc = wid & 3, fr = lane & 15, fq = lane >> 4;
    const int K = g.K, nt = K / BK;
    unsigned voffA[2], voffB[2];
#pragma unroll
    for (int i = 0; i < 2; ++i) { int R, C; stage_rc(tid * 16 + i * 8192, R, C); const int Rb = Epi::PERM ? ((R & ~31) + perm32(R & 31)) : R;
        voffA[i] = (unsigned)(R * K + C) * 2u; voffB[i] = (unsigned)(Rb * K + C) * 2u; }
    const size_t kstep = (size_t)(BK * 2);
    const size_t hstep = (size_t)HALF * K * 2;
    const size_t tstep = 2 * hstep;
    const unsigned ldsw = (unsigned)wid * 1024u;
    const int aoff = lds_byte(wr * 64 + fr, fq * 8), boff = lds_byte(wc * 32 + fr, fq * 8);
#define PG8_SA(b, h) (((b) * 2 + (h)) * HTB)
#define PG8_SB(b, h) ((4 + (b) * 2 + (h)) * HTB)
#define PG8_STAGE(bufoff, gbase, voff) do { _Pragma("unroll") for (int _i = 0; _i < 2; ++_i) \
        __builtin_amdgcn_global_load_lds((const unsigned*)((const char*)(gbase) + (voff)[_i]), (PG8_LAS unsigned*)(lds + (bufoff) + ldsw + _i * 8192), 16, 0, 0); } while (0)
#define PG8_LDA(dst, b, h) do { _Pragma("unroll") for (int m = 0; m < 4; ++m) _Pragma("unroll") for (int k = 0; k < 2; ++k) dst[m][k] = *(const PG8_LAS bf16x8*)(lds + PG8_SA(b, h) + aoff + m * 2048 + k * 1024); } while (0)
#define PG8_LDB(dst, b, h) do { _Pragma("unroll") for (int n = 0; n < 2; ++n) _Pragma("unroll") for (int k = 0; k < 2; ++k) dst[n][k] = *(const PG8_LAS bf16x8*)(lds + PG8_SB(b, h) + boff + n * 2048 + k * 1024); } while (0)
#define PG8_MMA(ai, bj, At, Bt) do { __builtin_amdgcn_s_setprio(1); _Pragma("unroll") for (int m = 0; m < 4; ++m) _Pragma("unroll") for (int n = 0; n < 2; ++n) _Pragma("unroll") for (int k = 0; k < 2; ++k) \
        acc[ai][bj][m][n] = __builtin_amdgcn_mfma_f32_16x16x32_bf16(Bt[n][k], At[m][k], acc[ai][bj][m][n], 0, 0, 0); __builtin_amdgcn_s_setprio(0); } while (0)
#define PG8_WAIT_V(n) asm volatile("s_waitcnt vmcnt(" #n ")" ::: "memory")
#define PG8_WAIT_L(n) asm volatile("s_waitcnt lgkmcnt(" #n ")" ::: "memory")
#define PG8_BAR __builtin_amdgcn_s_barrier()
#define PG8_SCHED __builtin_amdgcn_sched_barrier(0)
    Unit cur, nxt; int ui = 0;
    if (!S.next(0, cur)) return;
    f32x4 acc[2][2][4][2];
#pragma unroll
    for (int a = 0; a < 2; ++a)
#pragma unroll
        for (int b = 0; b < 2; ++b)
#pragma unroll
            for (int m = 0; m < 4; ++m)
#pragma unroll
                for (int n = 0; n < 2; ++n) acc[a][b][m][n] = (f32x4){0.f, 0.f, 0.f, 0.f};
    bf16x8 At[4][2], B0[2][2], B1[2][2];
    const char* cA = (const char*)g.A + (size_t)cur.pm * tstep; const char* cB = (const char*)g.Bt + (size_t)cur.pn * tstep;
    S.a_ready(cur);
    if constexpr (SP2) {
        PG8_STAGE(PG8_SB(0, 0), cB, voffB); PG8_STAGE(PG8_SB(0, 1), cB + hstep, voffB); PG8_STAGE(PG8_SA(0, 0), cA, voffA); PG8_STAGE(PG8_SA(0, 1), cA + hstep, voffA);
        if (wr == 1) PG8_BAR;
        PG8_WAIT_V(2); PG8_BAR;
        PG8_STAGE(PG8_SB(1, 0), cB + kstep, voffB); PG8_STAGE(PG8_SA(1, 0), cA + kstep, voffA); PG8_STAGE(PG8_SB(1, 1), cB + hstep + kstep, voffB);
        PG8_WAIT_V(6); PG8_BAR;
    } else {
        PG8_STAGE(PG8_SB(0, 0), cB, voffB); PG8_STAGE(PG8_SA(0, 0), cA, voffA); PG8_STAGE(PG8_SB(0, 1), cB + hstep, voffB); PG8_STAGE(PG8_SA(0, 1), cA + hstep, voffA);
        if (wr == 1) PG8_BAR;
        PG8_WAIT_V(4); PG8_BAR;
        PG8_STAGE(PG8_SB(1, 0), cB + kstep, voffB); PG8_STAGE(PG8_SA(1, 0), cA + kstep, voffA); PG8_STAGE(PG8_SB(1, 1), cB + hstep + kstep, voffB);
        PG8_WAIT_V(6); PG8_BAR;
    }
    for (;;) {
        const bool has_next = S.next(ui + 1, nxt);
        const char* nA = has_next ? (const char*)g.A + (size_t)nxt.pm * tstep : cA; const char* nB = has_next ? (const char*)g.Bt + (size_t)nxt.pn * tstep : cB;
        for (int t = 0; t < nt; t += 2) {
            const bool last = (t == nt - 2);
            const char* a1 = cA + (size_t)(t + 1) * kstep;
            const char* a2 = last ? nA : cA + (size_t)(t + 2) * kstep; const char* b2 = last ? nB : cB + (size_t)(t + 2) * kstep;
            const char* a3 = a2 + kstep; const char* b3 = b2 + kstep;
            if (last && has_next) S.a_ready(nxt);
            if constexpr (SP2) {
            PG8_LDB(B0, 0, 0); PG8_LDB(B1, 0, 1); PG8_SCHED; PG8_LDA(At, 0, 0); PG8_STAGE(PG8_SA(1, 1), a1 + hstep, voffA);
            PG8_WAIT_V(8); PG8_WAIT_L(0); PG8_BAR; PG8_MMA(0, 0, At, B0); PG8_MMA(0, 1, At, B1); PG8_BAR; PG8_SCHED;
            PG8_LDA(At, 0, 1); PG8_STAGE(PG8_SB(0, 0), b2, voffB); PG8_STAGE(PG8_SB(0, 1), b2 + hstep, voffB); PG8_STAGE(PG8_SA(0, 0), a2, voffA);
            PG8_WAIT_V(8); PG8_WAIT_L(0); PG8_BAR; PG8_MMA(1, 0, At, B0); PG8_MMA(1, 1, At, B1); PG8_BAR; PG8_SCHED;
            PG8_LDB(B0, 1, 0); PG8_LDB(B1, 1, 1); PG8_SCHED; PG8_LDA(At, 1, 0); PG8_STAGE(PG8_SA(0, 1), a2 + hstep, voffA);
            PG8_WAIT_V(8); PG8_WAIT_L(0); PG8_BAR; PG8_MMA(0, 0, At, B0); PG8_MMA(0, 1, At, B1); PG8_BAR; PG8_SCHED;
            PG8_LDA(At, 1, 1); PG8_STAGE(PG8_SB(1, 0), b3, voffB); PG8_STAGE(PG8_SB(1, 1), b3 + hstep, voffB); PG8_STAGE(PG8_SA(1, 0), a3, voffA);
            PG8_WAIT_V(8); PG8_WAIT_L(0); PG8_BAR; PG8_MMA(1, 0, At, B0); PG8_MMA(1, 1, At, B1); PG8_BAR; PG8_SCHED;
            } else {
            PG8_LDB(B0, 0, 0); PG8_SCHED; PG8_LDA(At, 0, 0); PG8_STAGE(PG8_SA(1, 1), a1 + hstep, voffA);
            PG8_WAIT_L(8); PG8_BAR; PG8_WAIT_L(0); PG8_MMA(0, 0, At, B0); PG8_BAR; PG8_SCHED;
            PG8_LDB(B1, 0, 1); PG8_STAGE(PG8_SB(0, 0), b2, voffB);
            PG8_BAR; PG8_WAIT_L(0); PG8_MMA(0, 1, At, B1); PG8_BAR;
            PG8_LDA(At, 0, 1); PG8_STAGE(PG8_SA(0, 0), a2, voffA);
            PG8_BAR; PG8_WAIT_L(0); PG8_MMA(1, 0, At, B0); PG8_BAR; PG8_SCHED;
            PG8_STAGE(PG8_SB(0, 1), b2 + hstep, voffB);
            PG8_WAIT_V(6); PG8_BAR; PG8_MMA(1, 1, At, B1); PG8_BAR;
            PG8_LDB(B0, 1, 0); PG8_SCHED; PG8_LDA(At, 1, 0); PG8_STAGE(PG8_SA(0, 1), a2 + hstep, voffA);
            PG8_WAIT_L(8); PG8_BAR; PG8_WAIT_L(0); PG8_MMA(0, 0, At, B0); PG8_BAR; PG8_SCHED;
            PG8_LDB(B1, 1, 1); PG8_STAGE(PG8_SB(1, 0), b3, voffB);
            PG8_BAR; PG8_WAIT_L(0); PG8_MMA(0, 1, At, B1); PG8_BAR;
            PG8_LDA(At, 1, 1); PG8_STAGE(PG8_SA(1, 0), a3, voffA);
            PG8_BAR; PG8_WAIT_L(0); PG8_MMA(1, 0, At, B0); PG8_BAR; PG8_SCHED;
            PG8_STAGE(PG8_SB(1, 1), b3 + hstep, voffB);
            PG8_WAIT_V(6); PG8_BAR; PG8_MMA(1, 1, At, B1); PG8_BAR;
            }
        }
        if constexpr (ALIGN_EPI) { if (wr == 0) PG8_BAR; }
        if constexpr (!Epi::AFTER_DRAIN) { E(acc, cur, wr, wc, fr, fq); S.done(cur); }
        if (!has_next) break;
#pragma unroll
        for (int a = 0; a < 2; ++a)
#pragma unroll
            for (int b = 0; b < 2; ++b)
#pragma unroll
                for (int m = 0; m < 4; ++m)
#pragma unroll
                    for (int n = 0; n < 2; ++n) acc[a][b][m][n] = (f32x4){0.f, 0.f, 0.f, 0.f};
        cur = nxt; cA = nA; cB = nB; ++ui;
        if constexpr (ALIGN_EPI) { if (wr == 1) PG8_BAR; }
    }
    PG8_WAIT_V(0);
    if constexpr (!ALIGN_EPI) { if (wr == 0) PG8_BAR; }
    PG8_BAR;
    if constexpr (Epi::AFTER_DRAIN) { E.fused(acc, cur, wr, wc, fr, fq, lds, wid, lane); S.done(cur); }
#undef PG8_SA
#undef PG8_SB
#undef PG8_STAGE
#undef PG8_LDA
#undef PG8_LDB
#undef PG8_MMA
#undef PG8_WAIT_V
#undef PG8_WAIT_L
#undef PG8_BAR
#undef PG8_SCHED
}
}
#define LAS __attribute__((address_space(3)))
#define DI __device__ __forceinline__
typedef unsigned short bf16;
typedef short bf16x8 __attribute__((ext_vector_type(8)));
typedef short s16x4 __attribute__((ext_vector_type(4)));
typedef float f32x2 __attribute__((ext_vector_type(2)));
typedef float f32x4 __attribute__((ext_vector_type(4)));
typedef float f32x16 __attribute__((ext_vector_type(16)));
typedef unsigned u32x2 __attribute__((ext_vector_type(2)));
typedef unsigned u32x4 __attribute__((ext_vector_type(4)));
using pg8::cvt_pk_bf16;
#define MFMA32(a, b, c) __builtin_amdgcn_mfma_f32_32x32x16_bf16((a), (b), (c), 0, 0, 0)

constexpr int T = 8192, DM = 2048, NWAVES = 8;
constexpr int NIN = 10544, NINP = 10752;
constexpr float LOG2E = 1.4426950408889634f, LN2 = 0.6931471805599453f, NEGBIG = -1e30f, EPS = 1e-6f;

constexpr size_t MiB = 1u << 20;
constexpr size_t WS_SUMSQ1 = 0, WS_SUMSQ2 = 32768, WS_BAR = 65536, CTL_ZERO_BYTES = 65536 + 16384;
constexpr size_t WS_WCK1T = 1 * MiB, WS_WCV1T = 1 * MiB + 512 * 1024, WS_WCK2T = 2 * MiB, WS_WCV2T = 2 * MiB + 16384, WS_SK1 = 2 * MiB + 32768, WS_SK2 = 2 * MiB + 65536,
                 WS_PEBK = 2 * MiB + 98304, WS_PEBV = 2 * MiB + 98304 + 512, WS_KX = 3 * MiB, WS_VXT = 3 * MiB + 262144, WS_KC = 3 * MiB + 524288, WS_VCT = 3 * MiB + 524288 + 131072,
                 WS_LSE = 4 * MiB, WS_GINV = 5 * MiB, WS_MN = 6 * MiB;
constexpr size_t WS_WIN = 8 * MiB, WS_WUPA = 50 * MiB, WS_WUPB = 52 * MiB, WS_WOUT = 56 * MiB, WS_WXQ = 64 * MiB, WS_WXKV = 66 * MiB, WS_WXO = 70 * MiB, WS_WPQ = 72 * MiB;
constexpr size_t WS_SSQ1 = 144 * MiB, WS_SSQ2 = 145 * MiB;
constexpr size_t WS_EU = 80 * MiB, WS_EV = 112 * MiB;
constexpr size_t WS_N = 208 * MiB, WS_MIXTMP = 208 * MiB, WS_AQ = 240 * MiB, WS_AK = 264 * MiB, WS_AVT = 288 * MiB, WS_BQ = 312 * MiB;
constexpr size_t WS_KCS = 328 * MiB, WS_VCS = 330 * MiB, WS_KS = 332 * MiB, WS_VST = 334 * MiB, WS_KW = 336 * MiB, WS_VWT = 338 * MiB, WS_BG = 340 * MiB, WS_MG = 342 * MiB;
constexpr size_t WS_OA = 406 * MiB, WS_YA = 431 * MiB, WS_YB = 439 * MiB, WS_MIX = 455 * MiB, WS_END = 487 * MiB;
constexpr size_t WS_H1G = 240 * MiB, WS_QX = 272 * MiB, WS_OX = 280 * MiB, WS_H2G = 288 * MiB, WS_PQ = 320 * MiB, WS_EID = 352 * MiB, WS_GW = 356 * MiB;
constexpr int LDSCTL_OFF = 131072;
constexpr int LDS_BYTES = 147456;

struct Args { const float* in[25]; float* out; unsigned char* ws; int ph_lo, ph_hi; };

DI float bflo(unsigned w) { return __uint_as_float(w << 16); }
DI float bfhi(unsigned w) { return __uint_as_float(w & 0xffff0000u); }
DI float bf2f(bf16 b) { return __uint_as_float(((unsigned)b) << 16); }
DI bf16 f2bf(float f) { return (bf16)(cvt_pk_bf16(f, 0.f) & 0xffffu); }
DI float fexp2(float x) { return __builtin_amdgcn_exp2f(x); }
DI float sigm(float x) { return 1.f / (1.f + __expf(-x)); }
DI float gelu_tanh(float x) { const float u = 0.7978845608028654f * (x + 0.044715f * x * x * x); return x / (1.f + __expf(-2.f * u)); }
DI int crow(int r, int h) { return (r & 3) + 8 * (r >> 2) + 4 * h; }
DI float wave_sum(float v) {
#pragma unroll
    for (int o = 1; o < 64; o <<= 1) v += __shfl_xor(v, o);
    return v;
}
DI u32x4 pack8(const f32x4& a, const f32x4& b) { u32x4 w; w.x = cvt_pk_bf16(a[0], a[1]); w.y = cvt_pk_bf16(a[2], a[3]); w.z = cvt_pk_bf16(b[0], b[1]); w.w = cvt_pk_bf16(b[2], b[3]); return w; }
DI bf16x8 pack8f(const float* p) { u32x4 w; w.x = cvt_pk_bf16(p[0], p[1]); w.y = cvt_pk_bf16(p[2], p[3]); w.z = cvt_pk_bf16(p[4], p[5]); w.w = cvt_pk_bf16(p[6], p[7]); return __builtin_bit_cast(bf16x8, w); }
DI bf16x8 cat4(s16x4 a, s16x4 b) { return (bf16x8){a[0], a[1], a[2], a[3], b[0], b[1], b[2], b[3]}; }

struct EpiProj {
    static constexpr bool PERM = true, AFTER_DRAIN = false;
    unsigned char* ws;
    DI void operator()(const f32x4 (&acc)[2][2][4][2], const pg8::Unit& u, int wr, int wc, int fr, int fq) const {
#pragma unroll
        for (int bj = 0; bj < 2; ++bj) {
            const int c8 = u.pn * 256 + bj * 128 + wc * 32 + 8 * fq;
            if (c8 >= NIN) continue;
            const int r0 = u.pm * 256 + wr * 64 + fr;
            if (c8 < 4608) {
                const int qkv = c8 / 1536, rem = c8 % 1536, g = rem / 512, hh = (rem % 512) / 128, d = rem % 128, ld = 2 * g, dm1 = (1 << ld) - 1;
                {
                    bf16* base = (bf16*)(ws + (qkv == 0 ? WS_AQ : qkv == 1 ? WS_AK : WS_AVT)) + (size_t)(g * 4 + hh) * T * 128 + d;
#pragma unroll
                    for (int ai = 0; ai < 2; ++ai)
#pragma unroll
                        for (int m = 0; m < 4; ++m) { const int t = r0 + ai * 128 + m * 16, tp = ((t & dm1) << (13 - ld)) + (t >> ld);
                            *(u32x4*)(base + (size_t)tp * 128) = pack8(acc[ai][bj][m][0], acc[ai][bj][m][1]); }
                }
            } else if (c8 < 5632) {
                bf16* base = (bf16*)(ws + WS_BQ) + (c8 - 4608);
#pragma unroll
                for (int ai = 0; ai < 2; ++ai)
#pragma unroll
                    for (int m = 0; m < 4; ++m) { const int t = r0 + ai * 128 + m * 16; *(u32x4*)(base + (size_t)t * 1024) = pack8(acc[ai][bj][m][0], acc[ai][bj][m][1]); }
            } else if (c8 < 6400) {
                const int c = c8 - 5632, br = c / 256, kv = (c % 256) / 128, G = (c % 128) / 64, d = c % 64;
                {
                    const size_t off = kv == 0 ? (br == 0 ? WS_KCS : br == 1 ? WS_KS : WS_KW) : (br == 0 ? WS_VCS : br == 1 ? WS_VST : WS_VWT);
                    bf16* base = (bf16*)(ws + off) + (size_t)G * T * 64 + d;
#pragma unroll
                    for (int ai = 0; ai < 2; ++ai)
#pragma unroll
                        for (int m = 0; m < 4; ++m) { const int t = r0 + ai * 128 + m * 16; *(u32x4*)(base + (size_t)t * 64) = pack8(acc[ai][bj][m][0], acc[ai][bj][m][1]); }
                }
            } else if (c8 < 10496) {
                bf16* base = (bf16*)(ws + WS_MG) + (c8 - 6400);
#pragma unroll
                for (int ai = 0; ai < 2; ++ai)
#pragma unroll
                    for (int m = 0; m < 4; ++m) { const int t = r0 + ai * 128 + m * 16; f32x4 a = acc[ai][bj][m][0], b = acc[ai][bj][m][1];
#pragma unroll
                        for (int e = 0; e < 4; ++e) { a[e] = sigm(a[e]); b[e] = sigm(b[e]); }
                        *(u32x4*)(base + (size_t)t * 4096) = pack8(a, b); }
            } else {
                float* base = (float*)(ws + WS_BG) + (c8 - 10496);
#pragma unroll
                for (int ai = 0; ai < 2; ++ai)
#pragma unroll
                    for (int m = 0; m < 4; ++m) { const int t = r0 + ai * 128 + m * 16; f32x4 a = acc[ai][bj][m][0], b = acc[ai][bj][m][1];
#pragma unroll
                        for (int e = 0; e < 4; ++e) { a[e] = sigm(a[e]); b[e] = sigm(b[e]); }
                        *(f32x4*)(base + (size_t)t * 48) = a; *(f32x4*)(base + (size_t)t * 48 + 4) = b; }
            }
        }
    }
};
struct EpiKvx {
    static constexpr bool PERM = true, AFTER_DRAIN = false;
    unsigned char* ws;
    DI void operator()(const f32x4 (&acc)[2][2][4][2], const pg8::Unit& u, int wr, int wc, int fr, int fq) const {
#pragma unroll
        for (int bj = 0; bj < 2; ++bj) {
            const int c8 = u.pn * 256 + bj * 128 + wc * 32 + 8 * fq, kvi = c8 / 512, hx = (c8 % 512) / 128, d = c8 % 128, r0 = wr * 64 + fr;
#pragma unroll
            for (int ai = 0; ai < 2; ++ai)
#pragma unroll
                for (int m = 0; m < 4; ++m) { const int row = r0 + ai * 128 + m * 16;
                    *(u32x4*)((bf16*)(ws + (kvi == 0 ? WS_KX : WS_VXT)) + (size_t)(hx * 256 + row) * 128 + d) = pack8(acc[ai][bj][m][0], acc[ai][bj][m][1]); }
        }
    }
};
template <int SECOND> struct EpiMix {
    static constexpr bool PERM = true, AFTER_DRAIN = false;
    unsigned char* ws;
    DI void operator()(const f32x4 (&acc)[2][2][4][2], const pg8::Unit& u, int wr, int wc, int fr, int fq) const {
#pragma unroll
        for (int bj = 0; bj < 2; ++bj) {
            const int c8 = u.pn * 256 + bj * 128 + wc * 32 + 8 * fq, r0 = u.pm * 256 + wr * 64 + fr;
#pragma unroll
            for (int ai = 0; ai < 2; ++ai)
#pragma unroll
                for (int m = 0; m < 4; ++m) { const int t = r0 + ai * 128 + m * 16;
                    const u32x4 gt = *(const u32x4*)((const bf16*)(ws + WS_MG) + (size_t)t * 4096 + SECOND * 2048 + c8);
                    f32x4 a = acc[ai][bj][m][0], b = acc[ai][bj][m][1];
                    a[0] *= bflo(gt.x); a[1] *= bfhi(gt.x); a[2] *= bflo(gt.y); a[3] *= bfhi(gt.y); b[0] *= bflo(gt.z); b[1] *= bfhi(gt.z); b[2] *= bflo(gt.w); b[3] *= bfhi(gt.w);
                    if (SECOND) { const u32x4 p = *(const u32x4*)((const bf16*)(ws + WS_MIXTMP) + (size_t)t * 2048 + c8);
                        a[0] += bflo(p.x); a[1] += bfhi(p.x); a[2] += bflo(p.y); a[3] += bfhi(p.y); b[0] += bflo(p.z); b[1] += bfhi(p.z); b[2] += bflo(p.w); b[3] += bfhi(p.w); }
                    *(u32x4*)((bf16*)(ws + (SECOND ? WS_MIX : WS_MIXTMP)) + (size_t)t * 2048 + c8) = pack8(a, b); }
        }
    }
};
DI float row_rs(const float* part) {
    float s = 0.f;
#pragma unroll
    for (int i = 0; i < 8; ++i) { const f32x4 p = *(const f32x4*)(part + 4 * i); s += (p[0] + p[1]) + (p[2] + p[3]); }
    return __builtin_amdgcn_rsqf(s * (1.f / DM) + EPS);
}
struct EpiRes {
    static constexpr bool PERM = false, AFTER_DRAIN = false;
    const float* base; float* out; bf16* hg; const float* gain; float* sumsq;
    DI void operator()(const f32x4 (&acc)[2][2][4][2], const pg8::Unit& u, int wr, int wc, int fr, int fq) const {
        const int r0 = u.pm * 256 + wr * 64 + fr, c0 = u.pn * 256 + wc * 32 + 4 * fq;
#pragma unroll
        for (int ai = 0; ai < 2; ++ai)
#pragma unroll
            for (int m = 0; m < 4; ++m) { const int t = r0 + ai * 128 + m * 16; float ss = 0.f;
#pragma unroll
                for (int bj = 0; bj < 2; ++bj)
#pragma unroll
                    for (int n = 0; n < 2; ++n) { const int c = c0 + bj * 128 + 16 * n; const size_t off = (size_t)t * DM + c;
                        const f32x4 h = *(const f32x4*)(base + off) + acc[ai][bj][m][n]; const f32x4 g = *(const f32x4*)(gain + c);
                        *(f32x4*)(out + off) = h; ss += (h[0] * h[0] + h[1] * h[1]) + (h[2] * h[2] + h[3] * h[3]);
                        u32x2 w; w.x = cvt_pk_bf16(h[0] * g[0], h[1] * g[1]); w.y = cvt_pk_bf16(h[2] * g[2], h[3] * g[3]); *(u32x2*)(hg + off) = w; }
                ss += __shfl_xor(ss, 16); ss += __shfl_xor(ss, 32);
                if (fq == 0) sumsq[(size_t)t * 32 + u.pn * 4 + wc] = ss; }
    }
};
struct EpiScaleRow {
    static constexpr bool PERM = true, AFTER_DRAIN = false;
    bf16* O; int ldc; const float* sumsq;
    DI void operator()(const f32x4 (&acc)[2][2][4][2], const pg8::Unit& u, int wr, int wc, int fr, int fq) const {
        const int r0 = u.pm * 256 + wr * 64 + fr;
#pragma unroll
        for (int ai = 0; ai < 2; ++ai)
#pragma unroll
            for (int m = 0; m < 4; ++m) { const int t = r0 + ai * 128 + m * 16; const float rs = row_rs(sumsq + (size_t)t * 32);
#pragma unroll
                for (int bj = 0; bj < 2; ++bj) { const int c8 = u.pn * 256 + bj * 128 + wc * 32 + 8 * fq;
                    *(u32x4*)(O + (size_t)t * ldc + c8) = pack8(acc[ai][bj][m][0] * rs, acc[ai][bj][m][1] * rs); } }
    }
};
template <class RowMap>
DI void transpose_item(const float* W, int K, int N, bf16* WT, LAS float* scr, int item, int lane, RowMap rowmap) {
    const int nblk = (N + 63) / 64, kb = item / nblk, nb = item % nblk, k0 = 64 * kb, n0 = 64 * nb;
    const int nn = n0 + lane; const bool okn = nn < N;
    float v[64];
#pragma unroll
    for (int i = 0; i < 64; ++i) v[i] = okn ? W[(size_t)(k0 + i) * N + nn] : 0.f;
#pragma unroll
    for (int i = 0; i < 64; ++i) scr[i * 64 + (lane ^ (8 * ((i >> 3) & 3)))] = v[i];
    asm volatile("s_waitcnt lgkmcnt(0)" ::: "memory");
    const int c = lane & 7, sw = 8 * (c & 3);
#pragma unroll
    for (int j = 0; j < 8; ++j) { const int nl = (lane >> 3) + 8 * j, n = n0 + nl; const LAS float* s = scr + (8 * c) * 64 + (nl ^ sw);
        u32x4 o; o.x = cvt_pk_bf16(s[0 * 64], s[1 * 64]); o.y = cvt_pk_bf16(s[2 * 64], s[3 * 64]); o.z = cvt_pk_bf16(s[4 * 64], s[5 * 64]); o.w = cvt_pk_bf16(s[6 * 64], s[7 * 64]);
        if (n < N) *(u32x4*)(WT + (size_t)rowmap(n) * K + k0 + 8 * c) = o; }
    asm volatile("s_waitcnt lgkmcnt(0)" ::: "memory");
}
struct RowId { DI int operator()(int n) const { return n; } };
struct RowWin { DI int operator()(int n) const { return n < 6400 ? n : (n < 6448 ? n + 4096 : n - 48); } };

DI void rms_row_to_bf16(const float* xrow, const float* gain, bf16* orow, int lane) {
    f32x4 v[8]; float s = 0.f;
#pragma unroll
    for (int j = 0; j < 8; ++j) { v[j] = *(const f32x4*)(xrow + j * 256 + lane * 4); s += (v[j][0] * v[j][0] + v[j][1] * v[j][1]) + (v[j][2] * v[j][2] + v[j][3] * v[j][3]); }
    const float rs = __builtin_amdgcn_rsqf(wave_sum(s) * (1.f / DM) + EPS);
#pragma unroll
    for (int j = 0; j < 8; ++j) { const f32x4 g = *(const f32x4*)(gain + j * 256 + lane * 4); u32x2 w; w.x = cvt_pk_bf16(v[j][0] * rs * g[0], v[j][1] * rs * g[1]); w.y = cvt_pk_bf16(v[j][2] * rs * g[2], v[j][3] * rs * g[3]);
        *(u32x2*)(orow + j * 256 + lane * 4) = w; }
}
DI void phase_prologue(const Args& a, LAS unsigned char* lds, int gw, int NGW, int wave, int lane) {
    unsigned char* ws = a.ws;
    LAS float* scr = (LAS float*)(lds + wave * 16384);
    constexpr int I_WIN = 32 * 165, I_UPA = 8 * 32, I_UPB = 16 * 32, I_OUT = 32 * 32, I_XQ = 32 * 8, I_XKV = 32 * 16, I_XO = 8 * 32, I_PQ = 32 * 32, I_C1 = 32 * 2, I_C2 = 2 * 1;
    constexpr int NITEMS = I_WIN + I_UPA + I_UPB + I_OUT + I_XQ + I_XKV + I_XO + I_PQ + 2 * I_C1 + 2 * I_C2;
    for (int it = gw; it < NITEMS; it += NGW) {
        int r = it;
        if (r < I_WIN) { transpose_item(a.in[3], 2048, NIN, (bf16*)(ws + WS_WIN), scr, r, lane, RowWin()); continue; } r -= I_WIN;
        if (r < I_UPA) { transpose_item(a.in[10], 512, 2048, (bf16*)(ws + WS_WUPA), scr, r, lane, RowId()); continue; } r -= I_UPA;
        if (r < I_UPB) { transpose_item(a.in[11], 1024, 2048, (bf16*)(ws + WS_WUPB), scr, r, lane, RowId()); continue; } r -= I_UPB;
        if (r < I_OUT) { transpose_item(a.in[12], 2048, 2048, (bf16*)(ws + WS_WOUT), scr, r, lane, RowId()); continue; } r -= I_OUT;
        if (r < I_XQ) { transpose_item(a.in[15], 2048, 512, (bf16*)(ws + WS_WXQ), scr, r, lane, RowId()); continue; } r -= I_XQ;
        if (r < I_XKV) { transpose_item(a.in[16], 2048, 1024, (bf16*)(ws + WS_WXKV), scr, r, lane, RowId()); continue; } r -= I_XKV;
        if (r < I_XO) { transpose_item(a.in[17], 512, 2048, (bf16*)(ws + WS_WXO), scr, r, lane, RowId()); continue; } r -= I_XO;
        if (r < I_PQ) { transpose_item(a.in[19], 2048, 2048, (bf16*)(ws + WS_WPQ), scr, r, lane, RowId()); continue; } r -= I_PQ;
        if (r < I_C1) { transpose_item(a.in[4], 2048, 128, (bf16*)(ws + WS_WCK1T), scr, r, lane, RowId()); continue; } r -= I_C1;
        if (r < I_C1) { transpose_item(a.in[7], 2048, 128, (bf16*)(ws + WS_WCV1T), scr, r, lane, RowId()); continue; } r -= I_C1;
        if (r < I_C2) { transpose_item(a.in[5], 128, 64, (bf16*)(ws + WS_WCK2T), scr, r, lane, RowId()); continue; } r -= I_C2;
        transpose_item(a.in[8], 128, 64, (bf16*)(ws + WS_WCV2T), scr, r, lane, RowId());
    }
    { u32x4* p = (u32x4*)((bf16*)(ws + WS_WIN) + (size_t)NIN * 2048); const int n16 = (NINP - NIN) * 2048 / 8;
      for (int i = gw * 64 + lane; i < n16; i += NGW * 64) p[i] = (u32x4){0u, 0u, 0u, 0u}; }
    for (int m = gw; m < T + 256; m += NGW) {
        if (m < T) rms_row_to_bf16(a.in[0] + (size_t)m * DM, a.in[2], (bf16*)(ws + WS_N) + (size_t)m * DM, lane);
        else rms_row_to_bf16(a.in[1] + (size_t)(m - T) * DM, a.in[14], (bf16*)(ws + WS_MN) + (size_t)(m - T) * DM, lane);
    }
    {   const size_t tid = (size_t)gw * 64 + lane, nth = (size_t)NGW * 64;
        for (int tb = 0; tb < 2; ++tb) { const f32x4* src = (const f32x4*)a.in[20 + tb]; u32x4* dst = (u32x4*)(ws + (tb ? WS_SK2 : WS_SK1));
            for (size_t i = tid; i < 128 * 128 / 8; i += nth) dst[i] = pack8(src[2 * i], src[2 * i + 1]); }
    }
    for (int o = gw; o < 256; o += NGW) { const int kv = o >> 7, j = o & 127; const float* pe = a.in[kv ? 9 : 6]; const float* w1 = a.in[kv ? 7 : 4]; float s = 0.f;
        for (int i = lane; i < 2048; i += 64) s += pe[i] * w1[(size_t)i * 128 + j];
        s = wave_sum(s); if (lane == 0) ((float*)(ws + (kv ? WS_PEBV : WS_PEBK)))[j] = s; }
}
constexpr float EU_SCALE = 64.f, EV_SCALE = 8.f;
DI unsigned pk4_fp8(const f32x4 v, float sc) {
    const float a = __builtin_amdgcn_fmed3f(v[0] * sc, -448.f, 448.f), b = __builtin_amdgcn_fmed3f(v[1] * sc, -448.f, 448.f), c = __builtin_amdgcn_fmed3f(v[2] * sc, -448.f, 448.f), d = __builtin_amdgcn_fmed3f(v[3] * sc, -448.f, 448.f);
    int w = __builtin_amdgcn_cvt_pk_fp8_f32(a, b, 0, false); w = __builtin_amdgcn_cvt_pk_fp8_f32(c, d, w, true); return (unsigned)w;
}
DI void convert_experts(const Args& a, size_t tid, size_t nth) {
    const size_t n16 = (size_t)16384 * 2048 / 16;
    for (int tb = 0; tb < 2; ++tb) { const f32x4* src = (const f32x4*)a.in[22 + tb]; u32x4* dst = (u32x4*)(a.ws + (tb ? WS_EV : WS_EU)); const float sc = tb ? EV_SCALE : EU_SCALE;
        for (size_t i = tid; i < n16; i += nth) { const f32x4 x0 = __builtin_nontemporal_load(src + 4 * i), x1 = __builtin_nontemporal_load(src + 4 * i + 1), x2 = __builtin_nontemporal_load(src + 4 * i + 2), x3 = __builtin_nontemporal_load(src + 4 * i + 3);
            u32x4 w; w.x = pk4_fp8(x0, sc); w.y = pk4_fp8(x1, sc); w.z = pk4_fp8(x2, sc); w.w = pk4_fp8(x3, sc); dst[i] = w; } }
}
typedef short v4i16_t __attribute__((ext_vector_type(4)));
template <int HD> struct Stage { u32x4 rk[HD / 16], rv[HD / 16]; };
template <int HD, bool WITH_V> DI void st_load(Stage<HD>& S, const bf16* Ktile, const bf16* Vtile, int lane) {
#pragma unroll
    for (int j = 0; j < HD / 16; ++j) { S.rk[j] = *(const u32x4*)((const char*)Ktile + j * 1024 + lane * 16); if (WITH_V) S.rv[j] = *(const u32x4*)((const char*)Vtile + j * 1024 + lane * 16); }
}
template <int HD, bool WITH_V> DI void st_write(const Stage<HD>& S, LAS unsigned char* buf, int lane) {
#pragma unroll
    for (int j = 0; j < HD / 16; ++j) { const int b = j * 1024 + lane * 16, row = b / (2 * HD), ch = (b >> 4) & (HD / 8 - 1);
        *(LAS u32x4*)(buf + row * (2 * HD) + ((ch ^ (row & (HD / 8 - 1))) << 4)) = S.rk[j];
        if (WITH_V) *(LAS u32x4*)(buf + 64 * HD + b) = S.rv[j]; }
}
template <int HD> DI bf16x8 k_frag(const LAS unsigned char* buf, int ks, int lane) { const int row = lane & 31, ch = 2 * ks + (lane >> 5);
    return *(const LAS bf16x8*)(buf + row * (2 * HD) + ((ch ^ (row & (HD / 8 - 1))) << 4)); }
template <int HD> DI bf16x8 v_frag(const LAS unsigned char* buf, int dt, int s, int lane) {
    const int gl = lane & 15, q = gl >> 2, p = gl & 3, h = lane >> 5;
    const LAS unsigned char* a0 = buf + 64 * HD + (16 * s + 4 * h + q) * (2 * HD) + (dt * 32 + 16 * ((lane >> 4) & 1) + 4 * p) * 2;
    const s16x4 lo = __builtin_bit_cast(s16x4, __builtin_amdgcn_ds_read_tr16_b64_v4i16((LAS v4i16_t*)a0));
    const s16x4 hi = __builtin_bit_cast(s16x4, __builtin_amdgcn_ds_read_tr16_b64_v4i16((LAS v4i16_t*)(a0 + 8 * (2 * HD))));
    return cat4(lo, hi);
}
template <int HD> DI f32x16 qk_tile(const bf16x8 (&q)[HD / 16], const LAS unsigned char* buf, int lane) {
    f32x16 s;
#pragma unroll
    for (int r = 0; r < 16; ++r) s[r] = 0.f;
#pragma unroll
    for (int ks = 0; ks < HD / 16; ++ks) s = MFMA32(k_frag<HD>(buf, ks, lane), q[ks], s);
    return s;
}
template <int HD> DI void pv_tile(const float (&p)[16], const LAS unsigned char* buf, f32x16 (&o)[HD / 32], int lane) {
    const bf16x8 pf0 = pack8f(p), pf1 = pack8f(p + 8);
#pragma unroll
    for (int dt = 0; dt < HD / 32; ++dt) { o[dt] = MFMA32(v_frag<HD>(buf, dt, 0, lane), pf0, o[dt]); o[dt] = MFMA32(v_frag<HD>(buf, dt, 1, lane), pf1, o[dt]); }
}
template <int HD, class SF>
DI void attn_compute(const bf16x8 (&q)[HD / 16], const LAS unsigned char* buf, float& m, float& l, f32x16 (&o)[HD / 32], int lane, SF sf) {
    const f32x16 s = qk_tile<HD>(q, buf, lane);
    float v[16]; float tmax = NEGBIG;
#pragma unroll
    for (int r = 0; r < 16; ++r) { v[r] = sf(r, s[r]); tmax = fmaxf(tmax, v[r]); }
    tmax = fmaxf(tmax, __shfl_xor(tmax, 32));
    if (__any(tmax > m)) {
        const float mn = fmaxf(m, tmax), alpha = fexp2(m - mn);
        l *= alpha; m = mn;
#pragma unroll
        for (int dt = 0; dt < HD / 32; ++dt) o[dt] = o[dt] * alpha;
    }
    const float msub = fmaxf(m, -1e20f);
    float p[16];
#pragma unroll
    for (int r = 0; r < 16; ++r) { p[r] = fexp2(v[r] - msub); l += p[r]; }
    pv_tile<HD>(p, buf, o, lane);
}
template <int HD, class KeyF, class CtxF, class MaskF>
DI void attn_run(const bf16x8 (&q)[HD / 16], const bf16* K, const bf16* V, LAS unsigned char* buf, int ntiles, KeyF keyf, float& m, float& l, f32x16 (&o)[HD / 32], int lane, CtxF ctxf, MaskF maskf) {
    if (ntiles <= 0) return;
    Stage<HD> S; int k0 = keyf(0);
    st_load<HD, true>(S, K + (long)k0 * HD, V + (long)k0 * HD, lane);
    st_write<HD, true>(S, buf, lane);
#pragma unroll 1
    for (int i = 0; i < ntiles; ++i) {
        int k1 = k0;
        if (i + 1 < ntiles) { k1 = keyf(i + 1); st_load<HD, true>(S, K + (long)k1 * HD, V + (long)k1 * HD, lane); }
        const auto ctx = ctxf(k0);
        attn_compute<HD>(q, buf, m, l, o, lane, [&](int r, float raw) { return maskf(ctx, r, raw); });
        if (i + 1 < ntiles) st_write<HD, true>(S, buf, lane);
        k0 = k1;
    }
    l += __shfl_xor(l, 32);
}
template <int NT>
DI void store_ot(bf16* orow, const f32x16 (&o)[NT], float scale, int h) {
#pragma unroll
    for (int dt = 0; dt < NT; ++dt)
#pragma unroll
        for (int rg = 0; rg < 4; ++rg) { u32x2 w; w.x = cvt_pk_bf16(o[dt][4 * rg] * scale, o[dt][4 * rg + 1] * scale); w.y = cvt_pk_bf16(o[dt][4 * rg + 2] * scale, o[dt][4 * rg + 3] * scale);
            *(u32x2*)(orow + 32 * dt + 8 * rg + 4 * h) = w; }
}

DI void dilated_item(unsigned char* ws, int item, int w, LAS unsigned char* buf, int lane) {
    const int g = item >> 8, rem = item & 255, hh = rem >> 6, nb = rem & 63, ld = 2 * g, dil = 1 << ld, nbk = 64 >> ld, n = nb / nbk, b = nb % nbk, L = T >> ld;
    const int i32 = lane & 31, h = lane >> 5, iq = 32 * w + i32, rowbase = n * L + 128 * b, gh = g * 4 + hh;
    const bf16* Q = (const bf16*)(ws + WS_AQ) + ((size_t)gh * T + rowbase + iq) * 128 + 8 * h;
    const bf16* K = (const bf16*)(ws + WS_AK) + ((long)gh * T + rowbase - 128) * 128;
    const bf16* V = (const bf16*)(ws + WS_AVT) + ((long)gh * T + rowbase - 128) * 128;
    bf16x8 q[8];
#pragma unroll
    for (int ks = 0; ks < 8; ++ks) q[ks] = *(const bf16x8*)(Q + 16 * ks);
    const float slope = exp2f(-8.f * (float)(gh + 1) / 12.f), sl2 = slope * (float)dil * LOG2E, sc2 = 0.08838834764831845f * LOG2E;
    f32x16 o[4];
#pragma unroll
    for (int dt = 0; dt < 4; ++dt)
#pragma unroll
        for (int r = 0; r < 16; ++r) o[dt][r] = 0.f;
    float m = NEGBIG, l = 0.f;
    { const int first = (b == 0 && 32 * w < 128) ? 128 : 32 * w, ntiles = (32 * w + 160 - first) >> 5, last = first + 32 * (ntiles - 1);
      struct Ctx { int relh; float c0; };
      attn_run<128>(q, K, V, buf, ntiles, [&](int i) { return last - 32 * i; }, m, l, o, lane,
          [&](int j0) { Ctx c; c.relh = iq + 128 - j0 - 4 * h; c.c0 = -sl2 * (float)c.relh; return c; },
          [&](const Ctx& c, int r, float raw) { const int cr = (r & 3) + 8 * (r >> 2); return (cr <= c.relh && cr >= c.relh - 128) ? __builtin_fmaf(raw, sc2, __builtin_fmaf((float)cr, sl2, c.c0)) : NEGBIG; }); }
    const int t = (128 * b + iq) * dil + n;
    store_ot<4>((bf16*)(ws + WS_OA) + ((size_t)g * T + t) * 512 + hh * 128, o, 1.f / l, h);
    if (h == 0) ((float*)(ws + WS_LSE))[((size_t)g * T + t) * 4 + hh] = (m + __log2f(l)) * LN2;
}
DI void compress_block(unsigned char* ws, int item, LAS unsigned char* lds, int wave, int lane, int tid) {
    const int kv = item >> 5, G = (item >> 4) & 1, rt = item & 15, i32 = lane & 31, h = lane >> 5;
    const int c = rt * 32 + i32, cc = c < 511 ? c : 510;
    LAS float* red = (LAS float*)lds;
    const bf16* A = (const bf16*)(ws + (kv ? WS_VCS : WS_KCS)) + (size_t)G * T * 64 + (size_t)cc * 1024 + 8 * h + wave * 256;
    const bf16* W1 = (const bf16*)(ws + (kv ? WS_WCV1T : WS_WCK1T)) + (size_t)i32 * 2048 + 8 * h + wave * 256;
    f32x16 hid[4];
#pragma unroll
    for (int jt = 0; jt < 4; ++jt)
#pragma unroll
        for (int r = 0; r < 16; ++r) hid[jt][r] = 0.f;
#pragma unroll 4
    for (int ks = 0; ks < 16; ++ks) {
        const bf16x8 af = *(const bf16x8*)(A + 16 * ks);
#pragma unroll
        for (int jt = 0; jt < 4; ++jt) hid[jt] = MFMA32(*(const bf16x8*)(W1 + (size_t)jt * 32 * 2048 + 16 * ks), af, hid[jt]);
    }
#pragma unroll
    for (int jt = 0; jt < 4; ++jt)
#pragma unroll
        for (int r = 0; r < 16; ++r) red[wave * 4096 + (jt * 16 + r) * 64 + lane] = hid[jt][r];
    __syncthreads();
    if (wave < 2) {
        const int dt = wave;
        const float* peb = (const float*)(ws + (kv ? WS_PEBV : WS_PEBK));
        const bf16* W2 = (const bf16*)(ws + (kv ? WS_WCV2T : WS_WCK2T)) + (size_t)(dt * 32 + i32) * 128 + 4 * h;
        f32x16 o;
#pragma unroll
        for (int r = 0; r < 16; ++r) o[r] = 0.f;
#pragma unroll
        for (int jt = 0; jt < 4; ++jt) { float gl[16];
#pragma unroll
            for (int r = 0; r < 16; ++r) { float sacc = red[(jt * 16 + r) * 64 + lane];
#pragma unroll
                for (int w8 = 1; w8 < 8; ++w8) sacc += red[w8 * 4096 + (jt * 16 + r) * 64 + lane];
                gl[r] = gelu_tanh(sacc + peb[jt * 32 + crow(r, h)]); }
            const bf16* wp = W2 + jt * 32;
            o = MFMA32(cat4(*(const s16x4*)(wp), *(const s16x4*)(wp + 8)), pack8f(gl), o);
            o = MFMA32(cat4(*(const s16x4*)(wp + 16), *(const s16x4*)(wp + 24)), pack8f(gl + 8), o); }
        const float keep = c < 511 ? 1.f : 0.f;
        { bf16* orow = (bf16*)(ws + (kv ? WS_VCT : WS_KC)) + ((size_t)G * 512 + c) * 64 + 32 * dt;
#pragma unroll
            for (int rg = 0; rg < 4; ++rg) { u32x2 w; w.x = cvt_pk_bf16(o[4 * rg] * keep, o[4 * rg + 1] * keep); w.y = cvt_pk_bf16(o[4 * rg + 2] * keep, o[4 * rg + 3] * keep); *(u32x2*)(orow + 8 * rg + 4 * h) = w; } }
    }
    __syncthreads();
}
DI void nsa_item(unsigned char* ws, int G, int chunk, LAS float* pc  , LAS int* tl  , LAS unsigned char* buf  , int lane) {
    const int i32 = lane & 31, h = lane >> 5, tok = i32 >> 3, hh = G * 8 + (i32 & 7), t0 = chunk * 4, t = t0 + tok;
    const float slope = exp2f(-0.5f * (float)(hh + 1)), sl2 = slope * LOG2E, sc2 = 0.125f * LOG2E;
    bf16x8 q[4];
    { const bf16* Q = (const bf16*)(ws + WS_BQ) + (size_t)t * 1024 + hh * 64 + 8 * h;
#pragma unroll
      for (int ks = 0; ks < 4; ++ks) q[ks] = *(const bf16x8*)(Q + 16 * ks); }
    const float* gate = (const float*)(ws + WS_BG) + (size_t)t * 48 + hh * 3;
    const float g_c = gate[0], g_s = gate[1], g_w = gate[2];
    f32x16 o[2];
#pragma unroll
    for (int dt = 0; dt < 2; ++dt)
#pragma unroll
        for (int r = 0; r < 16; ++r) o[dt][r] = 0.f;
    const int cv = t >= 31 ? ((t - 31) >> 4) : -1;
    const int cmaxw = t0 + 3 >= 31 ? ((t0 + 3 - 31) >> 4) : -1;
    const int nct = cmaxw >= 0 ? (cmaxw >> 5) + 1 : 0;
    const bf16* KC = (const bf16*)(ws + WS_KC) + (size_t)G * 512 * 64;
    const bf16* VC = (const bf16*)(ws + WS_VCT) + (size_t)G * 512 * 64;
    float m = NEGBIG, l = 0.f;
    if (nct > 0) {
        Stage<64> S;
        st_load<64, false>(S, KC, VC, lane); st_write<64, false>(S, buf, lane);
#pragma unroll 1
        for (int ct = 0; ct < nct; ++ct) {
            if (ct + 1 < nct) st_load<64, false>(S, KC + (size_t)(ct + 1) * 32 * 64, VC, lane);
            const f32x16 s = qk_tile<64>(q, buf, lane);
            float v[16]; float tmax = NEGBIG;
#pragma unroll
            for (int r = 0; r < 16; ++r) { const int c = ct * 32 + crow(r, h); v[r] = c <= cv ? s[r] * sc2 - sl2 * (float)(t - 16 * c - 31) : NEGBIG; tmax = fmaxf(tmax, v[r]); }
            tmax = fmaxf(tmax, __shfl_xor(tmax, 32));
            const float mn = fmaxf(m, tmax); float ps = 0.f;
#pragma unroll
            for (int r = 0; r < 16; ++r) ps += v[r] > -1e29f ? fexp2(v[r] - mn) : 0.f;
            ps += __shfl_xor(ps, 32);
            l = l * fexp2(m - mn) + ps; m = mn;
            if (ct + 1 < nct) st_write<64, false>(S, buf, lane);
        }
        const float inv_c = l > 0.f ? 1.f / l : 0.f;
        st_load<64, true>(S, KC, VC, lane); st_write<64, true>(S, buf, lane);
#pragma unroll 1
        for (int ct = 0; ct < nct; ++ct) {
            if (ct + 1 < nct) st_load<64, true>(S, KC + (size_t)(ct + 1) * 32 * 64, VC + (size_t)(ct + 1) * 32 * 64, lane);
            const f32x16 s = qk_tile<64>(q, buf, lane);
            float p[16];
#pragma unroll
            for (int r = 0; r < 16; ++r) { const int c = ct * 32 + crow(r, h); p[r] = c <= cv ? fexp2(s[r] * sc2 - sl2 * (float)(t - 16 * c - 31) - m) * inv_c : 0.f; }
            pv_tile<64>(p, buf, o, lane);
#pragma unroll
            for (int r = 0; r < 16; ++r) { float x = p[r]; x += __shfl_xor(x, 1); x += __shfl_xor(x, 2); x += __shfl_xor(x, 4);
                if ((i32 & 7) == 0) pc[tok * 512 + ct * 32 + crow(r, h)] = x; }
            if (ct + 1 < nct) st_write<64, true>(S, buf, lane);
        }
    }
    asm volatile("s_waitcnt lgkmcnt(0)" ::: "memory");
    unsigned msk[4] = {0u, 0u, 0u, 0u};
    {   const int ts = lane >> 4, l16 = lane & 15, tsel = t0 + ts, cur = tsel >> 6;
        float cand[8];
#pragma unroll
        for (int e = 0; e < 8; ++e) { const int j = l16 * 8 + e; const bool valid = j >= 1 && j <= cur - 2; const LAS float* pp = pc + ts * 512 + 4 * j;
            const int jm = valid ? -1 : 0;
            cand[e] = valid ? (pp[0] + pp[1]) + pp[2] + 0.5f * (pp[3] + pp[jm]) : -1.f; }
        msk[0] |= 1u;
#pragma unroll
        for (int w = 0; w < 4; ++w) { if ((cur >> 5) == w) msk[w] |= 1u << (cur & 31); if (cur >= 1 && ((cur - 1) >> 5) == w) msk[w] |= 1u << ((cur - 1) & 31); }
        for (int round = 0; round < 13; ++round) {
            float bv = -3.f; int bi = 1 << 20;
#pragma unroll
            for (int e = 0; e < 8; ++e) if (cand[e] > bv) { bv = cand[e]; bi = l16 * 8 + e; }
#pragma unroll
            for (int off = 1; off < 16; off <<= 1) { const float ov = __shfl_xor(bv, off); const int oi = __shfl_xor(bi, off); if (ov > bv || (ov == bv && oi < bi)) { bv = ov; bi = oi; } }
            if (bv >= 0.f) {
#pragma unroll
                for (int w = 0; w < 4; ++w) if ((bi >> 5) == w) msk[w] |= 1u << (bi & 31);
#pragma unroll
                for (int e = 0; e < 8; ++e) if (l16 * 8 + e == bi) cand[e] = -2.f;
            }
        }
    }
    unsigned mk[4], U[4];
#pragma unroll
    for (int w = 0; w < 4; ++w) { mk[w] = __shfl(msk[w], tok * 16);
        U[w] = __builtin_amdgcn_readlane(msk[w], 0) | __builtin_amdgcn_readlane(msk[w], 16) | __builtin_amdgcn_readlane(msk[w], 32) | __builtin_amdgcn_readlane(msk[w], 48); }
    const unsigned long long mklo = (unsigned long long)mk[0] | ((unsigned long long)mk[1] << 32), mkhi = (unsigned long long)mk[2] | ((unsigned long long)mk[3] << 32);
    asm volatile("s_waitcnt lgkmcnt(0)" ::: "memory");
    LAS float* yl = pc + lane;
#pragma unroll
    for (int dt = 0; dt < 2; ++dt)
#pragma unroll
        for (int r = 0; r < 16; ++r) { yl[(16 * dt + r) * 64] = g_c * o[dt][r]; o[dt][r] = 0.f; }
    m = NEGBIG; l = 0.f;
    {
        int base = 0;
#pragma unroll
        for (int w = 0; w < 4; ++w) { const unsigned bits = U[w]; if (lane < 32 && ((bits >> lane) & 1u)) { const int pos = base + __builtin_popcount(bits & ((1u << lane) - 1u)); tl[2 * pos] = 64 * (w * 32 + lane); tl[2 * pos + 1] = 64 * (w * 32 + lane) + 32; }
            base += __builtin_popcount(bits); }
        const int ntl = 2 * base - (((t0 + 3) & 63) < 32 ? 1 : 0);
        asm volatile("s_waitcnt lgkmcnt(0)" ::: "memory");
        struct Ctx { int tbh; float c0; bool mine; };
        attn_run<64>(q, (const bf16*)(ws + WS_KS) + (size_t)G * T * 64, (const bf16*)(ws + WS_VST) + (size_t)G * T * 64, buf, ntl, [&](int i) { return __builtin_amdgcn_readfirstlane(tl[ntl - 1 - i]); }, m, l, o, lane,
            [&](int key0) { Ctx c; const int jb = key0 >> 6; const unsigned long long mm = (jb & 64) ? mkhi : mklo;
                c.mine = (mm >> (jb & 63)) & 1ull; c.tbh = t - key0 - 4 * h; c.c0 = -sl2 * (float)c.tbh; return c; },
            [&](const Ctx& c, int r, float raw) { const int cr = (r & 3) + 8 * (r >> 2); return (c.mine && cr <= c.tbh) ? __builtin_fmaf(raw, sc2, __builtin_fmaf((float)cr, sl2, c.c0)) : NEGBIG; });
    }
    { const float sc = l > 0.f ? g_s / l : 0.f;
#pragma unroll
      for (int dt = 0; dt < 2; ++dt)
#pragma unroll
          for (int r = 0; r < 16; ++r) { yl[(16 * dt + r) * 64] += sc * o[dt][r]; o[dt][r] = 0.f; } }
    m = NEGBIG; l = 0.f;
    { const int lo = (t0 - 511 > 0 ? t0 - 511 : 0) & ~31, ntl = ((t0 + 3 - lo) >> 5) + 1, hi0 = lo + 32 * (ntl - 1);
      struct Ctx { int tbh; float c0; };
      attn_run<64>(q, (const bf16*)(ws + WS_KW) + (size_t)G * T * 64, (const bf16*)(ws + WS_VWT) + (size_t)G * T * 64, buf, ntl, [&](int i) { return hi0 - 32 * i; }, m, l, o, lane,
          [&](int key0) { Ctx c; c.tbh = t - key0 - 4 * h; c.c0 = -sl2 * (float)c.tbh; return c; },
          [&](const Ctx& c, int r, float raw) { const int cr = (r & 3) + 8 * (r >> 2); return (cr <= c.tbh && cr > c.tbh - 512) ? __builtin_fmaf(raw, sc2, __builtin_fmaf((float)cr, sl2, c.c0)) : NEGBIG; }); }
    { const float sc = l > 0.f ? g_w / l : 0.f;
#pragma unroll
      for (int dt = 0; dt < 2; ++dt)
#pragma unroll
          for (int r = 0; r < 16; ++r) o[dt][r] = yl[(16 * dt + r) * 64] + sc * o[dt][r]; }
    store_ot<2>((bf16*)(ws + WS_YB) + (size_t)t * 1024 + hh * 64, o, 1.f, h);
    asm volatile("s_waitcnt lgkmcnt(0)" ::: "memory");
}
DI void dilated_combine(unsigned char* ws, size_t tid, size_t nth) {
    const float* lse = (const float*)(ws + WS_LSE); const bf16* oa = (const bf16*)(ws + WS_OA); bf16* ya = (bf16*)(ws + WS_YA);
    for (size_t i = tid; i < (size_t)T * 64; i += nth) {
        const size_t t = i >> 6; const int c8 = (int)(i & 63) * 8, hh = c8 >> 7;
        const float l0 = lse[(0 * (size_t)T + t) * 4 + hh], l1 = lse[(1 * (size_t)T + t) * 4 + hh], l2 = lse[(2 * (size_t)T + t) * 4 + hh];
        const float mx = fmaxf(l0, fmaxf(l1, l2)), e0 = __expf(l0 - mx), e1 = __expf(l1 - mx), e2 = __expf(l2 - mx), inv = 1.f / (e0 + e1 + e2);
        const u32x4 a = *(const u32x4*)(oa + (0 * (size_t)T + t) * 512 + c8), b = *(const u32x4*)(oa + (1 * (size_t)T + t) * 512 + c8), c = *(const u32x4*)(oa + (2 * (size_t)T + t) * 512 + c8);
        const float w0 = e0 * inv, w1 = e1 * inv, w2 = e2 * inv; u32x4 r;
        r.x = cvt_pk_bf16(w0 * bflo(a.x) + w1 * bflo(b.x) + w2 * bflo(c.x), w0 * bfhi(a.x) + w1 * bfhi(b.x) + w2 * bfhi(c.x));
        r.y = cvt_pk_bf16(w0 * bflo(a.y) + w1 * bflo(b.y) + w2 * bflo(c.y), w0 * bfhi(a.y) + w1 * bfhi(b.y) + w2 * bfhi(c.y));
        r.z = cvt_pk_bf16(w0 * bflo(a.z) + w1 * bflo(b.z) + w2 * bflo(c.z), w0 * bfhi(a.z) + w1 * bfhi(b.z) + w2 * bfhi(c.z));
        r.w = cvt_pk_bf16(w0 * bflo(a.w) + w1 * bflo(b.w) + w2 * bflo(c.w), w0 * bfhi(a.w) + w1 * bfhi(b.w) + w2 * bfhi(c.w));
        *(u32x4*)(ya + t * 512 + c8) = r;
    }
}
DI void cross_item(unsigned char* ws, int item, LAS unsigned char* buf, int lane) {
    const int hx = item & 3, qt = item >> 2, i32 = lane & 31, h = lane >> 5, t = qt * 32 + i32;
    const bf16* Q = (const bf16*)(ws + WS_QX) + (size_t)t * 512 + hx * 128 + 8 * h;
    bf16x8 q[8];
#pragma unroll
    for (int ks = 0; ks < 8; ++ks) q[ks] = *(const bf16x8*)(Q + 16 * ks);
    const bf16* K = (const bf16*)(ws + WS_KX) + (size_t)hx * 256 * 128;
    const bf16* V = (const bf16*)(ws + WS_VXT) + (size_t)hx * 256 * 128;
    f32x16 o[4];
#pragma unroll
    for (int dt = 0; dt < 4; ++dt)
#pragma unroll
        for (int r = 0; r < 16; ++r) o[dt][r] = 0.f;
    float m = NEGBIG, l = 0.f; const float sc2 = 0.08838834764831845f * LOG2E;
    attn_run<128>(q, K, V, buf, 8, [&](int i) { return 32 * i; }, m, l, o, lane, [&](int) { return 0; }, [&](int, int, float raw) { return raw * sc2; });
    store_ot<4>((bf16*)(ws + WS_OX) + (size_t)t * 512 + hx * 128, o, 1.f / l, h);
}
DI void peer_topk_item(unsigned char* ws, int item, LAS float* scr, int lane) {
    const int hp = item & 7, tt = item >> 3, i32 = lane & 31, h = lane >> 5, t = tt * 32 + i32;
    const bf16* Q = (const bf16*)(ws + WS_PQ) + (size_t)t * 2048 + hp * 256 + 8 * h;
    LAS float* my = scr + i32 * 64;
#pragma unroll 1
    for (int z = 0; z < 2; ++z) {
        bf16x8 q[8];
#pragma unroll
        for (int ks = 0; ks < 8; ++ks) q[ks] = *(const bf16x8*)(Q + z * 128 + 16 * ks);
        const bf16* SK = (const bf16*)(ws + (z ? WS_SK2 : WS_SK1)) + (size_t)i32 * 128 + 8 * h;
        f32x16 s[4];
#pragma unroll
        for (int kt = 0; kt < 4; ++kt) {
#pragma unroll
            for (int r = 0; r < 16; ++r) s[kt][r] = 0.f;
#pragma unroll
            for (int ks = 0; ks < 8; ++ks) s[kt] = MFMA32(*(const bf16x8*)(SK + (size_t)kt * 32 * 128 + 16 * ks), q[ks], s[kt]);
        }
#pragma unroll 1
        for (int round = 0; round < 16; ++round) {
            float bv = -3.0e38f; int bi = 1 << 20;
#pragma unroll
            for (int kt = 0; kt < 4; ++kt)
#pragma unroll
                for (int r = 0; r < 16; ++r) if (s[kt][r] > bv) { bv = s[kt][r]; bi = kt * 32 + crow(r, h); }
            { const float ov = __shfl_xor(bv, 32); const int oi = __shfl_xor(bi, 32); if (ov > bv || (ov == bv && oi < bi)) { bv = ov; bi = oi; } }
#pragma unroll
            for (int kt = 0; kt < 4; ++kt)
#pragma unroll
                for (int r = 0; r < 16; ++r) if (kt * 32 + crow(r, h) == bi) s[kt][r] = -3.0e38f;
            if (h == 0) { my[(z * 16 + round) * 2] = bv; my[(z * 16 + round) * 2 + 1] = __int_as_float(bi); }
        }
    }
    asm volatile("s_waitcnt lgkmcnt(0)" ::: "memory");
    float v1[16], v2[16];
#pragma unroll
    for (int k = 0; k < 16; ++k) { v1[k] = my[k * 2]; v2[k] = my[(16 + k) * 2]; }
    float cand[50]; int n = 0;
#pragma unroll
    for (int a = 0; a < 16; ++a)
#pragma unroll
        for (int b = 0; b < 16 / (a + 1); ++b) cand[n++] = v1[a] + v2[b];
    int* eid = (int*)(ws + WS_EID) + (size_t)t * 128 + hp * 16; float* gw = (float*)(ws + WS_GW) + (size_t)t * 128 + hp * 16;
    float vmax = 0.f, esum = 0.f;
#pragma unroll 1
    for (int round = 0; round < 16; ++round) {
        float bv = -3.0e38f; int bc = 0; n = 0;
#pragma unroll
        for (int a = 0; a < 16; ++a)
#pragma unroll
            for (int b = 0; b < 16 / (a + 1); ++b) { if (cand[n] > bv) { bv = cand[n]; bc = a * 16 + b; } ++n; }
        n = 0;
#pragma unroll
        for (int a = 0; a < 16; ++a)
#pragma unroll
            for (int b = 0; b < 16 / (a + 1); ++b) { if (a * 16 + b == bc) cand[n] = -3.0e38f; ++n; }
        if (round == 0) vmax = bv;
        const float e = __expf(bv - vmax); esum += e;
        const int e1 = __float_as_int(my[(bc >> 4) * 2 + 1]), e2 = __float_as_int(my[(16 + (bc & 15)) * 2 + 1]);
        if (h == 0) { eid[round] = e1 * 128 + e2; gw[round] = e; }
    }
    if (h == 0) ((float*)(ws + WS_GINV))[(size_t)t * 8 + hp] = 1.f / esum;
}
DI void peer_load(u32x4 (&R)[4][2], const unsigned char* E, int eA, int eB, int b) {
#pragma unroll
    for (int k = 0; k < 4; ++k) { const int p = 4 * b + k; const int e = b < 16 ? __builtin_amdgcn_readlane(eA, p & 63) : __builtin_amdgcn_readlane(eB, p & 63);
        const unsigned char* rp = E + (size_t)e * DM; R[k][0] = *(const u32x4*)(rp); R[k][1] = *(const u32x4*)(rp + 1024); }
}
DI float peer_dots(const u32x4 (&U)[4][2], const f32x2 (&xs)[16], int lane) {
    float d[4];
#pragma unroll
    for (int k = 0; k < 4; ++k) { f32x2 acc = {0.f, 0.f};
#pragma unroll
        for (int c = 0; c < 2; ++c)
#pragma unroll
            for (int wd = 0; wd < 4; ++wd) { const int w = (int)U[k][c][wd];
                acc = __builtin_elementwise_fma(__builtin_amdgcn_cvt_pk_f32_fp8(w, false), xs[c * 8 + wd * 2], acc);
                acc = __builtin_elementwise_fma(__builtin_amdgcn_cvt_pk_f32_fp8(w, true), xs[c * 8 + wd * 2 + 1], acc); }
        d[k] = acc.x + acc.y; }
    const bool hi32 = lane & 32, hi16 = lane & 16;
    float k0 = hi32 ? d[2] : d[0], k1 = hi32 ? d[3] : d[1];
    k0 += __shfl_xor(hi32 ? d[0] : d[2], 32); k1 += __shfl_xor(hi32 ? d[1] : d[3], 32);
    float kk = hi16 ? k1 : k0; kk += __shfl_xor(hi16 ? k0 : k1, 16);
    kk += __shfl_xor(kk, 8); kk += __shfl_xor(kk, 4); kk += __shfl_xor(kk, 2); kk += __shfl_xor(kk, 1);
    return kk;
}
DI void peer_axpy(const u32x4 (&V)[4][2], float kk, f32x2 (&y)[16], int gA, int gB, int b, float arg_scale) {
#pragma unroll
    for (int k = 0; k < 4; ++k) { const int p = 4 * b + k;
        const float dot = __int_as_float(__builtin_amdgcn_readlane(__float_as_int(kk), 16 * k));
        const float g = __int_as_float(b < 16 ? __builtin_amdgcn_readlane(gA, p & 63) : __builtin_amdgcn_readlane(gB, p & 63));
        const float coef = g * gelu_tanh(dot * arg_scale); const f32x2 cf = {coef, coef};
#pragma unroll
        for (int c = 0; c < 2; ++c)
#pragma unroll
            for (int wd = 0; wd < 4; ++wd) { const int w = (int)V[k][c][wd];
                y[c * 8 + wd * 2] = __builtin_elementwise_fma(__builtin_amdgcn_cvt_pk_f32_fp8(w, false), cf, y[c * 8 + wd * 2]);
                y[c * 8 + wd * 2 + 1] = __builtin_elementwise_fma(__builtin_amdgcn_cvt_pk_f32_fp8(w, true), cf, y[c * 8 + wd * 2 + 1]); } }
}
DI void peer_gather_token(const Args& a, int t, int lane, float* outp) {
    unsigned char* ws = a.ws;
    const bf16* xg = (const bf16*)(ws + WS_H2G) + (size_t)t * DM + lane * 16;
    f32x2 xs[16];
#pragma unroll
    for (int c = 0; c < 2; ++c)
#pragma unroll
        for (int q = 0; q < 2; ++q) { const u32x4 w = *(const u32x4*)(xg + c * 1024 + q * 8);
            xs[c * 8 + q * 4 + 0] = (f32x2){bflo(w.x), bfhi(w.x)}; xs[c * 8 + q * 4 + 1] = (f32x2){bflo(w.y), bfhi(w.y)}; xs[c * 8 + q * 4 + 2] = (f32x2){bflo(w.z), bfhi(w.z)}; xs[c * 8 + q * 4 + 3] = (f32x2){bflo(w.w), bfhi(w.w)}; }
    const float rs2 = row_rs((const float*)(ws + WS_SSQ2) + (size_t)t * 32);
    const int* eidp = (const int*)(ws + WS_EID) + (size_t)t * 128; const float* gwp = (const float*)(ws + WS_GW) + (size_t)t * 128; const float* ginv = (const float*)(ws + WS_GINV) + (size_t)t * 8;
    const int eA = eidp[lane], eB = eidp[64 + lane];
    const int gA = __float_as_int(gwp[lane] * ginv[lane >> 4] * (1.f / EV_SCALE)), gB = __float_as_int(gwp[64 + lane] * ginv[4 + (lane >> 4)] * (1.f / EV_SCALE));
    f32x2 y[16];
#pragma unroll
    for (int i = 0; i < 16; ++i) y[i] = (f32x2){0.f, 0.f};
    const unsigned char* EU = ws + WS_EU + lane * 16; const unsigned char* EV = ws + WS_EV + lane * 16;
    const float arg_scale = rs2 * (1.f / EU_SCALE);
    u32x4 U0[4][2], V0[4][2], U1[4][2], V1[4][2];
    peer_load(U0, EU, eA, eB, 0); peer_load(V0, EV, eA, eB, 0);
#pragma unroll 1
    for (int b = 0; b < 32; b += 2) {
        peer_load(U1, EU, eA, eB, b + 1);
        const float ka = peer_dots(U0, xs, lane);
        asm volatile("" ::: "memory");
        peer_load(V1, EV, eA, eB, b + 1);
        peer_axpy(V0, ka, y, gA, gB, b, arg_scale);
        asm volatile("" ::: "memory");
        if (b + 2 < 32) peer_load(U0, EU, eA, eB, b + 2);
        const float kb = peer_dots(U1, xs, lane);
        asm volatile("" ::: "memory");
        if (b + 2 < 32) peer_load(V0, EV, eA, eB, b + 2);
        peer_axpy(V1, kb, y, gA, gB, b + 1, arg_scale);
        asm volatile("" ::: "memory");
    }
    const float* hrow = a.out + (size_t)t * DM + lane * 16; float* orow = outp + (size_t)t * DM + lane * 16; const float* gf = a.in[24] + lane * 16; float ss = 0.f;
#pragma unroll
    for (int c = 0; c < 2; ++c)
#pragma unroll
        for (int q = 0; q < 4; ++q) { const f32x4 hv = *(const f32x4*)(hrow + c * 1024 + q * 4);
            f32x2& y0 = y[c * 8 + q * 2]; f32x2& y1 = y[c * 8 + q * 2 + 1];
            y0.x += hv[0]; y0.y += hv[1]; y1.x += hv[2]; y1.y += hv[3]; ss += (y0.x * y0.x + y0.y * y0.y) + (y1.x * y1.x + y1.y * y1.y); }
    const float rs = __builtin_amdgcn_rsqf(wave_sum(ss) * (1.f / DM) + EPS);
#pragma unroll
    for (int c = 0; c < 2; ++c)
#pragma unroll
        for (int q = 0; q < 4; ++q) { const f32x4 gv = *(const f32x4*)(gf + c * 1024 + q * 4); const f32x2 y0 = y[c * 8 + q * 2], y1 = y[c * 8 + q * 2 + 1];
            *(f32x4*)(orow + c * 1024 + q * 4) = (f32x4){y0.x * rs * gv[0], y0.y * rs * gv[1], y1.x * rs * gv[2], y1.y * rs * gv[3]}; }
}
#define XB_TMO      128
#define XB_XCNT(j)  (256  + 64 * (j))
#define XB_XSUB(j)  (1280 + 64 * (j))
#define XB_XGEN(j)  (2304 + 64 * (j))
#define XB_TOP      3328
#define XB_TOPGEN   3392
#define XCD_BAR_WORDS 3456
#define XB_SPIN_CAP (1u << 18)

__device__ __forceinline__ unsigned xb_ld(unsigned* p)              { return __hip_atomic_load(p, __ATOMIC_RELAXED, __HIP_MEMORY_SCOPE_AGENT); }
__device__ __forceinline__ unsigned xb_add(unsigned* p, unsigned v) { return __hip_atomic_fetch_add(p, v, __ATOMIC_RELAXED, __HIP_MEMORY_SCOPE_AGENT); }
__device__ __forceinline__ unsigned xb_xcc_id() { return (unsigned)__builtin_amdgcn_s_getreg((3 << 11) | 20) & 0xFu; }
#define XB_SPIN(cond, bar) do { unsigned _sp = 0; while (cond) { __builtin_amdgcn_s_sleep(1); \
    if ((++_sp & 255u) == 0u) { if (xb_ld(&(bar)[XB_TMO])) break; if (_sp > XB_SPIN_CAP) { atomicAdd(&(bar)[XB_TMO], 1u); break; } } } } while (0)

struct XcdBarrier {
    unsigned* bar; unsigned x;
    volatile LAS unsigned* st;
};

__device__ __forceinline__ XcdBarrier xcd_barrier_post(unsigned* bar, volatile LAS unsigned* st) {
    XcdBarrier b; b.bar = bar; b.x = xb_xcc_id(); b.st = st;
    if (threadIdx.x == 0) (void)xb_add(&bar[XB_XCNT(b.x)], 1u);
    return b;
}
__device__ __forceinline__ void xcd_barrier_complete(unsigned* bar, unsigned x, unsigned& nloc, unsigned& nx) {
    const unsigned G = gridDim.x * gridDim.y * gridDim.z;
    unsigned sum, cnt, mine, sp = 0u;
    for (;;) {
        sum = 0u; cnt = 0u; mine = 0u;
#pragma unroll
        for (unsigned j = 0; j < 16; ++j) { const unsigned c = xb_ld(&bar[XB_XCNT(j)]); sum += c; cnt += (c > 0u) ? 1u : 0u; mine = (j == x) ? c : mine; }
        if (sum == G) break;
        __builtin_amdgcn_s_sleep(1);
        if ((++sp & 255u) == 0u) { if (xb_ld(&bar[XB_TMO])) break; if (sp > XB_SPIN_CAP) { atomicAdd(&bar[XB_TMO], 1u); break; } }
    }
    nloc = mine > 0u ? mine : 1u; nx = cnt > 0u ? cnt : 1u;
}

__device__ __forceinline__ void xcd_barrier(const XcdBarrier& b) {
    asm volatile("s_waitcnt vmcnt(0)" ::: "memory");
    __syncthreads();
    if (threadIdx.x == 0) {
        unsigned* bar = b.bar;
        __builtin_amdgcn_s_waitcnt(0);
        unsigned nloc = b.st[0], nx = b.st[1];
        if (nloc == 0u) { xcd_barrier_complete(bar, b.x, nloc, nx); b.st[0] = nloc; b.st[1] = nx; }
        const unsigned old = xb_add(&bar[XB_XSUB(b.x)], 1u);
        const unsigned gen = old / nloc;
        if (old + 1u == (gen + 1u) * nloc) {
            __builtin_amdgcn_fence(__ATOMIC_RELEASE, "agent");
            asm volatile("s_waitcnt vmcnt(0)" ::: "memory");
            const unsigned og = xb_add(&bar[XB_TOP], 1u);
            const unsigned tg = og / nx;
            if (og + 1u == (tg + 1u) * nx) xb_add(&bar[XB_TOPGEN], 1u);
            else XB_SPIN(xb_ld(&bar[XB_TOPGEN]) == tg, bar);
            __builtin_amdgcn_fence(__ATOMIC_ACQUIRE, "agent");
            xb_add(&bar[XB_XGEN(b.x)], 1u);
            asm volatile("s_waitcnt vmcnt(0)" ::: "memory");
        } else {
            XB_SPIN(xb_ld(&bar[XB_XGEN(b.x)]) == gen, bar);
            __builtin_amdgcn_fence(__ATOMIC_ACQUIRE, "agent");
            asm volatile("s_waitcnt vmcnt(0)" ::: "memory");
        }
    }
    __syncthreads();
}

constexpr int NPHASES = 12;
__global__ void __launch_bounds__(NWAVES * 64, 2) fwd_kernel(Args a) {
    extern __shared__ __attribute__((aligned(16))) unsigned char lds_raw[];
    LAS unsigned char* lds = (LAS unsigned char*)lds_raw;
    const int tid = threadIdx.x, lane = tid & 63, wave = __builtin_amdgcn_readfirstlane(tid >> 6);
    const int G = gridDim.x, bx = blockIdx.x, gw = bx * NWAVES + wave, NGW = G * NWAVES;
    unsigned char* ws = a.ws;
    const int lo = a.ph_lo, hi = a.ph_hi;
    for (int u = tid; u < (LDS_BYTES - LDSCTL_OFF) / 4; u += NWAVES * 64) ((LAS unsigned*)(lds + LDSCTL_OFF))[u] = 0u;
    __syncthreads();
    XcdBarrier bar; bar.bar = (unsigned*)(ws + WS_BAR); bar.x = 0; bar.st = nullptr;
    if (hi - lo > 1) bar = xcd_barrier_post((unsigned*)(ws + WS_BAR), (volatile LAS unsigned*)(lds + LDSCTL_OFF + 64));
#ifndef PHM
#define PHM 0xfff
#endif
#define IN(k) (((PHM >> (k)) & 1) && lo <= (k) && (k) < hi)
#ifndef REPM
#define REPM 0
#endif
#define NREP(k) (1 + ((REPM >> (k)) & 1))
#define SEAM(k) do { if (IN(k) && IN((k) + 1)) { if ((k) == 0) cg::this_grid().sync(); else { xcd_barrier(bar); if ((REPM >> 15) & 1) xcd_barrier(bar); } } } while (0)
#define GEMM_PHASE(EPI, gm, S, E) pg8::gemm_phase<EPI, pg8::StaticOrder, true, true>(lds, gm, S, E)

    if (IN(0)) for (int rep = 0; rep < NREP(0); ++rep) phase_prologue(a, lds, gw, NGW, wave, lane);
    SEAM(0);
    if (IN(1)) for (int rep = 0; rep < NREP(1); ++rep) {
        { pg8::Gemm gm{(const bf16*)(ws + WS_N), (const bf16*)(ws + WS_WIN), T, NINP, 2048}; pg8::StaticOrder S; S.init(T, NINP, G, bx); EpiProj E{ws}; GEMM_PHASE(EpiProj, gm, S, E); }
#if (REPM >> 14) & 1
        { pg8::Gemm gm{(const bf16*)(ws + WS_N), (const bf16*)(ws + WS_WIN), T, NINP, 2048}; pg8::StaticOrder S; S.init(T, NINP, G, bx); EpiProj E{ws}; GEMM_PHASE(EpiProj, gm, S, E); }
#endif
        { pg8::Gemm gm{(const bf16*)(ws + WS_MN), (const bf16*)(ws + WS_WXKV), 256, 1024, 2048}; pg8::StaticOrder S; S.init(256, 1024, G, G - 1 - bx); EpiKvx E{ws}; GEMM_PHASE(EpiKvx, gm, S, E); }
    }
    SEAM(1);
    if (IN(2)) for (int rep = 0; rep < NREP(2); ++rep) {
        for (int r2 = 0; r2 < 1 + ((REPM >> 13) & 1); ++r2) for (int it = bx; it < 64; it += G) compress_block(ws, it, lds, wave, lane, tid);
        for (int r2 = 0; r2 < 1 + ((REPM >> 12) & 1); ++r2) for (int wi = NGW - 1 - gw; wi < 3072; wi += NGW) dilated_item(ws, wi >> 2, wi & 3, lds + wave * 16384, lane);
    }
    SEAM(2);
    if (IN(3)) for (int rep = 0; rep < NREP(3); ++rep) {
        LAS float* pc = (LAS float*)(lds + wave * 16384); LAS unsigned char* buf = lds + wave * 16384 + 8192;
        for (int it = gw; it < 4096; it += NGW) { const int Gk = it >> 11, idx = it & 2047; nsa_item(ws, Gk, Gk ? 2047 - idx : idx, pc, (LAS int*)(lds + LDSCTL_OFF + 1024 + wave * 512), buf, lane); }
        dilated_combine(ws, (size_t)gw * 64 + lane, (size_t)NGW * 64);
    }
    SEAM(3);
    if (IN(4)) for (int rep = 0; rep < NREP(4); ++rep) {
        { pg8::Gemm gm{(const bf16*)(ws + WS_YA), (const bf16*)(ws + WS_WUPA), T, 2048, 512}; pg8::StaticOrder S; S.init(T, 2048, G, bx); EpiMix<0> E{ws}; GEMM_PHASE(EpiMix<0>, gm, S, E); }
        { pg8::Gemm gm{(const bf16*)(ws + WS_YB), (const bf16*)(ws + WS_WUPB), T, 2048, 1024}; pg8::StaticOrder S; S.init(T, 2048, G, bx); EpiMix<1> E{ws}; GEMM_PHASE(EpiMix<1>, gm, S, E); }
#if (REPM >> 16) & 1
        { pg8::Gemm gm{(const bf16*)(ws + WS_YA), (const bf16*)(ws + WS_WUPA), T, 2048, 512}; pg8::StaticOrder S; S.init(T, 2048, G, bx); EpiMix<0> E{ws}; GEMM_PHASE(EpiMix<0>, gm, S, E); }
        { pg8::Gemm gm{(const bf16*)(ws + WS_YB), (const bf16*)(ws + WS_WUPB), T, 2048, 1024}; pg8::StaticOrder S; S.init(T, 2048, G, bx); EpiMix<1> E{ws}; GEMM_PHASE(EpiMix<1>, gm, S, E); }
#endif
    }
    SEAM(4);
    if (IN(5)) {
        pg8::Gemm gm{(const bf16*)(ws + WS_MIX), (const bf16*)(ws + WS_WOUT), T, 2048, 2048}; pg8::StaticOrder S; S.init(T, 2048, G, bx);
        EpiRes E{a.in[0], a.out, (bf16*)(ws + WS_H1G), a.in[13], (float*)(ws + WS_SSQ1)}; GEMM_PHASE(EpiRes, gm, S, E);
    }
    SEAM(5);
    if (IN(6)) for (int rep = 0; rep < NREP(6); ++rep) {
        pg8::Gemm gm{(const bf16*)(ws + WS_H1G), (const bf16*)(ws + WS_WXQ), T, 512, 2048}; pg8::StaticOrder S; S.init(T, 512, G, bx);
        EpiScaleRow E{(bf16*)(ws + WS_QX), 512, (const float*)(ws + WS_SSQ1)}; GEMM_PHASE(EpiScaleRow, gm, S, E);
        if (G > 64 && bx >= 64) convert_experts(a, (size_t)(bx - 64) * (NWAVES * 64) + tid, (size_t)(G - 64) * (NWAVES * 64));
        else if (G <= 64) convert_experts(a, (size_t)bx * (NWAVES * 64) + tid, (size_t)G * (NWAVES * 64));
#if (REPM >> 17) & 1
        {
        pg8::Gemm gm{(const bf16*)(ws + WS_H1G), (const bf16*)(ws + WS_WXQ), T, 512, 2048}; pg8::StaticOrder S; S.init(T, 512, G, bx);
        EpiScaleRow E{(bf16*)(ws + WS_QX), 512, (const float*)(ws + WS_SSQ1)}; GEMM_PHASE(EpiScaleRow, gm, S, E);
        if (G > 64 && bx >= 64) convert_experts(a, (size_t)(bx - 64) * (NWAVES * 64) + tid, (size_t)(G - 64) * (NWAVES * 64));
        else if (G <= 64) convert_experts(a, (size_t)bx * (NWAVES * 64) + tid, (size_t)G * (NWAVES * 64));
        }
#endif
    }
    SEAM(6);
    if (IN(7)) for (int rep = 0; rep < NREP(7); ++rep) { for (int it = gw; it < 1024; it += NGW) cross_item(ws, it, lds + wave * 16384, lane); }
    SEAM(7);
    if (IN(8)) {
        pg8::Gemm gm{(const bf16*)(ws + WS_OX), (const bf16*)(ws + WS_WXO), T, 2048, 512}; pg8::StaticOrder S; S.init(T, 2048, G, bx);
        EpiRes E{a.out, a.out, (bf16*)(ws + WS_H2G), a.in[18], (float*)(ws + WS_SSQ2)}; GEMM_PHASE(EpiRes, gm, S, E);
    }
    SEAM(8);
    if (IN(9)) for (int rep = 0; rep < NREP(9); ++rep) {
        pg8::Gemm gm{(const bf16*)(ws + WS_H2G), (const bf16*)(ws + WS_WPQ), T, 2048, 2048}; pg8::StaticOrder S; S.init(T, 2048, G, bx);
        EpiScaleRow E{(bf16*)(ws + WS_PQ), 2048, (const float*)(ws + WS_SSQ2)}; GEMM_PHASE(EpiScaleRow, gm, S, E);
    }
    SEAM(9);
    if (IN(10)) for (int rep = 0; rep < NREP(10); ++rep) { LAS float* scr = (LAS float*)(lds + wave * 8192); for (int it = gw; it < 2048; it += NGW) peer_topk_item(ws, it, scr, lane); }
    SEAM(10);
    if (IN(11)) {
        if (NREP(11) > 1) for (int t = gw; t < T; t += NGW) peer_gather_token(a, t, lane, (float*)(ws + WS_OA));
        for (int t = gw; t < T; t += NGW) peer_gather_token(a, t, lane, a.out);
    }
#undef IN
#undef SEAM
#undef GEMM_PHASE
}

extern "C" void kernel_launch(void* const* d_in, const int* in_sizes, int n_in, void* d_out, int out_size, void* d_ws, size_t ws_size, hipStream_t stream) {
    static int grid = 0;
    if (grid == 0) {
        if (n_in != 25 || out_size != T * DM || ws_size < WS_END) { fprintf(stderr, "kernel_launch: unexpected problem (n_in %d, out %d, ws %zu < %zu)\n", n_in, out_size, ws_size, (size_t)WS_END); grid = -1; return; }
        int dev = 0, cus = 0, per_cu = 0;
        if (hipGetDevice(&dev) != hipSuccess || hipDeviceGetAttribute(&cus, hipDeviceAttributeMultiprocessorCount, dev) != hipSuccess) { grid = -1; return; }
        if (hipFuncSetAttribute((const void*)fwd_kernel, hipFuncAttributeMaxDynamicSharedMemorySize, LDS_BYTES) != hipSuccess) { fprintf(stderr, "kernel_launch: hipFuncSetAttribute failed\n"); grid = -1; return; }
        if (hipOccupancyMaxActiveBlocksPerMultiprocessor(&per_cu, (const void*)fwd_kernel, NWAVES * 64, LDS_BYTES) != hipSuccess || per_cu < 1) { fprintf(stderr, "kernel_launch: occupancy query says %d\n", per_cu); per_cu = 1; }
        (void)hipGetLastError();
        grid = cus;
    }
    if (grid < 0) return;
    (void)hipMemsetAsync((char*)d_ws, 0, CTL_ZERO_BYTES, stream);
    Args a{};
    for (int i = 0; i < 25; ++i) a.in[i] = (const float*)d_in[i];
    a.out = (float*)d_out; a.ws = (unsigned char*)d_ws;
#if ONE_LAUNCH
    a.ph_lo = 0; a.ph_hi = NPHASES;
    void* kargs[] = {&a};
    hipError_t e = hipLaunchCooperativeKernel((const void*)fwd_kernel, dim3(grid), dim3(NWAVES * 64), kargs, LDS_BYTES, stream);
    if (e != hipSuccess) fprintf(stderr, "kernel_launch: cooperative launch failed: %s (grid %d)\n", hipGetErrorString(e), grid);
#else
    for (int ph = 0; ph < NPHASES; ++ph) { a.ph_lo = ph; a.ph_hi = ph + 1; hipLaunchKernelGGL(fwd_kernel, dim3(grid), dim3(NWAVES * 64), LDS_BYTES, stream, a); }
#endif
}
```
